# Optimizing an MI355X kernel written in HIP

```python
import jax
import jax.numpy as jnp
from jax import lax
import numpy as np

D_MODEL = 1024
BATCH = 16
SEQ = 4096
DEPTH = 4

GRID_W = 64
CTX_LEN = 256
N_MIXERS = 3
N_ATTN_LAYERS = (DEPTH + 2) // N_MIXERS
N_RWKV_LAYERS = (DEPTH + 1) // N_MIXERS
N_POOL_LAYERS = DEPTH // N_MIXERS
N_MOD = 6
EPS = 1e-6
N_HEADS = 16
N_KV_HEADS = 4
HEAD_DIM = D_MODEL // N_HEADS
GQA_REP = N_HEADS // N_KV_HEADS
Q_WIDTH = N_HEADS * HEAD_DIM
KV_WIDTH = N_KV_HEADS * HEAD_DIM
QKV_WIDTH = Q_WIDTH + 2 * KV_WIDTH
ROPE_THETA = 10000.0
Q_BLOCK = 128
RWKV_HEAD = 64
RWKV_HEADS = D_MODEL // RWKV_HEAD
DECAY_LORA = 64
ICLR_LORA = 64
GATE_LORA = 160
GN_EPS = RWKV_HEAD * 1e-5
N_DIRS = 2
POOL_WINDOWS = (2, 4, 8, 16)
POOL_GROUP = D_MODEL // len(POOL_WINDOWS)
D_FF = 4 * D_MODEL

kernel_name = "hybrid_attn_rwkv7_pool_dit"


def _rmsnorm(x, g):
    xf = x.astype(jnp.float32)
    y = xf * lax.rsqrt(jnp.mean(xf * xf, axis=-1, keepdims=True) + EPS)
    return (y * g.astype(jnp.float32)).astype(x.dtype)


def _axial_rope(n_tokens):
    rows = n_tokens // GRID_W
    n_freq = HEAD_DIM // 4
    inv = ROPE_THETA ** (-jnp.arange(n_freq, dtype=jnp.float32) / n_freq)
    ang_r = jnp.arange(rows, dtype=jnp.float32)[:, None] * inv
    ang_c = jnp.arange(GRID_W, dtype=jnp.float32)[:, None] * inv
    ang = jnp.concatenate([
        jnp.broadcast_to(ang_r[:, None, :], (rows, GRID_W, n_freq)),
        jnp.broadcast_to(ang_c[None, :, :], (rows, GRID_W, n_freq))], axis=-1).reshape(rows * GRID_W, 2 * n_freq)
    return jnp.cos(ang), jnp.sin(ang)


def _rope(x, cos, sin):
    half = HEAD_DIM // 2
    xf = x.astype(jnp.float32)
    x1, x2 = xf[..., :half], xf[..., half:]
    c = cos[None, :, None, :]
    s = sin[None, :, None, :]
    return jnp.concatenate([x1 * c - x2 * s, x1 * s + x2 * c], axis=-1).astype(x.dtype)


def _attn_project(h, w_qkv, q_gain, k_gain):
    B, T, _ = h.shape
    qkv = h @ w_qkv
    q = qkv[..., :Q_WIDTH].reshape(B, T, N_HEADS, HEAD_DIM)
    k = qkv[..., Q_WIDTH:Q_WIDTH + KV_WIDTH].reshape(B, T, N_KV_HEADS, HEAD_DIM)
    v = qkv[..., Q_WIDTH + KV_WIDTH:].reshape(B, T, N_KV_HEADS, HEAD_DIM)
    return _rmsnorm(q, q_gain), _rmsnorm(k, k_gain), v


def attention_mixer(h_lat, h_ctx, w_qkv, q_gain, k_gain, w_o, with_ctx_out):
    B, S, _ = h_lat.shape
    L = h_ctx.shape[1]
    scale = HEAD_DIM ** -0.5
    cos, sin = _axial_rope(S)
    q_l, k_l, v_l = _attn_project(h_lat, w_qkv, q_gain, k_gain)
    q_l = _rope(q_l, cos, sin)
    k_l = _rope(k_l, cos, sin)
    q_c, k_c, v_c = _attn_project(h_ctx, w_qkv, q_gain, k_gain)
    n_blk = S // Q_BLOCK
    q_blocks = jnp.moveaxis(q_l.reshape(B, n_blk, Q_BLOCK, N_KV_HEADS, GQA_REP, HEAD_DIM), 1, 0)

    def attend_block(qb):
        s = jnp.concatenate([
            jnp.einsum("bqgrd,bsgd->bgrqs", qb, k_l),
            jnp.einsum("bqgrd,bcgd->bgrqc", qb, k_c)], axis=-1).astype(jnp.float32) * scale
        p = jax.nn.softmax(s, axis=-1).astype(v_l.dtype)
        return (jnp.einsum("bgrqs,bsgd->bqgrd", p[..., :S], v_l)
                + jnp.einsum("bgrqc,bcgd->bqgrd", p[..., S:], v_c))

    o = lax.map(attend_block, q_blocks)
    out_l = jnp.moveaxis(o, 0, 1).reshape(B, S, Q_WIDTH) @ w_o
    out_c = None
    if with_ctx_out:
        qc = q_c.reshape(B, L, N_KV_HEADS, GQA_REP, HEAD_DIM)
        s = jnp.einsum("bqgrd,bcgd->bgrqc", qc, k_c).astype(jnp.float32) * scale
        p = jax.nn.softmax(s, axis=-1).astype(v_c.dtype)
        out_c = jnp.einsum("bgrqc,bcgd->bqgrd", p, v_c).reshape(B, L, Q_WIDTH) @ w_o
    return out_l, out_c


def _centred_shift(h):
    zero = jnp.zeros_like(h[:, :1])
    prev = jnp.concatenate([zero, h[:, :-1]], axis=1)
    nxt = jnp.concatenate([h[:, 1:], zero], axis=1)
    return 0.5 * (prev + nxt) - h


def _heads(t):
    return t.reshape(t.shape[0], t.shape[1], RWKV_HEADS, RWKV_HEAD)


def _rwkv_prepare(h, mu, w_rkv, w0, w1, w2, a0, a1, a2, g1, g2, k_k, k_a):
    xx = _centred_shift(h)
    xr, xw, xk, xv, xa, xg = [h + xx * mu[m] for m in range(6)]
    r = xr @ w_rkv[0]
    k = xk @ w_rkv[1]
    v = xv @ w_rkv[2]
    g = jax.nn.sigmoid(xg @ g1) @ g2
    kk = _heads((k * k_k).astype(jnp.float32))
    kk = kk / jnp.maximum(jnp.sqrt(jnp.sum(kk * kk, axis=-1, keepdims=True)), 1e-12)
    decays, keys, iclrs = [], [], []
    for d in range(N_DIRS):
        w_log = -jax.nn.softplus(-(w0[d] + jnp.tanh(xw @ w1[d]) @ w2[d])) - 0.5
        decays.append(_heads(jnp.exp(-jnp.exp(w_log.astype(jnp.float32)))))
        a = jax.nn.sigmoid(a0[d] + (xa @ a1[d]) @ a2[d])
        keys.append(_heads(k * (1.0 + (a - 1.0) * k_a)))
        iclrs.append(_heads(a))
    return _heads(r), _heads(v), kk, g, decays, keys, iclrs


def _wkv_scan(state0, r, decay, k, v, kk, a, reverse):
    xs = tuple(jnp.moveaxis(t.astype(jnp.float32), 1, 0) for t in (r, decay, k, v, kk, a))

    def step(state, inp):
        r_t, w_t, k_t, v_t, kk_t, a_t = inp
        sa = jnp.einsum("bhvk,bhk->bhv", state, kk_t)
        state = (state * w_t[:, :, None, :]
                 - sa[..., None] * (kk_t * a_t)[:, :, None, :]
                 + v_t[..., None] * k_t[:, :, None, :])
        return state, jnp.einsum("bhvk,bhk->bhv", state, r_t)

    state, ys = lax.scan(step, state0, xs, reverse=reverse)
    return state, jnp.moveaxis(ys, 0, 1)


def _rwkv_finish(y, r, v, keys, r_k, g, ln_g, ln_b, w_o):
    B, T = y.shape[:2]
    mean = jnp.mean(y, axis=-1, keepdims=True)
    var = jnp.mean(jnp.square(y - mean), axis=-1, keepdims=True)
    y = ((y - mean) * lax.rsqrt(var + GN_EPS)).reshape(B, T, D_MODEL)
    y = y * ln_g.astype(jnp.float32) + ln_b.astype(jnp.float32)
    k_sum = (keys[0] + keys[1]).astype(jnp.float32)
    rk = r_k.reshape(RWKV_HEADS, RWKV_HEAD).astype(jnp.float32)
    bonus = jnp.sum(r.astype(jnp.float32) * k_sum * rk, axis=-1, keepdims=True) * v.astype(jnp.float32)
    y = y + bonus.reshape(B, T, D_MODEL)
    return (y.astype(g.dtype) * g) @ w_o


def rwkv_mixer(h_lat, h_ctx, mu, w_rkv, w0, w1, w2, a0, a1, a2, g1, g2, k_k, k_a, r_k, ln_g, ln_b, w_o,
               with_ctx_out):
    prep = (mu, w_rkv, w0, w1, w2, a0, a1, a2, g1, g2, k_k, k_a)
    r_l, v_l, kk_l, g_l, dec_l, key_l, a_l = _rwkv_prepare(h_lat, *prep)
    r_c, v_c, kk_c, g_c, dec_c, key_c, a_c = _rwkv_prepare(h_ctx, *prep)
    B = h_lat.shape[0]
    zero = jnp.zeros((B, RWKV_HEADS, RWKV_HEAD, RWKV_HEAD), jnp.float32)
    ys_l, ys_c = [], []
    for d in range(N_DIRS):
        rev = d == 1
        s_ctx, yc = _wkv_scan(zero, r_c, dec_c[d], key_c[d], v_c, kk_c, a_c[d], rev)
        _, yl = _wkv_scan(s_ctx, r_l, dec_l[d], key_l[d], v_l, kk_l, a_l[d], rev)
        ys_l.append(yl)
        ys_c.append(yc)
    out_l = _rwkv_finish(ys_l[0] + ys_l[1], r_l, v_l, key_l, r_k, g_l, ln_g, ln_b, w_o)
    out_c = None
    if with_ctx_out:
        out_c = _rwkv_finish(ys_c[0] + ys_c[1], r_c, v_c, key_c, r_k, g_c, ln_g, ln_b, w_o)
    return out_l, out_c


def pool_mixer(h, w_group, scale):
    B, T, _ = h.shape
    hf = h.astype(jnp.float32)
    cs = jnp.concatenate([jnp.zeros((B, 1, D_MODEL), jnp.float32), jnp.cumsum(hf, axis=1)], axis=1)
    t = jnp.arange(T)
    outs = []
    for gi, win in enumerate(POOL_WINDOWS):
        sl = slice(gi * POOL_GROUP, (gi + 1) * POOL_GROUP)
        lo = jnp.clip(t - win // 2, 0, T)
        hi = jnp.clip(t + win // 2, 0, T)
        cs_g = cs[..., sl]
        sums = jnp.take(cs_g, hi, axis=1) - jnp.take(cs_g, lo, axis=1)
        cnt = (hi - lo).astype(jnp.float32)[None, :, None]
        pooled = (sums / cnt - hf[..., sl]).astype(h.dtype)
        outs.append(jnp.einsum("btc,cd->btd", pooled, w_group[gi]))
    return jnp.concatenate(outs, axis=-1) * scale


def _sq_relu_mlp(h, w_in, w_out):
    u = jax.nn.relu(h @ w_in)
    return (u * u) @ w_out


def setup_inputs(seed: int = 0) -> dict:
    key = jax.random.key(seed)
    ks = iter(jax.random.split(key, 40))

    def nrm(shape, s):
        return jax.random.normal(next(ks), shape, jnp.float32) * s

    def unif(shape, lo, hi):
        return jax.random.uniform(next(ks), shape, jnp.float32, lo, hi)

    D = D_MODEL
    return {
        "x": nrm((BATCH, SEQ, D), 1.0),
        "c": nrm((BATCH, D), 1.0),
        "ctx": nrm((BATCH, CTX_LEN, D), 1.0),
        "c_ctx": nrm((D,), 1.0),
        "w_mod": nrm((DEPTH, D, N_MOD * D), 0.5 * D ** -0.5),
        "b_mod": nrm((DEPTH, N_MOD * D), 0.02),
        "norm1_g": 1.0 + nrm((DEPTH, D), 0.02),
        "norm2_g": 1.0 + nrm((DEPTH, D), 0.02),
        "mlp_w_in": nrm((DEPTH, D, D_FF), D ** -0.5),
        "mlp_w_out": nrm((DEPTH, D_FF, D), D_FF ** -0.5),
        "attn_w_qkv": nrm((N_ATTN_LAYERS, D, QKV_WIDTH), D ** -0.5),
        "attn_q_gain": 1.0 + nrm((N_ATTN_LAYERS, HEAD_DIM), 0.02),
        "attn_k_gain": 1.0 + nrm((N_ATTN_LAYERS, HEAD_DIM), 0.02),
        "attn_w_o": nrm((N_ATTN_LAYERS, Q_WIDTH, D), Q_WIDTH ** -0.5),
        "rwkv_mu": unif((N_RWKV_LAYERS, 6, D), 0.0, 1.0),
        "rwkv_w_rkv": nrm((N_RWKV_LAYERS, 3, D, D), D ** -0.5),
        "rwkv_w0": unif((N_RWKV_LAYERS, N_DIRS, D), -5.0, 0.0),
        "rwkv_w1": nrm((N_RWKV_LAYERS, N_DIRS, D, DECAY_LORA), D ** -0.5),
        "rwkv_w2": nrm((N_RWKV_LAYERS, N_DIRS, DECAY_LORA, D), 0.1 * DECAY_LORA ** -0.5),
        "rwkv_a0": nrm((N_RWKV_LAYERS, N_DIRS, D), 0.5),
        "rwkv_a1": nrm((N_RWKV_LAYERS, N_DIRS, D, ICLR_LORA), D ** -0.5),
        "rwkv_a2": nrm((N_RWKV_LAYERS, N_DIRS, ICLR_LORA, D), 0.5 * ICLR_LORA ** -0.5),
        "rwkv_g1": nrm((N_RWKV_LAYERS, D, GATE_LORA), D ** -0.5),
        "rwkv_g2": nrm((N_RWKV_LAYERS, GATE_LORA, D), GATE_LORA ** -0.5),
        "rwkv_k_k": 0.85 + nrm((N_RWKV_LAYERS, D), 0.05),
        "rwkv_k_a": 1.0 + nrm((N_RWKV_LAYERS, D), 0.05),
        "rwkv_r_k": nrm((N_RWKV_LAYERS, D), 0.1),
        "rwkv_ln_g": 1.0 + nrm((N_RWKV_LAYERS, D), 0.02),
        "rwkv_ln_b": nrm((N_RWKV_LAYERS, D), 0.02),
        "rwkv_w_o": nrm((N_RWKV_LAYERS, D, D), D ** -0.5),
        "pool_w": nrm((N_POOL_LAYERS, len(POOL_WINDOWS), POOL_GROUP, POOL_GROUP), POOL_GROUP ** -0.5),
        "pool_scale": unif((N_POOL_LAYERS, D), 0.5, 1.5),
    }


def reference(x, c, ctx, c_ctx, w_mod, b_mod, norm1_g, norm2_g, mlp_w_in, mlp_w_out,
              attn_w_qkv, attn_q_gain, attn_k_gain, attn_w_o,
              rwkv_mu, rwkv_w_rkv, rwkv_w0, rwkv_w1, rwkv_w2, rwkv_a0, rwkv_a1, rwkv_a2,
              rwkv_g1, rwkv_g2, rwkv_k_k, rwkv_k_a, rwkv_r_k, rwkv_ln_g, rwkv_ln_b, rwkv_w_o,
              pool_w, pool_scale):
    B = x.shape[0]
    silu_c = jax.nn.silu(c)
    silu_cc = jax.nn.silu(c_ctx)
    for i in range(DEPTH):
        last = i == DEPTH - 1
        j = i // N_MIXERS
        mod_l = (silu_c @ w_mod[i] + b_mod[i]).reshape(B, N_MOD, 1, D_MODEL)
        mod_c = (silu_cc @ w_mod[i] + b_mod[i]).reshape(N_MOD, 1, 1, D_MODEL)
        h_l = _rmsnorm(x, norm1_g[i]) * (1.0 + mod_l[:, 1]) + mod_l[:, 0]
        h_c = _rmsnorm(ctx, norm1_g[i]) * (1.0 + mod_c[1]) + mod_c[0]
        kind = i % N_MIXERS
        if kind == 0:
            y_l, y_c = attention_mixer(h_l, h_c, attn_w_qkv[j], attn_q_gain[j], attn_k_gain[j], attn_w_o[j],
                                       not last)
        elif kind == 1:
            y_l, y_c = rwkv_mixer(h_l, h_c, rwkv_mu[j], rwkv_w_rkv[j], rwkv_w0[j], rwkv_w1[j], rwkv_w2[j],
                                  rwkv_a0[j], rwkv_a1[j], rwkv_a2[j], rwkv_g1[j], rwkv_g2[j], rwkv_k_k[j],
                                  rwkv_k_a[j], rwkv_r_k[j], rwkv_ln_g[j], rwkv_ln_b[j], rwkv_w_o[j], not last)
        else:
            y_l = pool_mixer(h_l, pool_w[j], pool_scale[j])
            y_c = None if last else pool_mixer(h_c, pool_w[j], pool_scale[j])
        x = x + mod_l[:, 2] * y_l
        h2 = _rmsnorm(x, norm2_g[i]) * (1.0 + mod_l[:, 4]) + mod_l[:, 3]
        x = x + mod_l[:, 5] * _sq_relu_mlp(h2, mlp_w_in[i], mlp_w_out[i])
        if not last:
            ctx = ctx + mod_c[2] * y_c
            h2c = _rmsnorm(ctx, norm2_g[i]) * (1.0 + mod_c[4]) + mod_c[3]
            ctx = ctx + mod_c[5] * _sq_relu_mlp(h2c, mlp_w_in[i], mlp_w_out[i])
    return x
```

```cpp
#include <hip/hip_runtime.h>
#include <hip/hip_cooperative_groups.h>
#include <cstdio>
#include <cstdint>
namespace cg = cooperative_groups;
namespace pg8 {
#define PG8_LAS __attribute__((address_space(3)))
typedef unsigned short bf16_t;
typedef short bf16x8 __attribute__((ext_vector_type(8)));
typedef float f32x4 __attribute__((ext_vector_type(4)));
typedef unsigned u32x4 __attribute__((ext_vector_type(4)));
constexpr int BM = 256, BK = 64, HALF = 128, HTB = HALF * BK * 2  , STAGE_BYTES = 8 * HTB, NXCD = 8, WGM = 8;

__host__ __device__ __forceinline__ int lds_byte(int r, int c) { const int st = (r >> 4) * 2 + (c >> 5), rr = r & 15, cc = c & 31, ob = rr * 64 + cc * 2; return st * 1024 + (ob ^ (((ob >> 9) & 1) << 5)); }
__host__ __device__ __forceinline__ void stage_rc(int b, int& R, int& C) { const int st = b / 1024, sb = b % 1024, swz = sb ^ (((sb >> 9) & 1) << 5); R = (st >> 1) * 16 + swz / 64; C = (st & 1) * 32 + (swz % 64) / 2; }
__host__ __device__ __forceinline__ int perm32(int rho) { const int n = rho >> 4, i = rho & 15; return 8 * (i >> 2) + 4 * n + (i & 3); }

struct Unit { int pm, pn; };
struct Gemm { const bf16_t* A; const bf16_t* Bt; int M, N, K; int lda; long a_pn_off; };

struct StaticOrder {
    int nM, nN, nwg, G, c;
    __host__ __device__ void init(int M, int N, int G_, int c_) { nM = M / BM; nN = N / BM; nwg = nM * nN; G = G_; c = c_; }
    __host__ __device__ bool next(int i, Unit& u) const {
        const long L = (long)i * G + c; if (L >= nwg) return false;
        int wgid = (int)L; { const int q = nwg / NXCD, r = nwg % NXCD, xcd = wgid % NXCD, off = wgid / NXCD; wgid = (xcd < r ? xcd * (q + 1) : r * (q + 1) + (xcd - r) * q) + off; }
        const int nig = WGM * nN, gid = wgid / nig, fm = gid * WGM, gsz = (nM - fm) < WGM ? (nM - fm) : WGM;
        u.pm = fm + ((wgid % nig) % gsz); u.pn = (wgid % nig) / gsz; return true;
    }
    __device__ __forceinline__ void a_ready(const Unit&) const {}
    __device__ __forceinline__ void done(const Unit&) const {}
};

__device__ __forceinline__ unsigned cvt_pk_bf16(float lo, float hi) { unsigned r; asm volatile("v_cvt_pk_bf16_f32 %0, %1, %2" : "=v"(r) : "v"(lo), "v"(hi)); return r; }
typedef float f32x2 __attribute__((ext_vector_type(2)));
template <class Epi, class Sched, bool ALIGN_EPI = false, bool SP2 = false>
__device__ __forceinline__ void gemm_phase(PG8_LAS unsigned char* lds, const Gemm g, const Sched& S, const Epi& E) {
    int tid_ = threadIdx.x; asm volatile("" : "+v"(tid_)); const int tid = tid_, wid = __builtin_amdgcn_readfirstlane(tid >> 6), lane = tid & 63, wr = wid >> 2, wc = wid & 3, fr = lane & 15, fq = lane >> 4;
    const int K = g.K, nt = K / BK;
    unsigned voffA[2], voffB[2];
#pragma unroll
    for (int i = 0; i < 2; ++i) { int R, C; stage_rc(tid * 16 + i * 8192, R, C); const int Rb = Epi::PERM ? ((R & ~31) + perm32(R & 31)) : R;
        voffA[i] = (unsigned)(R * g.lda + C) * 2u; voffB[i] = (unsigned)(Rb * K + C) * 2u; }
    const size_t kstep = (size_t)(BK * 2);
    const size_t hA = (size_t)HALF * g.lda * 2, hB = (size_t)HALF * K * 2;
    const size_t tA = 2 * hA, tB = 2 * hB, pnA = (size_t)g.a_pn_off * 2;
    const unsigned ldsw = (unsigned)wid * 1024u;
    const int aoff = lds_byte(wr * 64 + fr, fq * 8), boff = lds_byte(wc * 32 + fr, fq * 8);
#define PG8_SA(b, h) (((b) * 2 + (h)) * HTB)
#define PG8_SB(b, h) ((4 + (b) * 2 + (h)) * HTB)
#define PG8_STAGE(bufoff, gbase, voff) do { _Pragma("unroll") for (int _i = 0; _i < 2; ++_i) \
        __builtin_amdgcn_global_load_lds((const unsigned*)((const char*)(gbase) + (voff)[_i]), (PG8_LAS unsigned*)(lds + (bufoff) + ldsw + _i * 8192), 16, 0, 0); } while (0)
#define PG8_LDA(dst, b, h) do { _Pragma("unroll") for (int m = 0; m < 4; ++m) _Pragma("unroll") for (int k = 0; k < 2; ++k) dst[m][k] = *(const PG8_LAS bf16x8*)(lds + PG8_SA(b, h) + aoff + m * 2048 + k * 1024); } while (0)
#define PG8_LDB(dst, b, h) do { _Pragma("unroll") for (int n = 0; n < 2; ++n) _Pragma("unroll") for (int k = 0; k < 2; ++k) dst[n][k] = *(const PG8_LAS bf16x8*)(lds + PG8_SB(b, h) + boff + n * 2048 + k * 1024); } while (0)
#define PG8_MMA(ai, bj, At, Bt) do { __builtin_amdgcn_s_setprio(1); _Pragma("unroll") for (int m = 0; m < 4; ++m) _Pragma("unroll") for (int n = 0; n < 2; ++n) _Pragma("unroll") for (int k = 0; k < 2; ++k) \
        acc[ai][bj][m][n] = __builtin_amdgcn_mfma_f32_16x16x32_bf16(Bt[n][k], At[m][k], acc[ai][bj][m][n], 0, 0, 0); __builtin_amdgcn_s_setprio(0); } while (0)
#define PG8_WAIT_V(n) asm volatile("s_waitcnt vmcnt(" #n ")" ::: "memory")
#define PG8_WAIT_L(n) asm volatile("s_waitcnt lgkmcnt(" #n ")" ::: "memory")
#define PG8_BAR __builtin_amdgcn_s_barrier()
#define PG8_SCHED __builtin_amdgcn_sched_barrier(0)
    Unit cur, nxt; int ui = 0;
    if (!S.next(0, cur)) return;
    f32x4 acc[2][2][4][2];
#pragma unroll
    for (int a = 0; a < 2; ++a)
#pragma unroll
        for (int b = 0; b < 2; ++b)
#pragma unroll
            for (int m = 0; m < 4; ++m)
#pragma unroll
                for (int n = 0; n < 2; ++n) acc[a][b][m][n] = (f32x4){0.f, 0.f, 0.f, 0.f};
    bf16x8 At[4][2], B0[2][2], B1[2][2];
    const char* cA = (const char*)g.A + (size_t)cur.pm * tA + (size_t)cur.pn * pnA; const char* cB = (const char*)g.Bt + (size_t)cur.pn * tB;
    S.a_ready(cur);
    if constexpr (SP2) {
        PG8_STAGE(PG8_SB(0, 0), cB, voffB); PG8_STAGE(PG8_SB(0, 1), cB + hB, voffB); PG8_STAGE(PG8_SA(0, 0), cA, voffA); PG8_STAGE(PG8_SA(0, 1), cA + hA, voffA);
        if (wr == 1) PG8_BAR;
        PG8_WAIT_V(2); PG8_BAR;
        PG8_STAGE(PG8_SB(1, 0), cB + kstep, voffB); PG8_STAGE(PG8_SA(1, 0), cA + kstep, voffA); PG8_STAGE(PG8_SB(1, 1), cB + hB + kstep, voffB);
        PG8_WAIT_V(6); PG8_BAR;
    } else {
        PG8_STAGE(PG8_SB(0, 0), cB, voffB); PG8_STAGE(PG8_SA(0, 0), cA, voffA); PG8_STAGE(PG8_SB(0, 1), cB + hB, voffB); PG8_STAGE(PG8_SA(0, 1), cA + hA, voffA);
        if (wr == 1) PG8_BAR;
        PG8_WAIT_V(4); PG8_BAR;
        PG8_STAGE(PG8_SB(1, 0), cB + kstep, voffB); PG8_STAGE(PG8_SA(1, 0), cA + kstep, voffA); PG8_STAGE(PG8_SB(1, 1), cB + hB + kstep, voffB);
        PG8_WAIT_V(6); PG8_BAR;
    }
    for (;;) {
        const bool has_next = S.next(ui + 1, nxt);
        const char* nA = has_next ? (const char*)g.A + (size_t)nxt.pm * tA + (size_t)nxt.pn * pnA : cA; const char* nB = has_next ? (const char*)g.Bt + (size_t)nxt.pn * tB : cB;
#pragma unroll 1
        for (int t = 0; t < nt; t += 2) {
            const bool last = (t == nt - 2);
            const char* a1 = cA + (size_t)(t + 1) * kstep;
            const char* a2 = last ? nA : cA + (size_t)(t + 2) * kstep; const char* b2 = last ? nB : cB + (size_t)(t + 2) * kstep;
            const char* a3 = a2 + kstep; const char* b3 = b2 + kstep;
            if (last && has_next) S.a_ready(nxt);
            if constexpr (SP2) {
            PG8_LDB(B0, 0, 0); PG8_LDB(B1, 0, 1); PG8_SCHED; PG8_LDA(At, 0, 0); PG8_STAGE(PG8_SA(1, 1), a1 + hA, voffA);
            PG8_WAIT_V(8); PG8_WAIT_L(0); PG8_BAR; PG8_MMA(0, 0, At, B0); PG8_MMA(0, 1, At, B1); PG8_BAR; PG8_SCHED;
            PG8_LDA(At, 0, 1); PG8_STAGE(PG8_SB(0, 0), b2, voffB); PG8_STAGE(PG8_SB(0, 1), b2 + hB, voffB); PG8_STAGE(PG8_SA(0, 0), a2, voffA);
            PG8_WAIT_V(8); PG8_WAIT_L(0); PG8_BAR; PG8_MMA(1, 0, At, B0); PG8_MMA(1, 1, At, B1); PG8_BAR; PG8_SCHED;
            PG8_LDB(B0, 1, 0); PG8_LDB(B1, 1, 1); PG8_SCHED; PG8_LDA(At, 1, 0); PG8_STAGE(PG8_SA(0, 1), a2 + hA, voffA);
            PG8_WAIT_V(8); PG8_WAIT_L(0); PG8_BAR; PG8_MMA(0, 0, At, B0); PG8_MMA(0, 1, At, B1); PG8_BAR; PG8_SCHED;
            PG8_LDA(At, 1, 1); PG8_STAGE(PG8_SB(1, 0), b3, voffB); PG8_STAGE(PG8_SB(1, 1), b3 + hB, voffB); PG8_STAGE(PG8_SA(1, 0), a3, voffA);
            PG8_WAIT_V(8); PG8_WAIT_L(0); PG8_BAR; PG8_MMA(1, 0, At, B0); PG8_MMA(1, 1, At, B1); PG8_BAR; PG8_SCHED;
            } else {
            PG8_LDB(B0, 0, 0); PG8_SCHED; PG8_LDA(At, 0, 0); PG8_STAGE(PG8_SA(1, 1), a1 + hA, voffA);
            PG8_WAIT_L(8); PG8_BAR; PG8_WAIT_L(0); PG8_MMA(0, 0, At, B0); PG8_BAR; PG8_SCHED;
            PG8_LDB(B1, 0, 1); PG8_STAGE(PG8_SB(0, 0), b2, voffB);
            PG8_BAR; PG8_WAIT_L(0); PG8_MMA(0, 1, At, B1); PG8_BAR;
            PG8_LDA(At, 0, 1); PG8_STAGE(PG8_SA(0, 0), a2, voffA);
            PG8_BAR; PG8_WAIT_L(0); PG8_MMA(1, 0, At, B0); PG8_BAR; PG8_SCHED;
            PG8_STAGE(PG8_SB(0, 1), b2 + hB, voffB);
            PG8_WAIT_V(6); PG8_BAR; PG8_MMA(1, 1, At, B1); PG8_BAR;
            PG8_LDB(B0, 1, 0); PG8_SCHED; PG8_LDA(At, 1, 0); PG8_STAGE(PG8_SA(0, 1), a2 + hA, voffA);
            PG8_WAIT_L(8); PG8_BAR; PG8_WAIT_L(0); PG8_MMA(0, 0, At, B0); PG8_BAR; PG8_SCHED;
            PG8_LDB(B1, 1, 1); PG8_STAGE(PG8_SB(1, 0), b3, voffB);
            PG8_BAR; PG8_WAIT_L(0); PG8_MMA(0, 1, At, B1); PG8_BAR;
            PG8_LDA(At, 1, 1); PG8_STAGE(PG8_SA(1, 0), a3, voffA);
            PG8_BAR; PG8_WAIT_L(0); PG8_MMA(1, 0, At, B0); PG8_BAR; PG8_SCHED;
            PG8_STAGE(PG8_SB(1, 1), b3 + hB, voffB);
            PG8_WAIT_V(6); PG8_BAR; PG8_MMA(1, 1, At, B1); PG8_BAR;
            }
        }
        if constexpr (ALIGN_EPI) { if (wr == 0) PG8_BAR; }
        if constexpr (!Epi::AFTER_DRAIN) { E(acc, cur, wr, wc, fr, fq); S.done(cur); }
        if (!has_next) break;
#pragma unroll
        for (int a = 0; a < 2; ++a)
#pragma unroll
            for (int b = 0; b < 2; ++b)
#pragma unroll
                for (int m = 0; m < 4; ++m)
#pragma unroll
                    for (int n = 0; n < 2; ++n) acc[a][b][m][n] = (f32x4){0.f, 0.f, 0.f, 0.f};
        cur = nxt; cA = nA; cB = nB; ++ui;
        if constexpr (ALIGN_EPI) { if (wr == 1) PG8_BAR; }
    }
    PG8_WAIT_V(0);
    if constexpr (!ALIGN_EPI) { if (wr == 0) PG8_BAR; }
    PG8_BAR;
    if constexpr (Epi::AFTER_DRAIN) { E.fused(acc, cur, wr, wc, fr, fq, lds, wid, lane); S.done(cur); }
#undef PG8_SA
#undef PG8_SB
#undef PG8_STAGE
#undef PG8_LDA
#undef PG8_LDB
#undef PG8_MMA
#undef PG8_WAIT_V
#undef PG8_WAIT_L
#undef PG8_BAR
#undef PG8_SCHED
}
}
#include <hip/hip_bf16.h>
#include <cmath>
namespace attn_body {
using bf16=__hip_bfloat16;
using bf16x8=__attribute__((ext_vector_type(8)))short;
using s16x4=__attribute__((ext_vector_type(4)))short;
using f32x16=__attribute__((ext_vector_type(16)))float;
using u32x4=__attribute__((ext_vector_type(4)))unsigned;
constexpr int D=64,DM=1024,KVP=256;
constexpr int NW=8,QBLK=32,QB=QBLK*NW,KVBLK=64;
constexpr int ATTN_PITCH=DM, ATTN_UNIT_ROWS=QB;
__device__ __forceinline__ int crow(int r,int hi){return (r&3)+8*(r>>2)+4*hi;}
#define SBAR() __builtin_amdgcn_sched_barrier(0)
__device__ __forceinline__ void cmask(f32x16&p0,f32x16&p1,int jb,int qrel,int hi){
  const float NEG=-INFINITY; int kb=64*jb+4*hi;
  #pragma unroll
  for(int r=0;r<16;++r){int kv=kb+(r&3)+8*(r>>2); if(kv>qrel)p0[r]=NEG; if(kv+32>qrel)p1[r]=NEG;}
}

constexpr int NSLOT=3, SLOTB=8192;
constexpr int LDS_K=0, LDS_V=NSLOT*SLOTB, LDS_WS=2*NSLOT*SLOTB, LDS_OST=LDS_WS+NW*64*4, LDS_BYTES=LDS_OST+NW*4096;
constexpr float C2=0.125f*1.4426950408889634f;
__device__ __forceinline__ void glds16(const void*gsrc,unsigned lds_dst){unsigned keep;
  asm volatile("s_mov_b32 %0, m0\n\ts_mov_b32 m0, %2\n\ts_nop 0\n\tglobal_load_lds_dwordx4 %1, off\n\ts_mov_b32 m0, %0":"=&s"(keep):"v"(gsrc),"s"(lds_dst):"memory");}
__device__ __forceinline__ float max3f(float a,float b,float c){float r;asm("v_max3_f32 %0, %1, %2, %3":"=v"(r):"v"(a),"v"(b),"v"(c));return r;}
__device__ __forceinline__ float max2f(float a,float b){float r;asm("v_max_f32_e32 %0, %1, %2":"=v"(r):"v"(a),"v"(b));return r;}
__device__ __forceinline__ float fadd_s(float a,float b){float r;asm("v_add_f32_e32 %0, %1, %2":"=v"(r):"v"(a),"v"(b));return r;}
__device__ __forceinline__ float fsub_s(float a,float b){float r;asm("v_sub_f32_e32 %0, %1, %2":"=v"(r):"v"(a),"v"(b));return r;}
typedef float f32x2_t __attribute__((ext_vector_type(2))); typedef __bf16 bf16x2_t __attribute__((ext_vector_type(2)));
__device__ __forceinline__ unsigned cvtpk_s(float lo,float hi){f32x2_t v={lo,hi};bf16x2_t b=__builtin_convertvector(v,bf16x2_t);return __builtin_bit_cast(unsigned,b);}
#define WAIT_BAR(N) asm volatile("s_waitcnt vmcnt(" #N ") lgkmcnt(0)\n\ts_barrier":::"memory")

__device__ __forceinline__ void qkt(f32x16&p0,f32x16&p1,const char*Kslot,const bf16x8*qr,const f32x16&negm,int r32,int hi){
  const char*kb=Kslot+hi*1024+r32*16;
  #pragma unroll
  for(int d0=0;d0<4;++d0){
    const bf16x8 b0=*reinterpret_cast<const bf16x8*>(kb+d0*2048);
    const bf16x8 b1=*reinterpret_cast<const bf16x8*>(kb+d0*2048+512);
    if(d0==0){p0=__builtin_amdgcn_mfma_f32_32x32x16_bf16(b0,qr[0],negm,0,0,0);p1=__builtin_amdgcn_mfma_f32_32x32x16_bf16(b1,qr[0],negm,0,0,0);}
    else{p0=__builtin_amdgcn_mfma_f32_32x32x16_bf16(b0,qr[d0],p0,0,0,0);p1=__builtin_amdgcn_mfma_f32_32x32x16_bf16(b1,qr[d0],p1,0,0,0);}}
}
typedef __attribute__((address_space(3))) const char* lds_cptr;
typedef short v4i16_t __attribute__((ext_vector_type(4)));
__device__ __forceinline__ void kload8(bf16x8*kf,lds_cptr kp){
  kf[0]=*(const __attribute__((address_space(3))) bf16x8*)(kp);      kf[1]=*(const __attribute__((address_space(3))) bf16x8*)(kp+512);
  kf[2]=*(const __attribute__((address_space(3))) bf16x8*)(kp+2048); kf[3]=*(const __attribute__((address_space(3))) bf16x8*)(kp+2560);
  kf[4]=*(const __attribute__((address_space(3))) bf16x8*)(kp+4096); kf[5]=*(const __attribute__((address_space(3))) bf16x8*)(kp+4608);
  kf[6]=*(const __attribute__((address_space(3))) bf16x8*)(kp+6144); kf[7]=*(const __attribute__((address_space(3))) bf16x8*)(kp+6656);
}
__device__ __forceinline__ void kload2(bf16x8*kf,lds_cptr kp,int j){ kf[2*j]=*(const __attribute__((address_space(3))) bf16x8*)(kp+j*2048); kf[2*j+1]=*(const __attribute__((address_space(3))) bf16x8*)(kp+j*2048+512); }
__device__ __forceinline__ s16x4 vtr(lds_cptr p){ return __builtin_bit_cast(s16x4,__builtin_amdgcn_ds_read_tr16_b64_v4i16((__attribute__((address_space(3))) v4i16_t*)p)); }
__device__ __forceinline__ float rowmax(const f32x16&p0,const f32x16&p1){
  float a=max3f(p0[0],p0[1],p1[0]),b=max3f(p0[2],p0[3],p1[1]);a=max3f(a,p1[2],p1[3]);
  #pragma unroll
  for(int r=4;r<16;r+=4){a=max3f(a,p0[r],p0[r+1]);b=max3f(b,p0[r+2],p0[r+3]);a=max3f(a,p1[r],p1[r+1]);b=max3f(b,p1[r+2],p1[r+3]);}
  const float m=max2f(a,b);
  auto rr=__builtin_amdgcn_permlane32_swap(__float_as_uint(m),__float_as_uint(m),false,false);
  return max2f(__uint_as_float(rr[0]),__uint_as_float(rr[1]));
}
__device__ __forceinline__ void pv(f32x16*o,int vb,bf16x8 pa0,bf16x8 pa1,bf16x8 pa2,bf16x8 pa3){
  #pragma unroll
  for(int d0=0;d0<2;++d0){s16x4 lo[4],hi[4];
    #pragma unroll
    for(int ks=0;ks<4;++ks){
      asm volatile("ds_read_b64_tr_b16 %0,%1 offset:%c2":"=&v"(lo[ks]):"v"(vb),"i"(d0*4096+ks*1024):"memory");
      asm volatile("ds_read_b64_tr_b16 %0,%1 offset:%c2":"=&v"(hi[ks]):"v"(vb),"i"(d0*4096+ks*1024+512):"memory");}
    asm volatile("s_waitcnt lgkmcnt(0)":::"memory");SBAR();
    #define PK(k) (bf16x8){lo[k][0],lo[k][1],lo[k][2],lo[k][3],hi[k][0],hi[k][1],hi[k][2],hi[k][3]}
    o[d0]=__builtin_amdgcn_mfma_f32_32x32x16_bf16(pa0,PK(0),o[d0],0,0,0);
    o[d0]=__builtin_amdgcn_mfma_f32_32x32x16_bf16(pa1,PK(1),o[d0],0,0,0);
    o[d0]=__builtin_amdgcn_mfma_f32_32x32x16_bf16(pa2,PK(2),o[d0],0,0,0);
    o[d0]=__builtin_amdgcn_mfma_f32_32x32x16_bf16(pa3,PK(3),o[d0],0,0,0);
    #undef PK
  }
}

#ifndef ATTN_STORE16
#define ATTN_STORE16(p,v) (*(u32x4*)(p)=(v))
#endif
template<int THRL> __device__ __forceinline__ void attn_unit(long qrow0,long kvrow0,const int NT,int h,const bf16*Q,const bf16*__restrict__ K,const bf16*__restrict__ V,bf16*O,char*shm){
  int tid_=threadIdx.x; asm volatile("":"+v"(tid_)); const int tid=tid_,lane=tid&63,r32=lane&31,hi=lane>>5; const int wid=__builtin_amdgcn_readfirstlane(tid>>6);
  const int g=h>>2;
  const bf16*Qw=Q+(qrow0+wid*QBLK)*DM+h*D;
  const bf16*Kh=K+kvrow0*KVP+g*D,*Vh=V+kvrow0*KVP+g*D;
  const unsigned lds0=(unsigned)(uintptr_t)shm;
  float*wsf=(float*)(shm+LDS_WS)+wid*64;
  const bf16*ksrc=Kh+(long)lane*KVP+wid*8;
  const bf16*vsrc=Vh+(long)(16*(wid&3)+(lane>>2))*KVP+(wid>>2)*32+(lane&3)*8;
  const unsigned kdst=lds0+LDS_K+wid*1024, vdst=lds0+LDS_V+wid*1024;
  #define DMA_K(t,slot) glds16(ksrc+(long)(t)*KVBLK*KVP,(unsigned)__builtin_amdgcn_readfirstlane(kdst+(slot)))
  #define DMA_V(t,slot) glds16(vsrc+(long)(t)*KVBLK*KVP,(unsigned)__builtin_amdgcn_readfirstlane(vdst+(slot)))
  const int vb0=(int)(lds0+LDS_V)+((lane>>4)&1)*32+(lane&3)*8+(4*hi+((lane&15)>>2))*64;
  const char*Kbase=shm+LDS_K; bf16x8 kf[8];
  const lds_cptr shm3=(lds_cptr)shm; const lds_cptr kp0=shm3+LDS_K+hi*1024+r32*16; const lds_cptr vp0=shm3+LDS_V+((lane>>4)&1)*32+(lane&3)*8+(4*hi+((lane&15)>>2))*64;
  DMA_K(0,0);DMA_V(0,0);DMA_K(1,SLOTB);
  bf16x8 qr[4];
  #pragma unroll
  for(int d0=0;d0<4;++d0)qr[d0]=*reinterpret_cast<const bf16x8*>(&Qw[(long)r32*DM+d0*16+hi*8]);
  float mhat=0.f,l_reg=0.f;f32x16 o[2];o[0]=f32x16{};o[1]=f32x16{};f32x16 negm=f32x16{};asm volatile("":"+v"(negm));
  const int qrel=wid*QBLK+r32;
  #define CMASK(P0,P1,t) do{}while(0)
  bool resc=false;
  #define START(P0,P1) do{ const float rm=rowmax(P0,P1); resc=false; \
    { const float dl=rm; mhat=fadd_s(mhat,dl); \
      _Pragma("unroll") for(int r=0;r<16;++r){P0[r]=fsub_s(P0[r],dl);P1[r]=fsub_s(P1[r],dl);} \
      _Pragma("unroll") for(int r=0;r<16;++r)negm[r]=-mhat; asm volatile("":"+v"(negm)); } \
    _Pragma("unroll") for(int r=0;r<16;++r)P0[r]=__builtin_amdgcn_exp2f(P0[r]); }while(0)
  #define RESC() do{ if(resc){ asm volatile("s_waitcnt lgkmcnt(0)":::"memory"); \
      _Pragma("unroll") for(int d_=0;d_<2;++d_) _Pragma("unroll") for(int r=0;r<16;++r)o[d_][r]*=wsf[crow(r,hi)]; } }while(0)
  f32x16 pA0,pA1,pB0,pB1;
  int sl_prev=0,sl_cur=0,sl_next=SLOTB;
  #define ROT() do{sl_prev=sl_cur;sl_cur=sl_next;sl_next=(sl_next==(NSLOT-1)*SLOTB)?0:sl_next+SLOTB;}while(0)
  DMA_K(2,2*SLOTB);
  WAIT_BAR(3);
  qkt(pA0,pA1,Kbase,qr,negm,r32,hi);asm volatile("s_nop 15\n\ts_nop 7":"+v"(pA0),"+v"(pA1));CMASK(pA0,pA1,0);
  START(pA0,pA1);
  _Pragma("unroll") for(int r=0;r<16;++r)pA1[r]=__builtin_amdgcn_exp2f(pA1[r]);
  WAIT_BAR(0);
  DMA_K(3,0);DMA_V(1,SLOTB);
  ROT();
  kload8(kf,kp0+sl_cur);
  WAIT_BAR(2);
  s16x4 vlo[8],vhi[8]; u32x4 pw0,pw1,pw2,pw3;
  #define PKW(P,B) cvtpk_s(P[B],P[B+1])
  #define PAF(k) __builtin_bit_cast(bf16x8,pw##k)
  #define VFR(i) (bf16x8){vlo[i][0],vlo[i][1],vlo[i][2],vlo[i][3],vhi[i][0],vhi[i][1],vhi[i][2],vhi[i][3]}
  #define PIN(x) asm volatile("":"+v"(x))
  #define MX3(a,b,c) __builtin_fmaxf(__builtin_fmaxf((a),(b)),(c))
  #define GAPA(MF,A0,A1,A2,A3,W0,W1,PW) do{ MF; sacc+=A0; sacc+=A1; sacc+=A2; sacc+=A3; PIN(sacc); W0; W1; PIN(PW); SBAR(); }while(0)
  #define EX(v) __builtin_amdgcn_exp2f(v)
  #define GAPB(MF,X,B) do{ MF; X[B]=EX(X[B]); X[B+1]=EX(X[B+1]); X[B+2]=EX(X[B+2]); X[B+3]=EX(X[B+3]); PIN(X); SBAR(); }while(0)
  #define VRD(i) do{ vlo[i]=vtr(vp_+(((i)>>2)*4096+((i)&3)*1024)); vhi[i]=vtr(vp_+(((i)>>2)*4096+((i)&3)*1024+512)); }while(0)
  #define KRD(G,j) do{ if(G){ kload2(kf,kp0+sl_next,j); SBAR(); } }while(0)
  #define STEP(C0,C1,P0,P1,t,GK,GV,GL) do{ SBAR(); \
    const lds_cptr vp_=vp0+sl_prev; \
    VRD(0); SBAR(); float sacc=(P0[0]+P0[1]); \
    GAPA(C0=__builtin_amdgcn_mfma_f32_32x32x16_bf16(kf[0],qr[0],negm,0,0,0), P0[2],P0[3],P0[4],P0[5],     pw0[0]=PKW(P0,0), pw0[1]=PKW(P0,2), pw0); \
    VRD(4); SBAR(); GAPA(C1=__builtin_amdgcn_mfma_f32_32x32x16_bf16(kf[1],qr[0],negm,0,0,0), P0[6],P0[7],P0[8],P0[9],     pw0[2]=PKW(P0,4), pw0[3]=PKW(P0,6), pw0); \
    VRD(1); SBAR(); GAPA(C0=__builtin_amdgcn_mfma_f32_32x32x16_bf16(kf[2],qr[1],C0,0,0,0),   P0[10],P0[11],P0[12],P0[13], pw1[0]=PKW(P0,8), pw1[1]=PKW(P0,10), pw1); \
    VRD(5); SBAR(); GAPA(C1=__builtin_amdgcn_mfma_f32_32x32x16_bf16(kf[3],qr[1],C1,0,0,0),   P0[14],P0[15],P1[0],P1[1],   pw1[2]=PKW(P0,12),pw1[3]=PKW(P0,14), pw1); \
    VRD(2); SBAR(); GAPA(C0=__builtin_amdgcn_mfma_f32_32x32x16_bf16(kf[4],qr[2],C0,0,0,0),   P1[2],P1[3],P1[4],P1[5],     pw2[0]=PKW(P1,0), pw2[1]=PKW(P1,2), pw2); \
    VRD(6); SBAR(); GAPA(C1=__builtin_amdgcn_mfma_f32_32x32x16_bf16(kf[5],qr[2],C1,0,0,0),   P1[6],P1[7],P1[8],P1[9],     pw2[2]=PKW(P1,4), pw2[3]=PKW(P1,6), pw2); \
    VRD(3); SBAR(); GAPA(C0=__builtin_amdgcn_mfma_f32_32x32x16_bf16(kf[6],qr[3],C0,0,0,0),   P1[10],P1[11],P1[12],P1[13], pw3[0]=PKW(P1,8), pw3[1]=PKW(P1,10), pw3); \
    VRD(7); SBAR(); GAPA(C1=__builtin_amdgcn_mfma_f32_32x32x16_bf16(kf[7],qr[3],C1,0,0,0),   P1[14],P1[15],0.f,0.f,       pw3[2]=PKW(P1,12),pw3[3]=PKW(P1,14), pw3); \
    l_reg+=sacc; \
    if(GK){DMA_K((t)+3,sl_cur);} if(GV){DMA_V((t)+1,sl_next);} \
    CMASK(C0,C1,t); \
    { float a=MX3(C0[0],C0[1],C1[0]),b=MX3(C0[2],C0[3],C1[1]); a=MX3(a,C1[2],C1[3]); \
      _Pragma("unroll") for(int r=4;r<16;r+=4){a=MX3(a,C0[r],C0[r+1]);b=MX3(b,C0[r+2],C0[r+3]);a=MX3(a,C1[r],C1[r+1]);b=MX3(b,C1[r+2],C1[r+3]);} \
      float rm=__builtin_fmaxf(a,b); { auto rr=__builtin_amdgcn_permlane32_swap(__float_as_uint(rm),__float_as_uint(rm),false,false); rm=__builtin_fmaxf(__uint_as_float(rr[0]),__uint_as_float(rr[1])); } \
      resc=false; \
      if(__builtin_expect(__any(rm>(float)THRL),0)){ const float dl=__builtin_fmaxf(rm,0.f); mhat+=dl; \
        _Pragma("unroll") for(int r=0;r<16;++r){C0[r]-=dl;C1[r]-=dl;} \
        _Pragma("unroll") for(int r=0;r<16;++r)negm[r]=-mhat; asm volatile("":"+v"(negm)); \
        const float f=__builtin_amdgcn_exp2f(-dl); l_reg*=f; if(hi==0)wsf[r32]=f; resc=true; } } \
    SBAR(); \
    GAPB(o[0]=__builtin_amdgcn_mfma_f32_32x32x16_bf16(PAF(0),VFR(0),o[0],0,0,0), C0,0); \
    GAPB(o[1]=__builtin_amdgcn_mfma_f32_32x32x16_bf16(PAF(0),VFR(4),o[1],0,0,0), C0,4); \
    KRD(GL,0); GAPB(o[0]=__builtin_amdgcn_mfma_f32_32x32x16_bf16(PAF(1),VFR(1),o[0],0,0,0), C0,8); \
    KRD(GL,1); GAPB(o[1]=__builtin_amdgcn_mfma_f32_32x32x16_bf16(PAF(1),VFR(5),o[1],0,0,0), C0,12); \
    KRD(GL,2); GAPB(o[0]=__builtin_amdgcn_mfma_f32_32x32x16_bf16(PAF(2),VFR(2),o[0],0,0,0), C1,0); \
    KRD(GL,3); GAPB(o[1]=__builtin_amdgcn_mfma_f32_32x32x16_bf16(PAF(2),VFR(6),o[1],0,0,0), C1,4); \
    GAPB(o[0]=__builtin_amdgcn_mfma_f32_32x32x16_bf16(PAF(3),VFR(3),o[0],0,0,0), C1,8); \
    GAPB(o[1]=__builtin_amdgcn_mfma_f32_32x32x16_bf16(PAF(3),VFR(7),o[1],0,0,0), C1,12); \
    }while(0)
  int t=1;
  #undef CMASK
  #define CMASK(P0,P1,t) do{}while(0)
  for(;t+5<NT;t+=2){
    STEP(pB0,pB1,pA0,pA1,t,true,true,true);     WAIT_BAR(2); RESC(); ROT();
    STEP(pA0,pA1,pB0,pB1,t+1,true,true,true);   WAIT_BAR(2); RESC(); ROT();
  }
  #undef CMASK
  #define CMASK(P0,P1,t) do{}while(0)
  #define ENDW(tt) do{ if((tt)+3<NT){WAIT_BAR(2);} else if((tt)+2<NT){WAIT_BAR(1);} else {WAIT_BAR(0);} }while(0)
  for(;t+1<NT;t+=2){
    STEP(pB0,pB1,pA0,pA1,t,(t+3<NT),(t+1<NT),(t+1<NT));       ENDW(t);   RESC(); ROT();
    STEP(pA0,pA1,pB0,pB1,t+1,(t+4<NT),(t+2<NT),(t+2<NT));     ENDW(t+1); RESC(); ROT();
  }
  STEP(pB0,pB1,pA0,pA1,NT-1,false,false,false); RESC();
  { float sacc=pB0[0]+pB0[1]; _Pragma("unroll") for(int r=2;r<16;++r)sacc+=pB0[r]; _Pragma("unroll") for(int r=0;r<16;++r)sacc+=pB1[r]; l_reg+=sacc;
    pw0=(u32x4){PKW(pB0,0),PKW(pB0,2),PKW(pB0,4),PKW(pB0,6)};pw1=(u32x4){PKW(pB0,8),PKW(pB0,10),PKW(pB0,12),PKW(pB0,14)};pw2=(u32x4){PKW(pB1,0),PKW(pB1,2),PKW(pB1,4),PKW(pB1,6)};pw3=(u32x4){PKW(pB1,8),PKW(pB1,10),PKW(pB1,12),PKW(pB1,14)};
    SBAR(); pv(o,vb0+sl_cur,PAF(0),PAF(1),PAF(2),PAF(3)); }
  #undef PKW
  #undef PAF
  #undef VFR
  #undef PIN
  #undef MX3
  #undef GAPA
  #undef GAPB
  #undef EX
  #undef VRD
  #undef KRD
  #undef STEP
  #undef ENDW
  {auto rr=__builtin_amdgcn_permlane32_swap(__float_as_uint(l_reg),__float_as_uint(l_reg),false,false);l_reg=__uint_as_float(rr[0])+__uint_as_float(rr[1]);}
  if(hi==0)wsf[32+r32]=l_reg;asm volatile("s_waitcnt lgkmcnt(0)":::"memory");
  float rli[16];
  #pragma unroll
  for(int r=0;r<16;++r)rli[r]=__builtin_amdgcn_rcpf(wsf[32+crow(r,hi)]);
  bf16*Ow=O+(qrow0+wid*QBLK)*DM+h*D;
  { bf16*stg=(bf16*)(shm+LDS_OST)+wid*2048;
    #pragma unroll
    for(int r=0;r<16;++r){const int orow=crow(r,hi);
      #pragma unroll
      for(int d0=0;d0<2;++d0)stg[orow*64+d0*32+r32]=__float2bfloat16(o[d0][r]*rli[r]);}
    asm volatile("s_waitcnt lgkmcnt(0)":::"memory");
    #pragma unroll
    for(int i=0;i<4;++i){const int row=i*8+(lane>>3),ch=lane&7; const u32x4 v=*(const u32x4*)(stg+row*64+ch*8); ATTN_STORE16(Ow+(long)row*DM+ch*8,v);} }
  asm volatile("s_waitcnt lgkmcnt(0)\n\ts_barrier":::"memory");
  #undef DMA_K
  #undef DMA_V
  #undef CMASK
  #undef START
  #undef RESC
  #undef ROT
}
constexpr int ATTN_LDS_BYTES=LDS_BYTES;
#undef SBAR
#undef WAIT_BAR
}
constexpr int NB = 16, SEQ = 4096, CTXL = 256, TPB = SEQ + CTXL, DM = 1024, FF = 4096, MROWS = NB * TPB;
constexpr int NMOD = 6 * DM;
constexpr int NWAVES = 8;
constexpr int LDS_BYTES = 147456;
constexpr float RMS_EPS = 1e-6f, GN_EPS_F = 64.0f * 1e-5f;
constexpr float QSCALE = 0.125f * 1.4426950408889634f;

#define LAS __attribute__((address_space(3)))
typedef unsigned short bf16;
typedef float f32x4 __attribute__((ext_vector_type(4)));
typedef float f32x2 __attribute__((ext_vector_type(2)));
typedef unsigned u32x4 __attribute__((ext_vector_type(4)));
typedef unsigned u32x2 __attribute__((ext_vector_type(2)));
typedef short bf16x8 __attribute__((ext_vector_type(8)));
using pg8::Unit; using pg8::cvt_pk_bf16;
constexpr int HALF = 128, BM = 256;

constexpr size_t MiB = 1u << 20;
constexpr size_t WS_MODP = 1 * MiB, WS_MOD = 8 * MiB, WS_ROPE = 10 * MiB, WS_BONUS = 12 * MiB, WS_CTX = 22 * MiB, WS_W = 38 * MiB, WS_ACT = 130 * MiB, WS_NEED = 1024 * MiB;
constexpr size_t W_QKV = 0, W_WO = 6 * MiB, W_IN = 10 * MiB, W_OUT = 42 * MiB, W_R1 = 74 * MiB, W_G2 = 88 * MiB, W_RWO = 89 * MiB, W_POOL = 91 * MiB;
constexpr size_t ACT1 = 136 * MiB;

__device__ __forceinline__ float bflo(unsigned u) { return __uint_as_float(u << 16); }
__device__ __forceinline__ float bfhi(unsigned u) { return __uint_as_float(u & 0xffff0000u); }
__device__ __forceinline__ float bf2f(unsigned short u) { return __uint_as_float(((unsigned)u) << 16); }
__device__ __forceinline__ float fsigmoid(float x) { return __builtin_amdgcn_rcpf(1.0f + __builtin_amdgcn_exp2f(-1.4426950408889634f * x)); }
__device__ __forceinline__ u32x4 pack8(f32x4 a, f32x4 b) { u32x4 w; w.x = cvt_pk_bf16(a[0], a[1]); w.y = cvt_pk_bf16(a[2], a[3]); w.z = cvt_pk_bf16(b[0], b[1]); w.w = cvt_pk_bf16(b[2], b[3]); return w; }
__device__ __forceinline__ void unpack8(u32x4 w, f32x4& a, f32x4& b) { a = (f32x4){bflo(w.x), bfhi(w.x), bflo(w.y), bfhi(w.y)}; b = (f32x4){bflo(w.z), bfhi(w.z), bflo(w.w), bfhi(w.w)}; }
__device__ __forceinline__ float wave_sum(float v) {
#pragma unroll
    for (int o = 1; o < 64; o <<= 1) v += __shfl_xor(v, o);
    return v;
}


struct EpiRelu2 {
    static constexpr bool PERM = true, AFTER_DRAIN = false;
    bf16* O; int ldc;
    __device__ __forceinline__ void operator()(const f32x4 (&acc)[2][2][4][2], const Unit& u, int wr_, int wc_, int fr_, int fq_) const {
        int wr = wr_, wc = wc_, fr = fr_, fq = fq_; asm volatile("" : "+s"(wr), "+s"(wc), "+v"(fr), "+v"(fq));
        const int row0 = u.pm * BM + wr * 64 + fr, col0 = u.pn * BM + wc * 32 + 8 * fq;
        const f32x4 z = (f32x4){0.f, 0.f, 0.f, 0.f};
#pragma unroll
        for (int ai = 0; ai < 2; ++ai)
#pragma unroll
            for (int m = 0; m < 4; ++m) { bf16* rowp = O + (size_t)(row0 + ai * HALF + m * 16) * ldc + col0;
#pragma unroll
                for (int bj = 0; bj < 2; ++bj) { f32x4 v0 = __builtin_elementwise_max(acc[ai][bj][m][0], z), v1 = __builtin_elementwise_max(acc[ai][bj][m][1], z);
                    *(u32x4*)(rowp + bj * HALF) = pack8(v0 * v0, v1 * v1); } }
    }
};

struct EpiResid {
    static constexpr bool PERM = false, AFTER_DRAIN = false;
    const float* srcL; const float* srcC; float* dstL; float* dstC; const float* mod; int slot; const float* colscale;
    __device__ __forceinline__ void operator()(const f32x4 (&acc)[2][2][4][2], const Unit& u, int wr_, int wc_, int fr_, int fq_) const {
        int wr = wr_, wc = wc_, fr = fr_, fq = fq_; asm volatile("" : "+s"(wr), "+s"(wc), "+v"(fr), "+v"(fq));
        const int b = u.pm / 17, tt = u.pm - b * 17; const bool ctx = (tt == 16);
        const size_t tb = ctx ? (size_t)b * CTXL * DM : ((size_t)b * SEQ + (size_t)tt * 256) * DM;
        const float* s = (ctx ? srcC : srcL) + tb; float* d = (ctx ? dstC : dstL) + tb;
        const int col0 = u.pn * BM + wc * 32 + 4 * fq;
        const float* gate = mod + (size_t)(ctx ? 16 : b) * NMOD + slot * DM + col0;
        f32x4 gv[2][2];
#pragma unroll
        for (int bj = 0; bj < 2; ++bj)
#pragma unroll
            for (int n = 0; n < 2; ++n) { gv[bj][n] = *(const f32x4*)(gate + bj * HALF + n * 16); if (colscale) gv[bj][n] = gv[bj][n] * *(const f32x4*)(colscale + col0 + bj * HALF + n * 16); }
#pragma unroll
        for (int ai = 0; ai < 2; ++ai)
#pragma unroll
            for (int m = 0; m < 4; ++m) { const size_t off = (size_t)(ai * HALF + wr * 64 + m * 16 + fr) * DM + col0;
#pragma unroll
                for (int bj = 0; bj < 2; ++bj)
#pragma unroll
                    for (int n = 0; n < 2; ++n) { const f32x4 bs = *(const f32x4*)(s + off + bj * HALF + n * 16); *(f32x4*)(d + off + bj * HALF + n * 16) = bs + gv[bj][n] * acc[ai][bj][m][n]; }
                if (m & 1) asm volatile("" ::: "memory"); }
    }
};

struct EpiQKV {
    static constexpr bool PERM = true, AFTER_DRAIN = false;
    bf16* Q; bf16* Kb; bf16* Vb; const float* qg; const float* kg; const float* rope;
    __device__ __forceinline__ void operator()(const f32x4 (&acc)[2][2][4][2], const Unit& u, int wr_, int wc_, int fr_, int fq_) const {
        int wr = wr_, wc = wc_, fr = fr_, fq = fq_; asm volatile("" : "+s"(wr), "+s"(wc), "+v"(fr), "+v"(fq));
        const int tt = u.pm % 17; const int row0 = u.pm * BM + wr * 64 + fr;
        if (u.pn == 5) {
#pragma unroll
            for (int ai = 0; ai < 2; ++ai)
#pragma unroll
                for (int m = 0; m < 4; ++m) { bf16* rp = Vb + (size_t)(row0 + ai * HALF + m * 16) * 256 + wc * 64 + 8 * fq;
#pragma unroll
                    for (int bj = 0; bj < 2; ++bj) *(u32x4*)(rp + 32 * bj) = pack8(acc[ai][bj][m][0], acc[ai][bj][m][1]); }
            return;
        }
        const bool isq = u.pn < 4; const float* gain = isq ? qg : kg; const float osc = isq ? QSCALE : 1.0f;
        f32x4 g[2][2];
#pragma unroll
        for (int bj = 0; bj < 2; ++bj)
#pragma unroll
            for (int n = 0; n < 2; ++n) g[bj][n] = *(const f32x4*)(gain + 32 * bj + 8 * fq + 4 * n) * osc;
#pragma unroll
        for (int ai = 0; ai < 2; ++ai)
#pragma unroll
            for (int m = 0; m < 4; ++m) {
                float ss = 0.f;
#pragma unroll
                for (int bj = 0; bj < 2; ++bj)
#pragma unroll
                    for (int n = 0; n < 2; ++n) { const f32x4 x = acc[ai][bj][m][n]; ss += (x[0] * x[0] + x[1] * x[1]) + (x[2] * x[2] + x[3] * x[3]); }
                ss += __shfl_xor(ss, 16); ss += __shfl_xor(ss, 32);
                const float rinv = __builtin_amdgcn_rsqf(ss * (1.0f / 64.0f) + RMS_EPS);
                const int rl = ai * HALF + wr * 64 + m * 16 + fr;
                const int t = tt * 256 + rl;
                const float* rp = rope + (size_t)t * 64 + 8 * fq;
                f32x4 o1[2], o2[2];
#pragma unroll
                for (int n = 0; n < 2; ++n) { const f32x4 c = *(const f32x4*)(rp + 4 * n), s = *(const f32x4*)(rp + 32 + 4 * n);
                    const f32x4 x1 = acc[ai][0][m][n] * rinv * g[0][n], x2 = acc[ai][1][m][n] * rinv * g[1][n];
                    o1[n] = x1 * c - x2 * s; o2[n] = x1 * s + x2 * c; }
                const size_t grow = (size_t)(u.pm * BM + rl);
                bf16* dst = isq ? Q + grow * DM + (u.pn * 4 + wc) * 64 + 8 * fq : Kb + grow * 256 + wc * 64 + 8 * fq;
                *(u32x4*)(dst) = pack8(o1[0], o1[1]); *(u32x4*)(dst + 32) = pack8(o2[0], o2[1]);
            }
    }
};

struct EpiRwkv1 {
    static constexpr bool PERM = true, AFTER_DRAIN = false;
    bf16* RKV; size_t rkv_stride; bf16* KK; bf16* P; const float* k_k;
    __device__ __forceinline__ void operator()(const f32x4 (&acc)[2][2][4][2], const Unit& u, int wr_, int wc_, int fr_, int fq_) const {
        int wr = wr_, wc = wc_, fr = fr_, fq = fq_; asm volatile("" : "+s"(wr), "+s"(wc), "+v"(fr), "+v"(fq));
        const int row0 = u.pm * BM + wr * 64 + fr;
        if (u.pn >= 12) {
            const int ob = 256 * (u.pn - 12) + 64 * wc + 8 * fq;
#pragma unroll
            for (int ai = 0; ai < 2; ++ai)
#pragma unroll
                for (int m = 0; m < 4; ++m) { bf16* rp = P + (size_t)(row0 + ai * HALF + m * 16) * 512 + ob;
#pragma unroll
                    for (int bj = 0; bj < 2; ++bj) { const int o = ob + 32 * bj; f32x4 v0 = acc[ai][bj][m][0], v1 = acc[ai][bj][m][1];
                        if (o < 128) {
#pragma unroll
                            for (int e = 0; e < 4; ++e) { v0[e] = 2.0f * fsigmoid(2.0f * v0[e]) - 1.0f; v1[e] = 2.0f * fsigmoid(2.0f * v1[e]) - 1.0f; }
                        } else if (o < 256) {
                        } else if (o < 416) {
#pragma unroll
                            for (int e = 0; e < 4; ++e) { v0[e] = fsigmoid(v0[e]); v1[e] = fsigmoid(v1[e]); }
                        } else { v0 = (f32x4){0.f, 0.f, 0.f, 0.f}; v1 = v0; }
                        *(u32x4*)(rp + 32 * bj) = pack8(v0, v1); } }
            return;
        }
        const int sel = u.pn >> 2; const int cb = (u.pn & 3) * 256 + wc * 64 + 8 * fq;
        bf16* O = RKV + (size_t)sel * rkv_stride;
        f32x4 kkg[2][2];
        if (sel == 1) {
#pragma unroll
            for (int bj = 0; bj < 2; ++bj)
#pragma unroll
                for (int n = 0; n < 2; ++n) kkg[bj][n] = *(const f32x4*)(k_k + cb + 32 * bj + 4 * n);
        }
#pragma unroll
        for (int ai = 0; ai < 2; ++ai)
#pragma unroll
            for (int m = 0; m < 4; ++m) { const size_t ro = (size_t)(row0 + ai * HALF + m * 16) * DM + cb;
#pragma unroll
                for (int bj = 0; bj < 2; ++bj) *(u32x4*)(O + ro + 32 * bj) = pack8(acc[ai][bj][m][0], acc[ai][bj][m][1]);
                if (sel == 1) {
                    f32x4 q[2][2]; float ss = 0.f;
#pragma unroll
                    for (int bj = 0; bj < 2; ++bj)
#pragma unroll
                        for (int n = 0; n < 2; ++n) { q[bj][n] = acc[ai][bj][m][n] * kkg[bj][n]; const f32x4 x = q[bj][n]; ss += (x[0] * x[0] + x[1] * x[1]) + (x[2] * x[2] + x[3] * x[3]); }
                    ss += __shfl_xor(ss, 16); ss += __shfl_xor(ss, 32);
                    const float rn = 1.0f / fmaxf(sqrtf(ss), 1e-12f);
#pragma unroll
                    for (int bj = 0; bj < 2; ++bj) *(u32x4*)(KK + ro + 32 * bj) = pack8(q[bj][0] * rn, q[bj][1] * rn);
                }
                asm volatile("" ::: "memory"); }
    }
};

struct EpiFinish {
    static constexpr bool PERM = true, AFTER_DRAIN = false;
    const bf16* Y0; const bf16* Y1; const bf16* Vb; const float* bonus; const float* ln_g; const float* ln_b; bf16* Z;
    __device__ __forceinline__ void operator()(const f32x4 (&acc)[2][2][4][2], const Unit& u, int wr_, int wc_, int fr_, int fq_) const {
        int wr = wr_, wc = wc_, fr = fr_, fq = fq_; asm volatile("" : "+s"(wr), "+s"(wc), "+v"(fr), "+v"(fq));
        const int row0 = u.pm * BM + wr * 64 + fr; const int head = u.pn * 4 + wc; const int cb = head * 64 + 8 * fq;
#pragma unroll
        for (int ai = 0; ai < 2; ++ai)
#pragma unroll
            for (int m = 0; m < 4; ++m) { const size_t grow = (size_t)(row0 + ai * HALF + m * 16); const size_t ro = grow * DM + cb;
                float sum = 0.f, sq = 0.f;
#pragma unroll
                for (int bj = 0; bj < 2; ++bj) { f32x4 a0, a1, b0, b1; unpack8(*(const u32x4*)(Y0 + ro + 32 * bj), a0, a1); unpack8(*(const u32x4*)(Y1 + ro + 32 * bj), b0, b1);
                    a0 += b0; a1 += b1; sum += (a0[0] + a0[1]) + (a0[2] + a0[3]) + (a1[0] + a1[1]) + (a1[2] + a1[3]);
                    sq += (a0[0] * a0[0] + a0[1] * a0[1]) + (a0[2] * a0[2] + a0[3] * a0[3]) + (a1[0] * a1[0] + a1[1] * a1[1]) + (a1[2] * a1[2] + a1[3] * a1[3]); }
                sum += __shfl_xor(sum, 16); sq += __shfl_xor(sq, 16); sum += __shfl_xor(sum, 32); sq += __shfl_xor(sq, 32);
                const float mean = sum * (1.0f / 64.0f); const float var = fmaxf(sq * (1.0f / 64.0f) - mean * mean, 0.f);
                const float rstd = __builtin_amdgcn_rsqf(var + GN_EPS_F);
                const f32x2 bo = *(const f32x2*)(bonus + (grow * 16 + head) * 2); const float bsum = bo.x + bo.y;
                asm volatile("" ::: "memory");
#pragma unroll
                for (int bj = 0; bj < 2; ++bj) { f32x4 a0, a1, b0, b1, v0, v1; unpack8(*(const u32x4*)(Y0 + ro + 32 * bj), a0, a1); unpack8(*(const u32x4*)(Y1 + ro + 32 * bj), b0, b1); unpack8(*(const u32x4*)(Vb + ro + 32 * bj), v0, v1);
                    const f32x4 lg0 = *(const f32x4*)(ln_g + cb + 32 * bj), lg1 = *(const f32x4*)(ln_g + cb + 32 * bj + 4), lb0 = *(const f32x4*)(ln_b + cb + 32 * bj), lb1 = *(const f32x4*)(ln_b + cb + 32 * bj + 4);
                    const f32x4 z0 = ((a0 + b0 - mean) * rstd * lg0 + lb0 + v0 * bsum) * acc[ai][bj][m][0];
                    const f32x4 z1 = ((a1 + b1 - mean) * rstd * lg1 + lb1 + v1 * bsum) * acc[ai][bj][m][1];
                    *(u32x4*)(Z + ro + 32 * bj) = pack8(z0, z1);
                    asm volatile("" ::: "memory"); }
            }
    }
};

struct WJob { const float* src; const float* kscale; bf16* dst; int ld_src, k_src, ldt, row_off, col_base, k_off, nblk, mode; };
constexpr int NJOBS = 36;
struct Args { const float* in[32]; float* out; unsigned char* ws; WJob job[NJOBS]; int istart[NJOBS + 2]; };

struct Frame { LAS unsigned char* lds; int tid, lane, wave, vcu, G; };

__device__ __forceinline__ int perm256(int o) { return (o & ~255) | (((o >> 5) & 1) << 7) | (((o >> 6) & 3) << 5) | (o & 31); }

__device__ __forceinline__ void wconv_item(const __attribute__((address_space(4))) WJob* Jp, int item, LAS float* scr, int lane) {
    WJob J; J.src = Jp->src; J.kscale = Jp->kscale; J.dst = Jp->dst; J.ld_src = Jp->ld_src; J.k_src = Jp->k_src; J.ldt = Jp->ldt; J.row_off = Jp->row_off; J.col_base = Jp->col_base; J.k_off = Jp->k_off; J.nblk = Jp->nblk; J.mode = Jp->mode;
    const int kb = item / J.nblk, nb = item - kb * J.nblk, k0 = 64 * kb, n0 = 32 * nb;
#pragma unroll 8
    for (int i = 0; i < 32; ++i) { const int kk = 2 * i + (lane >> 5), k = k0 + kk; float v = 0.f;
        if (J.src != nullptr && k < J.k_src) { v = J.src[(size_t)k * J.ld_src + n0 + (lane & 31)]; if (J.kscale) v *= J.kscale[k]; }
        scr[kk * 33 + (lane & 31)] = v; }
    asm volatile("s_waitcnt lgkmcnt(0)" ::: "memory");
    const int c = lane & 7;
#pragma unroll
    for (int j = 0; j < 4; ++j) { const int n = (lane >> 3) + 8 * j; const LAS float* s = scr + (8 * c) * 33 + n;
        u32x4 o; o.x = cvt_pk_bf16(s[0 * 33], s[1 * 33]); o.y = cvt_pk_bf16(s[2 * 33], s[3 * 33]); o.z = cvt_pk_bf16(s[4 * 33], s[5 * 33]); o.w = cvt_pk_bf16(s[6 * 33], s[7 * 33]);
        const int oc = J.col_base + n0 + n; const int drow = J.row_off + (J.mode ? perm256(oc) : oc);
        *(u32x4*)(J.dst + (size_t)drow * J.ldt + J.k_off + k0 + 8 * c) = o; }
    asm volatile("s_waitcnt lgkmcnt(0)" ::: "memory");
}

__device__ __forceinline__ void p0a(Frame& F, const __attribute__((address_space(4))) Args* A) {
    LAS float* sl = (LAS float*)F.lds;
    const float* c = A->in[1]; const float* cc = A->in[3];
    for (int idx = F.tid; idx < 17 * DM; idx += NWAVES * 64) { const int r = idx >> 10, k = idx & 1023; const float x = r < 16 ? c[r * DM + k] : cc[k]; sl[idx] = x * fsigmoid(x); }
    __syncthreads();
    const int gw = F.vcu * NWAVES + F.wave, NGW = F.G * NWAVES;
    float* modp = (float*)(A->ws + WS_MODP);
    for (int it = gw; it < 4 * 96 * 4; it += NGW) {
        const int l = it / 384, rem = it - l * 384, cgp = rem >> 2, kq = rem & 3, col = cgp * 64 + F.lane;
        const float* w = A->in[4] + ((size_t)l * DM + kq * 256) * NMOD + col;
        float acc[17];
#pragma unroll
        for (int r = 0; r < 17; ++r) acc[r] = 0.f;
        for (int k4 = 0; k4 < 256; k4 += 4) {
            const float w0 = w[(size_t)(k4 + 0) * NMOD], w1 = w[(size_t)(k4 + 1) * NMOD], w2 = w[(size_t)(k4 + 2) * NMOD], w3 = w[(size_t)(k4 + 3) * NMOD];
#pragma unroll
            for (int r = 0; r < 17; ++r) { const f32x4 sv = *(const LAS f32x4*)(sl + r * DM + kq * 256 + k4); acc[r] += (sv[0] * w0 + sv[1] * w1) + (sv[2] * w2 + sv[3] * w3); }
        }
#pragma unroll
        for (int r = 0; r < 17; ++r) modp[((size_t)(kq * 4 + l) * 17 + r) * NMOD + col] = acc[r];
    }
    __syncthreads();
    LAS float* scr = (LAS float*)(F.lds + F.wave * 16384);
    const int total = A->istart[NJOBS];
    for (int it = gw; it < total; it += NGW) {
        int j = 0;
        while (it >= A->istart[j + 1]) ++j;
        wconv_item(&A->job[j], it - A->istart[j], scr, F.lane);
    }
    float* rope = (float*)(A->ws + WS_ROPE);
    for (int idx = (F.vcu * NWAVES * 64) + F.tid; idx < TPB * 32; idx += F.G * NWAVES * 64) {
        const int t = idx >> 5, p = idx & 31; float cs = 1.f, sn = 0.f;
        if (t < SEQ) { const int f = p & 15; const int pos = p < 16 ? (t >> 6) : (t & 63);
            const float inv = __builtin_amdgcn_exp2f(-(float)f * (13.287712379549449f / 16.0f)); const float ang = (float)pos * inv;
            float x = ang * 0.15915494309189535f; x = x - floorf(x); cs = __builtin_amdgcn_cosf(x); sn = __builtin_amdgcn_sinf(x); }
        rope[(size_t)t * 64 + p] = cs; rope[(size_t)t * 64 + 32 + p] = sn;
    }
}
__device__ __forceinline__ void p0b(Frame& F, const __attribute__((address_space(4))) Args* A) {
    const float* modp = (const float*)(A->ws + WS_MODP); float* mod = (float*)(A->ws + WS_MOD); const float* bm = A->in[5];
    const int n = 4 * 17 * NMOD;
    for (int idx = (F.vcu * NWAVES * 64) + F.tid; idx < n; idx += F.G * NWAVES * 64) {
        const int l = idx / (17 * NMOD), rem = idx - l * 17 * NMOD, col = rem % NMOD;
        float s = bm[l * NMOD + col];
#pragma unroll
        for (int kq = 0; kq < 4; ++kq) s += modp[(size_t)(kq * 4 + l) * 17 * NMOD + rem];
        mod[idx] = s;
    }
}

struct LnPar { f32x4 g[4], sc[4], sh[4]; };
__device__ __forceinline__ void ln_load_par(LnPar& P, const float* gamma, const float* modrow, int slot, int lane) {
#pragma unroll
    for (int j = 0; j < 4; ++j) { const int c = 4 * lane + 256 * j; P.g[j] = *(const f32x4*)(gamma + c); P.sh[j] = *(const f32x4*)(modrow + slot * DM + c); P.sc[j] = *(const f32x4*)(modrow + (slot + 1) * DM + c) + 1.0f; P.g[j] = P.g[j] * P.sc[j]; }
}
__device__ __forceinline__ void ln_row(f32x4 (&h)[4], const float* xrow, const LnPar& P, int lane) {
    float ss = 0.f;
#pragma unroll
    for (int j = 0; j < 4; ++j) { h[j] = *(const f32x4*)(xrow + 4 * lane + 256 * j); ss += (h[j][0] * h[j][0] + h[j][1] * h[j][1]) + (h[j][2] * h[j][2] + h[j][3] * h[j][3]); }
    const float rinv = __builtin_amdgcn_rsqf(wave_sum(ss) * (1.0f / DM) + RMS_EPS);
#pragma unroll
    for (int j = 0; j < 4; ++j) h[j] = h[j] * rinv * P.g[j] + P.sh[j];
}
__device__ __forceinline__ const float* xrow_ptr(const float* L, const float* C, int b, int t) { return t < SEQ ? L + ((size_t)b * SEQ + t) * DM : C + ((size_t)b * CTXL + (t - SEQ)) * DM; }
__device__ __forceinline__ void st_row_bf16(bf16* orow, const f32x4 (&h)[4], int lane) {
#pragma unroll
    for (int j = 0; j < 4; ++j) { u32x2 w; w.x = cvt_pk_bf16(h[j][0], h[j][1]); w.y = cvt_pk_bf16(h[j][2], h[j][3]); *(u32x2*)(orow + 4 * lane + 256 * j) = w; }
}
__device__ __forceinline__ void ln_phase(Frame& F, const float* xl, const float* xc, const float* gamma, const float* modL, int slot, bf16* H) {
    const int gw = F.vcu * NWAVES + F.wave, NGW = F.G * NWAVES;
    for (int row = gw; row < MROWS; row += NGW) {
        const int b = row / TPB, t = row - b * TPB;
        LnPar P; ln_load_par(P, gamma, modL + (size_t)(t < SEQ ? b : 16) * NMOD, slot, F.lane);
        f32x4 h[4]; ln_row(h, xrow_ptr(xl, xc, b, t), P, F.lane);
        st_row_bf16(H + (size_t)row * DM, h, F.lane);
    }
}
__device__ __forceinline__ void ln_rwkv_phase(Frame& F, const float* xl, const float* xc, const float* gamma, const float* modL, bf16* A1) {
    const int gw = F.vcu * NWAVES + F.wave, NGW = F.G * NWAVES;
    for (int run = gw; run < MROWS / 8; run += NGW) {
        const int row0 = run * 8, b = row0 / TPB, t0 = row0 - b * TPB;
        const int slo = t0 < SEQ ? 0 : SEQ, shi = t0 < SEQ ? SEQ : TPB;
        LnPar P; ln_load_par(P, gamma, modL + (size_t)(t0 < SEQ ? b : 16) * NMOD, 0, F.lane);
        f32x4 prev[4], cur[4], nxt[4];
        if (t0 > slo) ln_row(prev, xrow_ptr(xl, xc, b, t0 - 1), P, F.lane);
        else {
#pragma unroll
            for (int j = 0; j < 4; ++j) prev[j] = (f32x4){0.f, 0.f, 0.f, 0.f}; }
        ln_row(cur, xrow_ptr(xl, xc, b, t0), P, F.lane);
        for (int i = 0; i < 8; ++i) {
            const int t = t0 + i;
            if (t + 1 < shi) ln_row(nxt, xrow_ptr(xl, xc, b, t + 1), P, F.lane);
            else {
#pragma unroll
                for (int j = 0; j < 4; ++j) nxt[j] = (f32x4){0.f, 0.f, 0.f, 0.f}; }
            f32x4 xx[4];
#pragma unroll
            for (int j = 0; j < 4; ++j) xx[j] = (prev[j] + nxt[j]) * 0.5f - cur[j];
            bf16* o = A1 + (size_t)(row0 + i) * 2048;
            st_row_bf16(o, cur, F.lane); st_row_bf16(o + DM, xx, F.lane);
#pragma unroll
            for (int j = 0; j < 4; ++j) { prev[j] = cur[j]; cur[j] = nxt[j]; }
        }
    }
}
__device__ __forceinline__ void pool_phase(Frame& F, const bf16* H, bf16* PL) {
    const int gt = F.vcu * NWAVES * 64 + F.tid, NT_ = F.G * NWAVES * 64;
    for (int it = gt; it < (MROWS / 16) * 128; it += NT_) {
        const int run = it >> 7, ch = it & 127, half = 1 << (ch >> 5);
        const int row0 = run * 16, b = row0 / TPB, t0 = row0 - b * TPB;
        const int slo = t0 < SEQ ? 0 : SEQ, shi = t0 < SEQ ? SEQ : TPB;
        const bf16* hb = H + (size_t)b * TPB * DM + ch * 8;
        f32x4 s0 = (f32x4){0.f, 0.f, 0.f, 0.f}, s1 = s0;
        { const int lo = max(t0 - half, slo), hi = min(t0 + half, shi);
          for (int r = lo; r < hi; ++r) { f32x4 a, c2; unpack8(*(const u32x4*)(hb + (size_t)r * DM), a, c2); s0 += a; s1 += c2; } }
        for (int i = 0; i < 16; ++i) {
            const int t = t0 + i; const int lo = max(t - half, slo), hi = min(t + half, shi);
            f32x4 a, c2; unpack8(*(const u32x4*)(hb + (size_t)t * DM), a, c2);
            const float ic = 1.0f / (float)(hi - lo);
            *(u32x4*)(PL + (size_t)(row0 + i) * DM + ch * 8) = pack8(s0 * ic - a, s1 * ic - c2);
            if (t + half < shi) { f32x4 p, q; unpack8(*(const u32x4*)(hb + (size_t)(t + half) * DM), p, q); s0 += p; s1 += q; }
            if (t - half >= slo) { f32x4 p, q; unpack8(*(const u32x4*)(hb + (size_t)(t - half) * DM), p, q); s0 -= p; s1 -= q; }
        }
    }
}

__device__ __forceinline__ float dpp_x1(float x) { return __int_as_float(__builtin_amdgcn_update_dpp(0, __float_as_int(x), 0xB1, 0xF, 0xF, true)); }
__device__ __forceinline__ float dpp_x2(float x) { return __int_as_float(__builtin_amdgcn_update_dpp(0, __float_as_int(x), 0x4E, 0xF, 0xF, true)); }
__device__ __forceinline__ float dpp_hm(float x) { return __int_as_float(__builtin_amdgcn_update_dpp(0, __float_as_int(x), 0x141, 0xF, 0xF, true)); }
__device__ __forceinline__ float red8(float x) { x += dpp_x1(x); x += dpp_x2(x); x += dpp_hm(x); return x; }
__device__ __forceinline__ int scan_tok(int dir, int s) { return dir ? (TPB - 1 - s) : (s < CTXL ? SEQ + s : s - CTXL); }
constexpr int NCHUNK = TPB / 16;

__device__ __forceinline__ void scan_phase(Frame& F, const bf16* Rg, const bf16* Kg, const bf16* KKg, const bf16* Vg, const bf16* P, bf16* Y0, bf16* Y1, float* bonus,
                                           const float* w0, const float* w2, const float* a0, const float* a2, const float* k_a, const float* r_k) {
    LAS float* L = (LAS float*)F.lds;
    const int lane = F.lane, dir = F.wave >> 2, wq = F.wave & 3, vg = lane >> 3, kg = lane & 7, fr = lane & 15, fq = lane >> 4;
    const int mm = wq >> 1, cth = wq & 1;
    for (int bh = F.vcu; bh < NB * 16; bh += F.G) {
        const int b = bh >> 4, h = bh & 15; const size_t rb = (size_t)b * TPB;
        const float* W2 = (mm == 0 ? w2 : a2) + (size_t)dir * 64 * DM + h * 64;
        bf16x8 Bf[2][2]; float bias[2], ka[2];
#pragma unroll
        for (int ct2 = 0; ct2 < 2; ++ct2) { const int j = 16 * (2 * cth + ct2) + fr;
            bias[ct2] = (mm == 0 ? w0 : a0)[dir * DM + h * 64 + j]; ka[ct2] = k_a[h * 64 + j];
#pragma unroll
            for (int ks = 0; ks < 2; ++ks) { const float* wp = W2 + (size_t)(32 * ks + 8 * fq) * DM + j;
                u32x4 pk; pk.x = cvt_pk_bf16(wp[0], wp[DM]); pk.y = cvt_pk_bf16(wp[2 * DM], wp[3 * DM]); pk.z = cvt_pk_bf16(wp[4 * DM], wp[5 * DM]); pk.w = cvt_pk_bf16(wp[6 * DM], wp[7 * DM]);
                Bf[ct2][ks] = __builtin_bit_cast(bf16x8, pk); } }
        f32x2 rk[4];
#pragma unroll
        for (int jp = 0; jp < 4; ++jp) rk[jp] = *(const f32x2*)(r_k + h * 64 + 8 * kg + 2 * jp);
        f32x2 S[2][4];
#pragma unroll
        for (int rr = 0; rr < 2; ++rr)
#pragma unroll
            for (int jp = 0; jp < 4; ++jp) S[rr][jp] = (f32x2){0.f, 0.f};
        bf16* Yd = dir ? Y1 : Y0;
        const bf16* srcA = mm == 0 ? Rg : Kg; const bf16* srcB = mm == 0 ? Vg : KKg;
        bf16x8 Pa[2]; unsigned short ga[8], gb[8];
#define SC_LOAD(c) do { const int s0_ = 16 * (c); const size_t ra_ = rb + scan_tok(dir, s0_ + fr); \
        _Pragma("unroll") for (int ks = 0; ks < 2; ++ks) Pa[ks] = *(const bf16x8*)(P + ra_ * 512 + 128 * mm + 64 * dir + 32 * ks + 8 * fq); \
        _Pragma("unroll") for (int e = 0; e < 4; ++e) { const size_t ri_ = (rb + scan_tok(dir, s0_ + 4 * fq + e)) * DM + h * 64 + 32 * cth + fr; \
            _Pragma("unroll") for (int ct2 = 0; ct2 < 2; ++ct2) { ga[e * 2 + ct2] = srcA[ri_ + 16 * ct2]; gb[e * 2 + ct2] = srcB[ri_ + 16 * ct2]; } } } while (0)
#define SC_COMPUTE(buf) do { LAS float* Lb_ = L + ((buf) * 2 + dir) * 6 * 1024; \
        _Pragma("unroll") for (int ct2 = 0; ct2 < 2; ++ct2) { f32x4 D_ = (f32x4){0.f, 0.f, 0.f, 0.f}; \
            D_ = __builtin_amdgcn_mfma_f32_16x16x32_bf16(Pa[0], Bf[ct2][0], D_, 0, 0, 0); D_ = __builtin_amdgcn_mfma_f32_16x16x32_bf16(Pa[1], Bf[ct2][1], D_, 0, 0, 0); \
            _Pragma("unroll") for (int e = 0; e < 4; ++e) { const int idx_ = (4 * fq + e) * 64 + 16 * (2 * cth + ct2) + fr; const float xa_ = bf2f(ga[e * 2 + ct2]), xb_ = bf2f(gb[e * 2 + ct2]); \
                if (mm == 0) { const float sg_ = fsigmoid(bias[ct2] + D_[e]); Lb_[1 * 1024 + idx_] = __builtin_amdgcn_exp2f(-0.8750387749f * sg_); Lb_[4 * 1024 + idx_] = xa_; Lb_[5 * 1024 + idx_] = xb_; } \
                else { const float a_ = fsigmoid(bias[ct2] + D_[e]); Lb_[3 * 1024 + idx_] = xa_ * (1.0f + (a_ - 1.0f) * ka[ct2]); Lb_[2 * 1024 + idx_] = xb_ * a_; Lb_[0 * 1024 + idx_] = xb_; } } } } while (0)
        SC_LOAD(0); SC_COMPUTE(0); __syncthreads();
        for (int c = 0; c < NCHUNK; ++c) {
            if (c + 1 < NCHUNK) SC_LOAD(c + 1);
            const LAS float* Lb = L + ((c & 1) * 2 + dir) * 6 * 1024 + 8 * kg;
#pragma unroll 2
            for (int i = 0; i < 16; ++i) {
                const LAS float* q = Lb + i * 64;
                f32x2 kk2[4], w2v[4], kka[4], kt[4], r2[4];
                { const f32x4 a = *(const LAS f32x4*)(q), bq = *(const LAS f32x4*)(q + 4); kk2[0] = (f32x2){a[0], a[1]}; kk2[1] = (f32x2){a[2], a[3]}; kk2[2] = (f32x2){bq[0], bq[1]}; kk2[3] = (f32x2){bq[2], bq[3]}; }
                { const f32x4 a = *(const LAS f32x4*)(q + 1024), bq = *(const LAS f32x4*)(q + 1024 + 4); w2v[0] = (f32x2){a[0], a[1]}; w2v[1] = (f32x2){a[2], a[3]}; w2v[2] = (f32x2){bq[0], bq[1]}; w2v[3] = (f32x2){bq[2], bq[3]}; }
                { const f32x4 a = *(const LAS f32x4*)(q + 2048), bq = *(const LAS f32x4*)(q + 2048 + 4); kka[0] = (f32x2){a[0], a[1]}; kka[1] = (f32x2){a[2], a[3]}; kka[2] = (f32x2){bq[0], bq[1]}; kka[3] = (f32x2){bq[2], bq[3]}; }
                { const f32x4 a = *(const LAS f32x4*)(q + 3072), bq = *(const LAS f32x4*)(q + 3072 + 4); kt[0] = (f32x2){a[0], a[1]}; kt[1] = (f32x2){a[2], a[3]}; kt[2] = (f32x2){bq[0], bq[1]}; kt[3] = (f32x2){bq[2], bq[3]}; }
                { const f32x4 a = *(const LAS f32x4*)(q + 4096), bq = *(const LAS f32x4*)(q + 4096 + 4); r2[0] = (f32x2){a[0], a[1]}; r2[1] = (f32x2){a[2], a[3]}; r2[2] = (f32x2){bq[0], bq[1]}; r2[3] = (f32x2){bq[2], bq[3]}; }
                const f32x2 vv = *(const LAS f32x2*)(Lb - 8 * kg + 5 * 1024 + i * 64 + 16 * wq + 2 * vg);
                float sa[2];
#pragma unroll
                for (int rr = 0; rr < 2; ++rr) { f32x2 t2 = S[rr][0] * kk2[0]; t2 += S[rr][1] * kk2[1]; t2 += S[rr][2] * kk2[2]; t2 += S[rr][3] * kk2[3]; sa[rr] = red8(t2.x + t2.y); }
                float yv[2];
#pragma unroll
                for (int rr = 0; rr < 2; ++rr) { const float nsa = -sa[rr]; const float vr = rr == 0 ? vv.x : vv.y; f32x2 t2 = (f32x2){0.f, 0.f};
#pragma unroll
                    for (int jp = 0; jp < 4; ++jp) { S[rr][jp] = S[rr][jp] * w2v[jp] + kka[jp] * nsa + kt[jp] * vr; t2 += S[rr][jp] * r2[jp]; }
                    yv[rr] = red8(t2.x + t2.y); }
                const size_t grow = rb + scan_tok(dir, 16 * c + i);
                if (kg == 0) *(unsigned*)(Yd + grow * DM + h * 64 + 16 * wq + 2 * vg) = cvt_pk_bf16(yv[0], yv[1]);
                if (wq == 0) { f32x2 t2 = r2[0] * kt[0] * rk[0]; t2 += r2[1] * kt[1] * rk[1]; t2 += r2[2] * kt[2] * rk[2]; t2 += r2[3] * kt[3] * rk[3];
                    const float bs = red8(t2.x + t2.y); if (lane == 0) bonus[(grow * 16 + h) * 2 + dir] = bs; }
            }
            if (c + 1 < NCHUNK) SC_COMPUTE((c + 1) & 1);
            __syncthreads();
        }
#undef SC_LOAD
#undef SC_COMPUTE
    }
}

typedef const __attribute__((address_space(4))) Args* ArgsP;
__device__ __forceinline__ ArgsP get_args() { ArgsP p = (ArgsP)__builtin_amdgcn_kernarg_segment_ptr(); asm volatile("" : "+s"(p)); return p; }
#define PHASE_BEGIN() Frame F; { int t_ = threadIdx.x; asm volatile("" : "+v"(t_)); F.tid = t_; F.lane = t_ & 63; F.wave = __builtin_amdgcn_readfirstlane(t_ >> 6); \
        F.lds = (LAS unsigned char*)lds; F.G = gridDim.x; const int bx_ = blockIdx.x; F.vcu = (F.G % 8 == 0) ? (bx_ % 8) * (F.G / 8) + bx_ / 8 : bx_; } \
    ArgsP A = get_args(); unsigned char* const ws = A->ws; float* const xout = A->out; float* const ctxb = (float*)(ws + WS_CTX); bf16* const Wb = (bf16*)(ws + WS_W); unsigned char* const act = ws + WS_ACT; \
    const float* const modL = (const float*)(ws + WS_MOD) + (size_t)layer * 17 * NMOD; \
    const float* const srcL = layer == 0 ? A->in[0] : xout; const float* const srcC = layer == 0 ? A->in[2] : ctxb; \
    (void)xout; (void)ctxb; (void)Wb; (void)act; (void)modL; (void)srcL; (void)srcC
#ifndef PHM
#define PHM 0xFFFF
#endif
#define PH(x) if (PHM & (x))
#define GSYNC() cg::this_grid().sync()
#define GEMM(EpiT, gg, EE) do { pg8::StaticOrder S_; S_.init((gg).M, (gg).N, F.G, (int)blockIdx.x); pg8::gemm_phase<EpiT, pg8::StaticOrder, true, true>(F.lds, gg, S_, EE); } while (0)

__global__ void __launch_bounds__(NWAVES * 64, 2) hybrid_fwd(Args args_unused) {
    extern __shared__ __attribute__((aligned(16))) unsigned char lds[];
    { const int layer = 0; PHASE_BEGIN(); PH(1) p0a(F, A); } GSYNC();
    { const int layer = 0; PHASE_BEGIN(); PH(1) p0b(F, A); } GSYNC();

#pragma unroll 1
    for (int layer = 0; layer < 4; ++layer) {
        const int kind = layer % 3;
        if (kind == 0) {
            PH(2) { PHASE_BEGIN(); ln_phase(F, srcL, srcC, A->in[6] + layer * DM, modL, 0, (bf16*)act); } GSYNC();
            PH(4) { PHASE_BEGIN(); const int j = layer / 3; bf16* Q = (bf16*)(act + ACT1); bf16* Kb = (bf16*)(act + 2 * ACT1); bf16* Vb = (bf16*)(act + 2 * ACT1 + 34 * MiB);
              pg8::Gemm g{(bf16*)act, Wb + (W_QKV + (size_t)j * 3 * MiB) / 2, MROWS, 1536, DM, DM, 0};
              EpiQKV E{Q, Kb, Vb, A->in[11] + j * 64, A->in[12] + j * 64, (const float*)(ws + WS_ROPE)};
              GEMM(EpiQKV, g, E); } GSYNC();
            PH(8) { PHASE_BEGIN(); const bool with_ctx = layer != 3; bf16* Q = (bf16*)(act + ACT1); bf16* Kb = (bf16*)(act + 2 * ACT1); bf16* Vb = (bf16*)(act + 2 * ACT1 + 34 * MiB);
              for (int bh = F.vcu; bh < NB * 16; bh += F.G) { const int b = bh >> 4, h = bh & 15; const long rb = (long)b * TPB;
                  for (int qb = 0; qb < 16; ++qb) attn_body::attn_unit<8>(rb + qb * 256, rb, TPB / 64, h, (const attn_body::bf16*)Q, (const attn_body::bf16*)Kb, (const attn_body::bf16*)Vb, (attn_body::bf16*)Q, (char*)lds);
                  if (with_ctx) attn_body::attn_unit<8>(rb + SEQ, rb + SEQ, CTXL / 64, h, (const attn_body::bf16*)Q, (const attn_body::bf16*)Kb, (const attn_body::bf16*)Vb, (attn_body::bf16*)Q, (char*)lds); } } GSYNC();
            PH(16) { PHASE_BEGIN(); const int j = layer / 3; bf16* Q = (bf16*)(act + ACT1);
              pg8::Gemm g{Q, Wb + (W_WO + (size_t)j * 2 * MiB) / 2, MROWS, DM, DM, DM, 0};
              EpiResid E{srcL, srcC, xout, ctxb, modL, 2, nullptr};
              GEMM(EpiResid, g, E); } GSYNC();
        } else if (kind == 1) {
            PH(32) { PHASE_BEGIN(); ln_rwkv_phase(F, srcL, srcC, A->in[6] + layer * DM, modL, (bf16*)act); } GSYNC();
            PH(64) { PHASE_BEGIN(); bf16* R = (bf16*)(act + 2 * ACT1); bf16* Kb = (bf16*)(act + 3 * ACT1); bf16* Vb = (bf16*)(act + 4 * ACT1); bf16* KK = (bf16*)(act + 5 * ACT1); bf16* P = (bf16*)(act + 6 * ACT1);
              pg8::Gemm g{(bf16*)act, Wb + W_R1 / 2, MROWS, 3584, 2048, 2048, 0};
              EpiRwkv1 E{R, (size_t)ACT1 / 2, KK, P, A->in[24]}; (void)Kb; (void)Vb;
              GEMM(EpiRwkv1, g, E); } GSYNC();
            PH(128) { PHASE_BEGIN(); bf16* R = (bf16*)(act + 2 * ACT1); bf16* Kb = (bf16*)(act + 3 * ACT1); bf16* Vb = (bf16*)(act + 4 * ACT1); bf16* KK = (bf16*)(act + 5 * ACT1); bf16* P = (bf16*)(act + 6 * ACT1);
              scan_phase(F, R, Kb, KK, Vb, P, (bf16*)act, (bf16*)(act + ACT1), (float*)(ws + WS_BONUS), A->in[16], A->in[18], A->in[19], A->in[21], A->in[25], A->in[26]); } GSYNC();
            PH(256) { PHASE_BEGIN(); bf16* Vb = (bf16*)(act + 4 * ACT1); bf16* P = (bf16*)(act + 6 * ACT1); bf16* Z = (bf16*)(act + 3 * ACT1);
              pg8::Gemm g{P + 256, Wb + W_G2 / 2, MROWS, DM, 256, 512, 0};
              EpiFinish E{(bf16*)act, (bf16*)(act + ACT1), Vb, (const float*)(ws + WS_BONUS), A->in[27], A->in[28], Z};
              GEMM(EpiFinish, g, E); } GSYNC();
            PH(512) { PHASE_BEGIN(); bf16* Z = (bf16*)(act + 3 * ACT1);
              pg8::Gemm g{Z, Wb + W_RWO / 2, MROWS, DM, DM, DM, 0};
              EpiResid E{srcL, srcC, xout, ctxb, modL, 2, nullptr};
              GEMM(EpiResid, g, E); } GSYNC();
        } else {
            PH(2) { PHASE_BEGIN(); ln_phase(F, srcL, srcC, A->in[6] + layer * DM, modL, 0, (bf16*)act); } GSYNC();
            PH(1024) { PHASE_BEGIN(); pool_phase(F, (bf16*)act, (bf16*)(act + ACT1)); } GSYNC();
            PH(2048) { PHASE_BEGIN(); bf16* PL = (bf16*)(act + ACT1);
              pg8::Gemm g{PL, Wb + W_POOL / 2, MROWS, DM, 256, DM, 256};
              EpiResid E{srcL, srcC, xout, ctxb, modL, 2, A->in[31]};
              GEMM(EpiResid, g, E); } GSYNC();
        }
        PH(2) { PHASE_BEGIN(); ln_phase(F, xout, ctxb, A->in[7] + layer * DM, modL, 3, (bf16*)act); } GSYNC();
        PH(4096) { PHASE_BEGIN(); bf16* U = (bf16*)(act + ACT1);
          pg8::Gemm g{(bf16*)act, Wb + (W_IN + (size_t)layer * 8 * MiB) / 2, MROWS, FF, DM, DM, 0};
          EpiRelu2 E{U, FF};
          GEMM(EpiRelu2, g, E); } GSYNC();
        PH(8192) { PHASE_BEGIN(); bf16* U = (bf16*)(act + ACT1);
          pg8::Gemm g{U, Wb + (W_OUT + (size_t)layer * 8 * MiB) / 2, MROWS, DM, FF, FF, 0};
          EpiResid E{xout, ctxb, xout, ctxb, modL, 5, nullptr};
          GEMM(EpiResid, g, E); }
        if (layer != 3) GSYNC();
    }
}

extern "C" void kernel_launch(void* const* d_in, const int* in_sizes, int n_in, void* d_out, int out_size, void* d_ws, size_t ws_size, hipStream_t stream) {
    static int grid = 0;
    if (grid == 0) {
        if (n_in != 32 || in_sizes[0] != NB * SEQ * DM || out_size != NB * SEQ * DM || ws_size < WS_NEED) { fprintf(stderr, "kernel_launch: unexpected shapes (n_in %d, in0 %d, out %d, ws %zu); nothing launched\n", n_in, n_in > 0 ? in_sizes[0] : -1, out_size, ws_size); grid = -1; return; }
        int dev = 0, cus = 0, per_cu = 0;
        if (hipGetDevice(&dev) != hipSuccess || hipDeviceGetAttribute(&cus, hipDeviceAttributeMultiprocessorCount, dev) != hipSuccess) { grid = -1; return; }
        if (hipFuncSetAttribute((const void*)hybrid_fwd, hipFuncAttributeMaxDynamicSharedMemorySize, LDS_BYTES) != hipSuccess) { fprintf(stderr, "kernel_launch: hipFuncSetAttribute failed\n"); grid = -1; return; }
        if (hipOccupancyMaxActiveBlocksPerMultiprocessor(&per_cu, (const void*)hybrid_fwd, NWAVES * 64, LDS_BYTES) != hipSuccess || per_cu < 1) { fprintf(stderr, "kernel_launch: occupancy query says %d\n", per_cu); per_cu = 1; }
        (void)hipGetLastError();
        grid = cus * per_cu;
    }
    if (grid < 0) return;
    Args a{};
    for (int i = 0; i < 32; ++i) a.in[i] = (const float*)d_in[i];
    a.out = (float*)d_out; a.ws = (unsigned char*)d_ws;
    bf16* Wb = (bf16*)((unsigned char*)d_ws + WS_W);
    int nj = 0, items = 0;
    auto add = [&](const float* src, const float* kscale, bf16* dst, int ld_src, int k_src, int k_pad, int ncols, int ldt, int row_off, int col_base, int k_off, int mode) {
        WJob& J = a.job[nj]; J.src = src; J.kscale = kscale; J.dst = dst; J.ld_src = ld_src; J.k_src = k_src; J.ldt = ldt; J.row_off = row_off; J.col_base = col_base; J.k_off = k_off; J.nblk = ncols / 32; J.mode = mode;
        a.istart[nj] = items; items += (k_pad / 64) * (ncols / 32); ++nj; };
    const float* in10 = a.in[10]; const float* in13 = a.in[13];
    for (int j = 0; j < 2; ++j) add(in10 + (size_t)j * DM * 1536, nullptr, Wb + (W_QKV + (size_t)j * 3 * MiB) / 2, 1536, DM, DM, 1536, DM, 0, 0, 0, 1);
    for (int j = 0; j < 2; ++j) add(in13 + (size_t)j * DM * DM, nullptr, Wb + (W_WO + (size_t)j * 2 * MiB) / 2, DM, DM, DM, DM, DM, 0, 0, 0, 0);
    for (int i = 0; i < 4; ++i) add(a.in[8] + (size_t)i * DM * FF, nullptr, Wb + (W_IN + (size_t)i * 8 * MiB) / 2, FF, DM, DM, FF, DM, 0, 0, 0, 0);
    for (int i = 0; i < 4; ++i) add(a.in[9] + (size_t)i * FF * DM, nullptr, Wb + (W_OUT + (size_t)i * 8 * MiB) / 2, DM, FF, FF, DM, FF, 0, 0, 0, 0);
    { bf16* W1 = Wb + W_R1 / 2; const float* mu = a.in[14]; const float* rkv = a.in[15];
      for (int hf = 0; hf < 2; ++hf) { const int ko = hf * DM;
          add(rkv, hf ? mu + 0 * DM : nullptr, W1, DM, DM, DM, DM, 2048, 0, 0, ko, 1);
          add(rkv + (size_t)DM * DM, hf ? mu + 2 * DM : nullptr, W1, DM, DM, DM, DM, 2048, 1024, 0, ko, 1);
          add(rkv + (size_t)2 * DM * DM, hf ? mu + 3 * DM : nullptr, W1, DM, DM, DM, DM, 2048, 2048, 0, ko, 1);
          for (int d = 0; d < 2; ++d) add(a.in[17] + (size_t)d * DM * 64, hf ? mu + 1 * DM : nullptr, W1, 64, DM, DM, 64, 2048, 3072, 64 * d, ko, 1);
          for (int d = 0; d < 2; ++d) add(a.in[20] + (size_t)d * DM * 64, hf ? mu + 4 * DM : nullptr, W1, 64, DM, DM, 64, 2048, 3072, 128 + 64 * d, ko, 1);
          add(a.in[22], hf ? mu + 5 * DM : nullptr, W1, 160, DM, DM, 160, 2048, 3072, 256, ko, 1);
          add(nullptr, nullptr, W1, 96, DM, DM, 96, 2048, 3072, 416, ko, 1); } }
    add(a.in[23], nullptr, Wb + W_G2 / 2, DM, 160, 256, DM, 256, 0, 0, 0, 1);
    add(a.in[29], nullptr, Wb + W_RWO / 2, DM, DM, DM, DM, DM, 0, 0, 0, 0);
    for (int gi = 0; gi < 4; ++gi) add(a.in[30] + (size_t)gi * 256 * 256, nullptr, Wb + W_POOL / 2, 256, 256, 256, 256, 256, 256 * gi, 0, 0, 0);
    if (nj != NJOBS) { fprintf(stderr, "kernel_launch: job count %d != %d\n", nj, NJOBS); return; }
    a.istart[NJOBS] = items; a.istart[NJOBS + 1] = 0;
    void* kargs[] = {&a};
    hipError_t e = hipLaunchCooperativeKernel((const void*)hybrid_fwd, dim3(grid), dim3(NWAVES * 64), kargs, LDS_BYTES, stream);
    if (e != hipSuccess) fprintf(stderr, "kernel_launch: cooperative launch failed: %s (grid %d)\n", hipGetErrorString(e), grid);
}
```

```cpp
#include <hip/hip_runtime.h>
#include <hip/hip_cooperative_groups.h>
#include <cstdio>
#include <cstdint>
namespace cg = cooperative_groups;
namespace pg8 {
#define PG8_LAS __attribute__((address_space(3)))
typedef unsigned short bf16_t;
typedef short bf16x8 __attribute__((ext_vector_type(8)));
typedef float f32x4 __attribute__((ext_vector_type(4)));
typedef unsigned u32x4 __attribute__((ext_vector_type(4)));
constexpr int BM = 256, BK = 64, HALF = 128, HTB = HALF * BK * 2  , STAGE_BYTES = 8 * HTB, NXCD = 8, WGM = 8;

__host__ __device__ __forceinline__ int lds_byte(int r, int c) { const int st = (r >> 4) * 2 + (c >> 5), rr = r & 15, cc = c & 31, ob = rr * 64 + cc * 2; return st * 1024 + (ob ^ (((ob >> 9) & 1) << 5)); }
__host__ __device__ __forceinline__ void stage_rc(int b, int& R, int& C) { const int st = b / 1024, sb = b % 1024, swz = sb ^ (((sb >> 9) & 1) << 5); R = (st >> 1) * 16 + swz / 64; C = (st & 1) * 32 + (swz % 64) / 2; }
__host__ __device__ __forceinline__ int perm32(int rho) { const int n = rho >> 4, i = rho & 15; return 8 * (i >> 2) + 4 * n + (i & 3); }

struct Unit { int pm, pn, kofs; };
struct Gemm { const bf16_t* A; const bf16_t* Bt; int M, N, K; int lda, ldb; long a_pn_off; };

struct StaticOrder {
    int nM, nN, nwg, G, c, skip;
    __host__ __device__ void init(int M, int N, int G_, int c_, int skip_ = 0) { skip = skip_; nM = M / BM; if (skip) nM = nM / 17 * 16; nN = N / BM; nwg = nM * nN; G = G_; c = c_; }
    __host__ __device__ bool next(int i, Unit& u) const {
        const long L = (long)i * G + c; if (L >= nwg) return false;
        int wgid = (int)L; { const int q = nwg / NXCD, r = nwg % NXCD, xcd = wgid % NXCD, off = wgid / NXCD; wgid = (xcd < r ? xcd * (q + 1) : r * (q + 1) + (xcd - r) * q) + off; }
        const int nig = WGM * nN, gid = wgid / nig, fm = gid * WGM, gsz = (nM - fm) < WGM ? (nM - fm) : WGM;
        u.pm = fm + ((wgid % nig) % gsz); u.pn = (wgid % nig) / gsz; u.kofs = 0; if (skip) u.pm += u.pm / 16; return true;
    }
    __device__ __forceinline__ void a_ready(const Unit&) const {}
    __device__ __forceinline__ void done(const Unit&) const {}
};

struct CtxSplitK {
    int G, c, kq;
    __host__ __device__ void init(int Kfull, int G_, int c_) { G = G_; c = c_; kq = Kfull / 4; }
    __host__ __device__ bool next(int i, Unit& u) const { const long L = (long)i * G + c; if (L >= 256) return false; const int l = (int)L; u.pm = (l >> 4) * 17 + 16; u.pn = (l >> 2) & 3; u.kofs = (l & 3) * kq; return true; }
    __device__ __forceinline__ void a_ready(const Unit&) const {}
    __device__ __forceinline__ void done(const Unit&) const {}
};
__device__ __forceinline__ unsigned cvt_pk_bf16(float lo, float hi) { unsigned r; asm volatile("v_cvt_pk_bf16_f32 %0, %1, %2" : "=v"(r) : "v"(lo), "v"(hi)); return r; }
typedef float f32x2 __attribute__((ext_vector_type(2)));
template <class Epi, class Sched, bool ALIGN_EPI = false, bool SP2 = false>
__device__ __forceinline__ void gemm_phase(PG8_LAS unsigned char* lds, const Gemm g, const Sched& S, const Epi& E) {
    int tid_ = threadIdx.x; asm volatile("" : "+v"(tid_)); const int tid = tid_, wid = __builtin_amdgcn_readfirstlane(tid >> 6), lane = tid & 63, wr = wid >> 2, wc = wid & 3, fr = lane & 15, fq = lane >> 4;
    const int K = g.K, nt = K / BK;
    unsigned voffA[2], voffB[2];
#pragma unroll
    for (int i = 0; i < 2; ++i) { int R, C; stage_rc(tid * 16 + i * 8192, R, C); const int Rb = Epi::PERM ? ((R & ~31) + perm32(R & 31)) : R;
        voffA[i] = (unsigned)(R * g.lda + C) * 2u; voffB[i] = (unsigned)(Rb * g.ldb + C) * 2u; }
    const size_t kstep = (size_t)(BK * 2);
    const size_t hA = (size_t)HALF * g.lda * 2, hB = (size_t)HALF * g.ldb * 2;
    const size_t tA = 2 * hA, tB = 2 * hB, pnA = (size_t)g.a_pn_off * 2;
    const unsigned ldsw = (unsigned)wid * 1024u;
    const int aoff = lds_byte(wr * 64 + fr, fq * 8), boff = lds_byte(wc * 32 + fr, fq * 8);
#define PG8_SA(b, h) (((b) * 2 + (h)) * HTB)
#define PG8_SB(b, h) ((4 + (b) * 2 + (h)) * HTB)
#define PG8_STAGE(bufoff, gbase, voff) do { _Pragma("unroll") for (int _i = 0; _i < 2; ++_i) \
        __builtin_amdgcn_global_load_lds((const unsigned*)((const char*)(gbase) + (voff)[_i]), (PG8_LAS unsigned*)(lds + (bufoff) + ldsw + _i * 8192), 16, 0, 0); } while (0)
#define PG8_LDA(dst, b, h) do { _Pragma("unroll") for (int m = 0; m < 4; ++m) _Pragma("unroll") for (int k = 0; k < 2; ++k) dst[m][k] = *(const PG8_LAS bf16x8*)(lds + PG8_SA(b, h) + aoff + m * 2048 + k * 1024); } while (0)
#define PG8_LDB(dst, b, h) do { _Pragma("unroll") for (int n = 0; n < 2; ++n) _Pragma("unroll") for (int k = 0; k < 2; ++k) dst[n][k] = *(const PG8_LAS bf16x8*)(lds + PG8_SB(b, h) + boff + n * 2048 + k * 1024); } while (0)
#define PG8_MMA(ai, bj, At, Bt) do { __builtin_amdgcn_s_setprio(1); _Pragma("unroll") for (int m = 0; m < 4; ++m) _Pragma("unroll") for (int n = 0; n < 2; ++n) _Pragma("unroll") for (int k = 0; k < 2; ++k) \
        acc[ai][bj][m][n] = __builtin_amdgcn_mfma_f32_16x16x32_bf16(Bt[n][k], At[m][k], acc[ai][bj][m][n], 0, 0, 0); __builtin_amdgcn_s_setprio(0); } while (0)
#define PG8_WAIT_V(n) asm volatile("s_waitcnt vmcnt(" #n ")" ::: "memory")
#define PG8_WAIT_L(n) asm volatile("s_waitcnt lgkmcnt(" #n ")" ::: "memory")
#define PG8_BAR __builtin_amdgcn_s_barrier()
#define PG8_SCHED __builtin_amdgcn_sched_barrier(0)
    Unit cur, nxt; int ui = 0;
    if (!S.next(0, cur)) return;
    f32x4 acc[2][2][4][2];
#pragma unroll
    for (int a = 0; a < 2; ++a)
#pragma unroll
        for (int b = 0; b < 2; ++b)
#pragma unroll
            for (int m = 0; m < 4; ++m)
#pragma unroll
                for (int n = 0; n < 2; ++n) acc[a][b][m][n] = (f32x4){0.f, 0.f, 0.f, 0.f};
    bf16x8 At[4][2], B0[2][2], B1[2][2];
    const char* cA = (const char*)g.A + (size_t)cur.pm * tA + (size_t)cur.pn * pnA + (size_t)cur.kofs * 2; const char* cB = (const char*)g.Bt + (size_t)cur.pn * tB + (size_t)cur.kofs * 2;
    S.a_ready(cur);
    if constexpr (SP2) {
        PG8_STAGE(PG8_SB(0, 0), cB, voffB); PG8_STAGE(PG8_SB(0, 1), cB + hB, voffB); PG8_STAGE(PG8_SA(0, 0), cA, voffA); PG8_STAGE(PG8_SA(0, 1), cA + hA, voffA);
        if (wr == 1) PG8_BAR;
        PG8_WAIT_V(2); PG8_BAR;
        PG8_STAGE(PG8_SB(1, 0), cB + kstep, voffB); PG8_STAGE(PG8_SA(1, 0), cA + kstep, voffA); PG8_STAGE(PG8_SB(1, 1), cB + hB + kstep, voffB);
        PG8_WAIT_V(6); PG8_BAR;
    } else {
        PG8_STAGE(PG8_SB(0, 0), cB, voffB); PG8_STAGE(PG8_SA(0, 0), cA, voffA); PG8_STAGE(PG8_SB(0, 1), cB + hB, voffB); PG8_STAGE(PG8_SA(0, 1), cA + hA, voffA);
        if (wr == 1) PG8_BAR;
        PG8_WAIT_V(4); PG8_BAR;
        PG8_STAGE(PG8_SB(1, 0), cB + kstep, voffB); PG8_STAGE(PG8_SA(1, 0), cA + kstep, voffA); PG8_STAGE(PG8_SB(1, 1), cB + hB + kstep, voffB);
        PG8_WAIT_V(6); PG8_BAR;
    }
    for (;;) {
        const bool has_next = S.next(ui + 1, nxt);
        const char* nA = has_next ? (const char*)g.A + (size_t)nxt.pm * tA + (size_t)nxt.pn * pnA + (size_t)nxt.kofs * 2 : cA; const char* nB = has_next ? (const char*)g.Bt + (size_t)nxt.pn * tB + (size_t)nxt.kofs * 2 : cB;
#pragma unroll 1
        for (int t = 0; t < nt; t += 2) {
            const bool last = (t == nt - 2);
            const char* a1 = cA + (size_t)(t + 1) * kstep;
            const char* a2 = last ? nA : cA + (size_t)(t + 2) * kstep; const char* b2 = last ? nB : cB + (size_t)(t + 2) * kstep;
            const char* a3 = a2 + kstep; const char* b3 = b2 + kstep;
            if (last && has_next) S.a_ready(nxt);
            if constexpr (SP2) {
            PG8_LDB(B0, 0, 0); PG8_LDB(B1, 0, 1); PG8_SCHED; PG8_LDA(At, 0, 0); PG8_STAGE(PG8_SA(1, 1), a1 + hA, voffA);
            PG8_WAIT_V(8); PG8_WAIT_L(0); PG8_BAR; PG8_MMA(0, 0, At, B0); PG8_MMA(0, 1, At, B1); PG8_BAR; PG8_SCHED;
            PG8_LDA(At, 0, 1); PG8_STAGE(PG8_SB(0, 0), b2, voffB); PG8_STAGE(PG8_SB(0, 1), b2 + hB, voffB); PG8_STAGE(PG8_SA(0, 0), a2, voffA);
            PG8_WAIT_V(8); PG8_WAIT_L(0); PG8_BAR; PG8_MMA(1, 0, At, B0); PG8_MMA(1, 1, At, B1); PG8_BAR; PG8_SCHED;
            PG8_LDB(B0, 1, 0); PG8_LDB(B1, 1, 1); PG8_SCHED; PG8_LDA(At, 1, 0); PG8_STAGE(PG8_SA(0, 1), a2 + hA, voffA);
            PG8_WAIT_V(8); PG8_WAIT_L(0); PG8_BAR; PG8_MMA(0, 0, At, B0); PG8_MMA(0, 1, At, B1); PG8_BAR; PG8_SCHED;
            PG8_LDA(At, 1, 1); PG8_STAGE(PG8_SB(1, 0), b3, voffB); PG8_STAGE(PG8_SB(1, 1), b3 + hB, voffB); PG8_STAGE(PG8_SA(1, 0), a3, voffA);
            PG8_WAIT_V(8); PG8_WAIT_L(0); PG8_BAR; PG8_MMA(1, 0, At, B0); PG8_MMA(1, 1, At, B1); PG8_BAR; PG8_SCHED;
            } else {
            PG8_LDB(B0, 0, 0); PG8_SCHED; PG8_LDA(At, 0, 0); PG8_STAGE(PG8_SA(1, 1), a1 + hA, voffA);
            PG8_WAIT_L(8); PG8_BAR; PG8_WAIT_L(0); PG8_MMA(0, 0, At, B0); PG8_BAR; PG8_SCHED;
            PG8_LDB(B1, 0, 1); PG8_STAGE(PG8_SB(0, 0), b2, voffB);
            PG8_BAR; PG8_WAIT_L(0); PG8_MMA(0, 1, At, B1); PG8_BAR;
            PG8_LDA(At, 0, 1); PG8_STAGE(PG8_SA(0, 0), a2, voffA);
            PG8_BAR; PG8_WAIT_L(0); PG8_MMA(1, 0, At, B0); PG8_BAR; PG8_SCHED;
            PG8_STAGE(PG8_SB(0, 1), b2 + hB, voffB);
            PG8_WAIT_V(6); PG8_BAR; PG8_MMA(1, 1, At, B1); PG8_BAR;
            PG8_LDB(B0, 1, 0); PG8_SCHED; PG8_LDA(At, 1, 0); PG8_STAGE(PG8_SA(0, 1), a2 + hA, voffA);
            PG8_WAIT_L(8); PG8_BAR; PG8_WAIT_L(0); PG8_MMA(0, 0, At, B0); PG8_BAR; PG8_SCHED;
            PG8_LDB(B1, 1, 1); PG8_STAGE(PG8_SB(1, 0), b3, voffB);
            PG8_BAR; PG8_WAIT_L(0); PG8_MMA(0, 1, At, B1); PG8_BAR;
            PG8_LDA(At, 1, 1); PG8_STAGE(PG8_SA(1, 0), a3, voffA);
            PG8_BAR; PG8_WAIT_L(0); PG8_MMA(1, 0, At, B0); PG8_BAR; PG8_SCHED;
            PG8_STAGE(PG8_SB(1, 1), b3 + hB, voffB);
            PG8_WAIT_V(6); PG8_BAR; PG8_MMA(1, 1, At, B1); PG8_BAR;
            }
        }
        if constexpr (ALIGN_EPI) { if (wr == 0) PG8_BAR; }
        if constexpr (!Epi::AFTER_DRAIN) { E(acc, cur, wr, wc, fr, fq); S.done(cur); }
        if (!has_next) break;
#pragma unroll
        for (int a = 0; a < 2; ++a)
#pragma unroll
            for (int b = 0; b < 2; ++b)
#pragma unroll
                for (int m = 0; m < 4; ++m)
#pragma unroll
                    for (int n = 0; n < 2; ++n) acc[a][b][m][n] = (f32x4){0.f, 0.f, 0.f, 0.f};
        cur = nxt; cA = nA; cB = nB; ++ui;
        if constexpr (ALIGN_EPI) { if (wr == 1) PG8_BAR; }
    }
    PG8_WAIT_V(0);
    if constexpr (!ALIGN_EPI) { if (wr == 0) PG8_BAR; }
    PG8_BAR;
    if constexpr (Epi::AFTER_DRAIN) { E.fused(acc, cur, wr, wc, fr, fq, lds, wid, lane); S.done(cur); }
#undef PG8_SA
#undef PG8_SB
#undef PG8_STAGE
#undef PG8_LDA
#undef PG8_LDB
#undef PG8_MMA
#undef PG8_WAIT_V
#undef PG8_WAIT_L
#undef PG8_BAR
#undef PG8_SCHED
}
}
#include <hip/hip_bf16.h>
#include <cmath>
namespace attn_body {
using bf16=__hip_bfloat16;
using bf16x8=__attribute__((ext_vector_type(8)))short;
using s16x4=__attribute__((ext_vector_type(4)))short;
using f32x16=__attribute__((ext_vector_type(16)))float;
using u32x4=__attribute__((ext_vector_type(4)))unsigned;
constexpr int D=64,DM=1024,KVP=256;
constexpr int NW=8,QBLK=32,QB=QBLK*NW,KVBLK=64;
constexpr int ATTN_PITCH=DM, ATTN_UNIT_ROWS=QB;
__device__ __forceinline__ int crow(int r,int hi){return (r&3)+8*(r>>2)+4*hi;}
#define SBAR() __builtin_amdgcn_sched_barrier(0)
__device__ __forceinline__ void cmask(f32x16&p0,f32x16&p1,int jb,int qrel,int hi){
  const float NEG=-INFINITY; int kb=64*jb+4*hi;
  #pragma unroll
  for(int r=0;r<16;++r){int kv=kb+(r&3)+8*(r>>2); if(kv>qrel)p0[r]=NEG; if(kv+32>qrel)p1[r]=NEG;}
}

constexpr int NSLOT=3, SLOTB=8192;
constexpr int LDS_K=0, LDS_V=NSLOT*SLOTB, LDS_WS=2*NSLOT*SLOTB, LDS_OST=LDS_WS+NW*64*4, LDS_BYTES=LDS_OST+NW*4096;
constexpr float C2=0.125f*1.4426950408889634f;
__device__ __forceinline__ void glds16(const void*gsrc,unsigned lds_dst){unsigned keep;
  asm volatile("s_mov_b32 %0, m0\n\ts_mov_b32 m0, %2\n\ts_nop 0\n\tglobal_load_lds_dwordx4 %1, off\n\ts_mov_b32 m0, %0":"=&s"(keep):"v"(gsrc),"s"(lds_dst):"memory");}
__device__ __forceinline__ float max3f(float a,float b,float c){float r;asm("v_max3_f32 %0, %1, %2, %3":"=v"(r):"v"(a),"v"(b),"v"(c));return r;}
__device__ __forceinline__ float max2f(float a,float b){float r;asm("v_max_f32_e32 %0, %1, %2":"=v"(r):"v"(a),"v"(b));return r;}
__device__ __forceinline__ float fadd_s(float a,float b){float r;asm("v_add_f32_e32 %0, %1, %2":"=v"(r):"v"(a),"v"(b));return r;}
__device__ __forceinline__ float fsub_s(float a,float b){float r;asm("v_sub_f32_e32 %0, %1, %2":"=v"(r):"v"(a),"v"(b));return r;}
typedef float f32x2_t __attribute__((ext_vector_type(2))); typedef __bf16 bf16x2_t __attribute__((ext_vector_type(2)));
__device__ __forceinline__ unsigned cvtpk_s(float lo,float hi){f32x2_t v={lo,hi};bf16x2_t b=__builtin_convertvector(v,bf16x2_t);return __builtin_bit_cast(unsigned,b);}
#define WAIT_BAR(N) asm volatile("s_waitcnt vmcnt(" #N ") lgkmcnt(0)\n\ts_barrier":::"memory")

__device__ __forceinline__ void qkt(f32x16&p0,f32x16&p1,const char*Kslot,const bf16x8*qr,const f32x16&negm,int r32,int hi){
  const char*kb=Kslot+hi*1024+r32*16;
  #pragma unroll
  for(int d0=0;d0<4;++d0){
    const bf16x8 b0=*reinterpret_cast<const bf16x8*>(kb+d0*2048);
    const bf16x8 b1=*reinterpret_cast<const bf16x8*>(kb+d0*2048+512);
    if(d0==0){p0=__builtin_amdgcn_mfma_f32_32x32x16_bf16(b0,qr[0],negm,0,0,0);p1=__builtin_amdgcn_mfma_f32_32x32x16_bf16(b1,qr[0],negm,0,0,0);}
    else{p0=__builtin_amdgcn_mfma_f32_32x32x16_bf16(b0,qr[d0],p0,0,0,0);p1=__builtin_amdgcn_mfma_f32_32x32x16_bf16(b1,qr[d0],p1,0,0,0);}}
}
typedef __attribute__((address_space(3))) const char* lds_cptr;
typedef short v4i16_t __attribute__((ext_vector_type(4)));
__device__ __forceinline__ void kload8(bf16x8*kf,lds_cptr kp){
  kf[0]=*(const __attribute__((address_space(3))) bf16x8*)(kp);      kf[1]=*(const __attribute__((address_space(3))) bf16x8*)(kp+512);
  kf[2]=*(const __attribute__((address_space(3))) bf16x8*)(kp+2048); kf[3]=*(const __attribute__((address_space(3))) bf16x8*)(kp+2560);
  kf[4]=*(const __attribute__((address_space(3))) bf16x8*)(kp+4096); kf[5]=*(const __attribute__((address_space(3))) bf16x8*)(kp+4608);
  kf[6]=*(const __attribute__((address_space(3))) bf16x8*)(kp+6144); kf[7]=*(const __attribute__((address_space(3))) bf16x8*)(kp+6656);
}
__device__ __forceinline__ void kload2(bf16x8*kf,lds_cptr kp,int j){ kf[2*j]=*(const __attribute__((address_space(3))) bf16x8*)(kp+j*2048); kf[2*j+1]=*(const __attribute__((address_space(3))) bf16x8*)(kp+j*2048+512); }
__device__ __forceinline__ s16x4 vtr(lds_cptr p){ return __builtin_bit_cast(s16x4,__builtin_amdgcn_ds_read_tr16_b64_v4i16((__attribute__((address_space(3))) v4i16_t*)p)); }
__device__ __forceinline__ float rowmax(const f32x16&p0,const f32x16&p1){
  float a=max3f(p0[0],p0[1],p1[0]),b=max3f(p0[2],p0[3],p1[1]);a=max3f(a,p1[2],p1[3]);
  #pragma unroll
  for(int r=4;r<16;r+=4){a=max3f(a,p0[r],p0[r+1]);b=max3f(b,p0[r+2],p0[r+3]);a=max3f(a,p1[r],p1[r+1]);b=max3f(b,p1[r+2],p1[r+3]);}
  const float m=max2f(a,b);
  auto rr=__builtin_amdgcn_permlane32_swap(__float_as_uint(m),__float_as_uint(m),false,false);
  return max2f(__uint_as_float(rr[0]),__uint_as_float(rr[1]));
}
__device__ __forceinline__ void pv(f32x16*o,int vb,bf16x8 pa0,bf16x8 pa1,bf16x8 pa2,bf16x8 pa3){
  #pragma unroll
  for(int d0=0;d0<2;++d0){s16x4 lo[4],hi[4];
    #pragma unroll
    for(int ks=0;ks<4;++ks){
      asm volatile("ds_read_b64_tr_b16 %0,%1 offset:%c2":"=&v"(lo[ks]):"v"(vb),"i"(d0*4096+ks*1024):"memory");
      asm volatile("ds_read_b64_tr_b16 %0,%1 offset:%c2":"=&v"(hi[ks]):"v"(vb),"i"(d0*4096+ks*1024+512):"memory");}
    asm volatile("s_waitcnt lgkmcnt(0)":::"memory");SBAR();
    #define PK(k) (bf16x8){lo[k][0],lo[k][1],lo[k][2],lo[k][3],hi[k][0],hi[k][1],hi[k][2],hi[k][3]}
    o[d0]=__builtin_amdgcn_mfma_f32_32x32x16_bf16(pa0,PK(0),o[d0],0,0,0);
    o[d0]=__builtin_amdgcn_mfma_f32_32x32x16_bf16(pa1,PK(1),o[d0],0,0,0);
    o[d0]=__builtin_amdgcn_mfma_f32_32x32x16_bf16(pa2,PK(2),o[d0],0,0,0);
    o[d0]=__builtin_amdgcn_mfma_f32_32x32x16_bf16(pa3,PK(3),o[d0],0,0,0);
    #undef PK
  }
}

#ifndef ATTN_STORE16
#define ATTN_STORE16(p,v) (*(u32x4*)(p)=(v))
#endif
template<int THRL> __device__ __forceinline__ void attn_unit(long qrow0,long kvrow0,const int NT,int h,const bf16*Q,const bf16*__restrict__ K,const bf16*__restrict__ V,bf16*O,char*shm){
  int tid_=threadIdx.x; asm volatile("":"+v"(tid_)); const int tid=tid_,lane=tid&63,r32=lane&31,hi=lane>>5; const int wid=__builtin_amdgcn_readfirstlane(tid>>6);
  const int g=h>>2;
  const bf16*Qw=Q+(qrow0+wid*QBLK)*DM+h*D;
  const bf16*Kh=K+kvrow0*KVP+g*D,*Vh=V+kvrow0*KVP+g*D;
  const unsigned lds0=(unsigned)(uintptr_t)shm;
  float*wsf=(float*)(shm+LDS_WS)+wid*64;
  const bf16*ksrc=Kh+(long)lane*KVP+wid*8;
  const bf16*vsrc=Vh+(long)(16*(wid&3)+(lane>>2))*KVP+(wid>>2)*32+(lane&3)*8;
  const unsigned kdst=lds0+LDS_K+wid*1024, vdst=lds0+LDS_V+wid*1024;
  #define DMA_K(t,slot) glds16(ksrc+(long)(t)*KVBLK*KVP,(unsigned)__builtin_amdgcn_readfirstlane(kdst+(slot)))
  #define DMA_V(t,slot) glds16(vsrc+(long)(t)*KVBLK*KVP,(unsigned)__builtin_amdgcn_readfirstlane(vdst+(slot)))
  const int vb0=(int)(lds0+LDS_V)+((lane>>4)&1)*32+(lane&3)*8+(4*hi+((lane&15)>>2))*64;
  const char*Kbase=shm+LDS_K; bf16x8 kf[8];
  const lds_cptr shm3=(lds_cptr)shm; const lds_cptr kp0=shm3+LDS_K+hi*1024+r32*16; const lds_cptr vp0=shm3+LDS_V+((lane>>4)&1)*32+(lane&3)*8+(4*hi+((lane&15)>>2))*64;
  DMA_K(0,0);DMA_V(0,0);DMA_K(1,SLOTB);
  bf16x8 qr[4];
  #pragma unroll
  for(int d0=0;d0<4;++d0)qr[d0]=*reinterpret_cast<const bf16x8*>(&Qw[(long)r32*DM+d0*16+hi*8]);
  float mhat=0.f,l_reg=0.f;f32x16 o[2];o[0]=f32x16{};o[1]=f32x16{};f32x16 negm=f32x16{};asm volatile("":"+v"(negm));
  const int qrel=wid*QBLK+r32;
  #define CMASK(P0,P1,t) do{}while(0)
  bool resc=false;
  #define START(P0,P1) do{ const float rm=rowmax(P0,P1); resc=false; \
    { const float dl=rm; mhat=fadd_s(mhat,dl); \
      _Pragma("unroll") for(int r=0;r<16;++r){P0[r]=fsub_s(P0[r],dl);P1[r]=fsub_s(P1[r],dl);} \
      _Pragma("unroll") for(int r=0;r<16;++r)negm[r]=-mhat; asm volatile("":"+v"(negm)); } \
    _Pragma("unroll") for(int r=0;r<16;++r)P0[r]=__builtin_amdgcn_exp2f(P0[r]); }while(0)
  #define RESC() do{ if(resc){ asm volatile("s_waitcnt lgkmcnt(0)":::"memory"); \
      _Pragma("unroll") for(int d_=0;d_<2;++d_) _Pragma("unroll") for(int r=0;r<16;++r)o[d_][r]*=wsf[crow(r,hi)]; } }while(0)
  f32x16 pA0,pA1,pB0,pB1;
  int sl_prev=0,sl_cur=0,sl_next=SLOTB;
  #define ROT() do{sl_prev=sl_cur;sl_cur=sl_next;sl_next=(sl_next==(NSLOT-1)*SLOTB)?0:sl_next+SLOTB;}while(0)
  DMA_K(2,2*SLOTB);
  WAIT_BAR(3);
  qkt(pA0,pA1,Kbase,qr,negm,r32,hi);asm volatile("s_nop 15\n\ts_nop 7":"+v"(pA0),"+v"(pA1));CMASK(pA0,pA1,0);
  START(pA0,pA1);
  _Pragma("unroll") for(int r=0;r<16;++r)pA1[r]=__builtin_amdgcn_exp2f(pA1[r]);
  WAIT_BAR(0);
  DMA_K(3,0);DMA_V(1,SLOTB);
  ROT();
  kload8(kf,kp0+sl_cur);
  WAIT_BAR(2);
  s16x4 vlo[8],vhi[8]; u32x4 pw0,pw1,pw2,pw3;
  #define PKW(P,B) cvtpk_s(P[B],P[B+1])
  #define PAF(k) __builtin_bit_cast(bf16x8,pw##k)
  #define VFR(i) (bf16x8){vlo[i][0],vlo[i][1],vlo[i][2],vlo[i][3],vhi[i][0],vhi[i][1],vhi[i][2],vhi[i][3]}
  #define PIN(x) asm volatile("":"+v"(x))
  #define MX3(a,b,c) __builtin_fmaxf(__builtin_fmaxf((a),(b)),(c))
  #define GAPA(MF,A0,A1,A2,A3,W0,W1,PW) do{ MF; sacc+=A0; sacc+=A1; sacc+=A2; sacc+=A3; PIN(sacc); W0; W1; PIN(PW); SBAR(); }while(0)
  #define EX(v) __builtin_amdgcn_exp2f(v)
  #define GAPB(MF,X,B) do{ MF; X[B]=EX(X[B]); X[B+1]=EX(X[B+1]); X[B+2]=EX(X[B+2]); X[B+3]=EX(X[B+3]); PIN(X); SBAR(); }while(0)
  #define VRD(i) do{ vlo[i]=vtr(vp_+(((i)>>2)*4096+((i)&3)*1024)); vhi[i]=vtr(vp_+(((i)>>2)*4096+((i)&3)*1024+512)); }while(0)
  #define KRD(G,j) do{ if(G){ kload2(kf,kp0+sl_next,j); SBAR(); } }while(0)
  #define STEP(C0,C1,P0,P1,t,GK,GV,GL) do{ SBAR(); \
    const lds_cptr vp_=vp0+sl_prev; \
    VRD(0); SBAR(); float sacc=(P0[0]+P0[1]); \
    GAPA(C0=__builtin_amdgcn_mfma_f32_32x32x16_bf16(kf[0],qr[0],negm,0,0,0), P0[2],P0[3],P0[4],P0[5],     pw0[0]=PKW(P0,0), pw0[1]=PKW(P0,2), pw0); \
    VRD(4); SBAR(); GAPA(C1=__builtin_amdgcn_mfma_f32_32x32x16_bf16(kf[1],qr[0],negm,0,0,0), P0[6],P0[7],P0[8],P0[9],     pw0[2]=PKW(P0,4), pw0[3]=PKW(P0,6), pw0); \
    VRD(1); SBAR(); GAPA(C0=__builtin_amdgcn_mfma_f32_32x32x16_bf16(kf[2],qr[1],C0,0,0,0),   P0[10],P0[11],P0[12],P0[13], pw1[0]=PKW(P0,8), pw1[1]=PKW(P0,10), pw1); \
    VRD(5); SBAR(); GAPA(C1=__builtin_amdgcn_mfma_f32_32x32x16_bf16(kf[3],qr[1],C1,0,0,0),   P0[14],P0[15],P1[0],P1[1],   pw1[2]=PKW(P0,12),pw1[3]=PKW(P0,14), pw1); \
    VRD(2); SBAR(); GAPA(C0=__builtin_amdgcn_mfma_f32_32x32x16_bf16(kf[4],qr[2],C0,0,0,0),   P1[2],P1[3],P1[4],P1[5],     pw2[0]=PKW(P1,0), pw2[1]=PKW(P1,2), pw2); \
    VRD(6); SBAR(); GAPA(C1=__builtin_amdgcn_mfma_f32_32x32x16_bf16(kf[5],qr[2],C1,0,0,0),   P1[6],P1[7],P1[8],P1[9],     pw2[2]=PKW(P1,4), pw2[3]=PKW(P1,6), pw2); \
    VRD(3); SBAR(); GAPA(C0=__builtin_amdgcn_mfma_f32_32x32x16_bf16(kf[6],qr[3],C0,0,0,0),   P1[10],P1[11],P1[12],P1[13], pw3[0]=PKW(P1,8), pw3[1]=PKW(P1,10), pw3); \
    VRD(7); SBAR(); GAPA(C1=__builtin_amdgcn_mfma_f32_32x32x16_bf16(kf[7],qr[3],C1,0,0,0),   P1[14],P1[15],0.f,0.f,       pw3[2]=PKW(P1,12),pw3[3]=PKW(P1,14), pw3); \
    l_reg+=sacc; \
    if(GK){DMA_K((t)+3,sl_cur);} if(GV){DMA_V((t)+1,sl_next);} \
    CMASK(C0,C1,t); \
    { float a=MX3(C0[0],C0[1],C1[0]),b=MX3(C0[2],C0[3],C1[1]); a=MX3(a,C1[2],C1[3]); \
      _Pragma("unroll") for(int r=4;r<16;r+=4){a=MX3(a,C0[r],C0[r+1]);b=MX3(b,C0[r+2],C0[r+3]);a=MX3(a,C1[r],C1[r+1]);b=MX3(b,C1[r+2],C1[r+3]);} \
      float rm=__builtin_fmaxf(a,b); { auto rr=__builtin_amdgcn_permlane32_swap(__float_as_uint(rm),__float_as_uint(rm),false,false); rm=__builtin_fmaxf(__uint_as_float(rr[0]),__uint_as_float(rr[1])); } \
      resc=false; \
      if(__builtin_expect(__any(rm>(float)THRL),0)){ const float dl=__builtin_fmaxf(rm,0.f); mhat+=dl; \
        _Pragma("unroll") for(int r=0;r<16;++r){C0[r]-=dl;C1[r]-=dl;} \
        _Pragma("unroll") for(int r=0;r<16;++r)negm[r]=-mhat; asm volatile("":"+v"(negm)); \
        const float f=__builtin_amdgcn_exp2f(-dl); l_reg*=f; if(hi==0)wsf[r32]=f; resc=true; } } \
    SBAR(); \
    GAPB(o[0]=__builtin_amdgcn_mfma_f32_32x32x16_bf16(PAF(0),VFR(0),o[0],0,0,0), C0,0); \
    GAPB(o[1]=__builtin_amdgcn_mfma_f32_32x32x16_bf16(PAF(0),VFR(4),o[1],0,0,0), C0,4); \
    KRD(GL,0); GAPB(o[0]=__builtin_amdgcn_mfma_f32_32x32x16_bf16(PAF(1),VFR(1),o[0],0,0,0), C0,8); \
    KRD(GL,1); GAPB(o[1]=__builtin_amdgcn_mfma_f32_32x32x16_bf16(PAF(1),VFR(5),o[1],0,0,0), C0,12); \
    KRD(GL,2); GAPB(o[0]=__builtin_amdgcn_mfma_f32_32x32x16_bf16(PAF(2),VFR(2),o[0],0,0,0), C1,0); \
    KRD(GL,3); GAPB(o[1]=__builtin_amdgcn_mfma_f32_32x32x16_bf16(PAF(2),VFR(6),o[1],0,0,0), C1,4); \
    GAPB(o[0]=__builtin_amdgcn_mfma_f32_32x32x16_bf16(PAF(3),VFR(3),o[0],0,0,0), C1,8); \
    GAPB(o[1]=__builtin_amdgcn_mfma_f32_32x32x16_bf16(PAF(3),VFR(7),o[1],0,0,0), C1,12); \
    }while(0)
  int t=1;
  #undef CMASK
  #define CMASK(P0,P1,t) do{}while(0)
  for(;t+5<NT;t+=2){
    STEP(pB0,pB1,pA0,pA1,t,true,true,true);     WAIT_BAR(2); RESC(); ROT();
    STEP(pA0,pA1,pB0,pB1,t+1,true,true,true);   WAIT_BAR(2); RESC(); ROT();
  }
  #undef CMASK
  #define CMASK(P0,P1,t) do{}while(0)
  #define ENDW(tt) do{ if((tt)+3<NT){WAIT_BAR(2);} else if((tt)+2<NT){WAIT_BAR(1);} else {WAIT_BAR(0);} }while(0)
  for(;t+1<NT;t+=2){
    STEP(pB0,pB1,pA0,pA1,t,(t+3<NT),(t+1<NT),(t+1<NT));       ENDW(t);   RESC(); ROT();
    STEP(pA0,pA1,pB0,pB1,t+1,(t+4<NT),(t+2<NT),(t+2<NT));     ENDW(t+1); RESC(); ROT();
  }
  STEP(pB0,pB1,pA0,pA1,NT-1,false,false,false); RESC();
  { float sacc=pB0[0]+pB0[1]; _Pragma("unroll") for(int r=2;r<16;++r)sacc+=pB0[r]; _Pragma("unroll") for(int r=0;r<16;++r)sacc+=pB1[r]; l_reg+=sacc;
    pw0=(u32x4){PKW(pB0,0),PKW(pB0,2),PKW(pB0,4),PKW(pB0,6)};pw1=(u32x4){PKW(pB0,8),PKW(pB0,10),PKW(pB0,12),PKW(pB0,14)};pw2=(u32x4){PKW(pB1,0),PKW(pB1,2),PKW(pB1,4),PKW(pB1,6)};pw3=(u32x4){PKW(pB1,8),PKW(pB1,10),PKW(pB1,12),PKW(pB1,14)};
    SBAR(); pv(o,vb0+sl_cur,PAF(0),PAF(1),PAF(2),PAF(3)); }
  #undef PKW
  #undef PAF
  #undef VFR
  #undef PIN
  #undef MX3
  #undef GAPA
  #undef GAPB
  #undef EX
  #undef VRD
  #undef KRD
  #undef STEP
  #undef ENDW
  {auto rr=__builtin_amdgcn_permlane32_swap(__float_as_uint(l_reg),__float_as_uint(l_reg),false,false);l_reg=__uint_as_float(rr[0])+__uint_as_float(rr[1]);}
  if(hi==0)wsf[32+r32]=l_reg;asm volatile("s_waitcnt lgkmcnt(0)":::"memory");
  float rli[16];
  #pragma unroll
  for(int r=0;r<16;++r)rli[r]=__builtin_amdgcn_rcpf(wsf[32+crow(r,hi)]);
  bf16*Ow=O+(qrow0+wid*QBLK)*DM+h*D;
  { bf16*stg=(bf16*)(shm+LDS_OST)+wid*2048;
    #pragma unroll
    for(int r=0;r<16;++r){const int orow=crow(r,hi);
      #pragma unroll
      for(int d0=0;d0<2;++d0)stg[orow*64+d0*32+r32]=__float2bfloat16(o[d0][r]*rli[r]);}
    asm volatile("s_waitcnt lgkmcnt(0)":::"memory");
    #pragma unroll
    for(int i=0;i<4;++i){const int row=i*8+(lane>>3),ch=lane&7; const u32x4 v=*(const u32x4*)(stg+row*64+ch*8); ATTN_STORE16(Ow+(long)row*DM+ch*8,v);} }
  asm volatile("s_waitcnt lgkmcnt(0)\n\ts_barrier":::"memory");
  #undef DMA_K
  #undef DMA_V
  #undef CMASK
  #undef START
  #undef RESC
  #undef ROT
}
constexpr int ATTN_LDS_BYTES=LDS_BYTES;
#undef SBAR
#undef WAIT_BAR
}
constexpr int NB = 16, SEQ = 4096, CTXL = 256, TPB = SEQ + CTXL, DM = 1024, FF = 4096, MROWS = NB * TPB;
constexpr int NMOD = 6 * DM;
constexpr int NWAVES = 8;
constexpr int LDS_BYTES = 147456;
constexpr float RMS_EPS = 1e-6f, GN_EPS_F = 64.0f * 1e-5f;
constexpr float QSCALE = 0.125f * 1.4426950408889634f;

#define LAS __attribute__((address_space(3)))
typedef unsigned short bf16;
typedef float f32x4 __attribute__((ext_vector_type(4)));
typedef float f32x2 __attribute__((ext_vector_type(2)));
typedef unsigned u32x4 __attribute__((ext_vector_type(4)));
typedef unsigned u32x2 __attribute__((ext_vector_type(2)));
typedef short bf16x8 __attribute__((ext_vector_type(8)));
using pg8::Unit; using pg8::cvt_pk_bf16;
constexpr int HALF = 128, BM = 256;

constexpr size_t MiB = 1u << 20;
constexpr size_t WS_ROWSQ = 64 * 1024  , WS_SW = 2 * MiB  , WS_ZERO_BYTES = 2 * MiB;
constexpr size_t WS_MODP = 4 * MiB, WS_MOD = 11 * MiB, WS_ROPE = 13 * MiB, WS_BONUS = 15 * MiB, WS_CTX = 24 * MiB, WS_W = 40 * MiB, WS_ACT = 132 * MiB, WS_NEED = 1024 * MiB;
constexpr size_t W_QKV = 0, W_WO = 6 * MiB, W_IN = 10 * MiB, W_OUT = 42 * MiB, W_R1 = 74 * MiB, W_G2 = 88 * MiB, W_RWO = 89 * MiB, W_POOL = 91 * MiB;
constexpr size_t ACT1 = 136 * MiB;

__device__ __forceinline__ float bflo(unsigned u) { return __uint_as_float(u << 16); }
__device__ __forceinline__ float bfhi(unsigned u) { return __uint_as_float(u & 0xffff0000u); }
__device__ __forceinline__ float bf2f(unsigned short u) { return __uint_as_float(((unsigned)u) << 16); }
__device__ __forceinline__ float fsigmoid(float x) { return __builtin_amdgcn_rcpf(1.0f + __builtin_amdgcn_exp2f(-1.4426950408889634f * x)); }
__device__ __forceinline__ u32x4 pack8(f32x4 a, f32x4 b) { u32x4 w; w.x = cvt_pk_bf16(a[0], a[1]); w.y = cvt_pk_bf16(a[2], a[3]); w.z = cvt_pk_bf16(b[0], b[1]); w.w = cvt_pk_bf16(b[2], b[3]); return w; }
__device__ __forceinline__ void unpack8(u32x4 w, f32x4& a, f32x4& b) { a = (f32x4){bflo(w.x), bfhi(w.x), bflo(w.y), bfhi(w.y)}; b = (f32x4){bflo(w.z), bfhi(w.z), bflo(w.w), bfhi(w.w)}; }
__device__ __forceinline__ float wave_sum(float v) {
#pragma unroll
    for (int o = 1; o < 64; o <<= 1) v += __shfl_xor(v, o);
    return v;
}


struct EpiRelu2 {
    static constexpr bool PERM = true, AFTER_DRAIN = false;
    bf16* O; int ldc; const float* rowsq; const float* sw;
    __device__ __forceinline__ void operator()(const f32x4 (&acc)[2][2][4][2], const Unit& u, int wr_, int wc_, int fr_, int fq_) const {
        int wr = wr_, wc = wc_, fr = fr_, fq = fq_; asm volatile("" : "+s"(wr), "+s"(wc), "+v"(fr), "+v"(fq));
        const int row0 = u.pm * BM + wr * 64 + fr, col0 = u.pn * BM + wc * 32 + 8 * fq;
        const f32x4 z = (f32x4){0.f, 0.f, 0.f, 0.f};
        const int bb = u.pm / 17; const float* swr = sw + (size_t)((u.pm - bb * 17 == 16) ? 16 : bb) * FF + col0;
        f32x4 bv[2][2];
#pragma unroll
        for (int bj = 0; bj < 2; ++bj)
#pragma unroll
            for (int n = 0; n < 2; ++n) bv[bj][n] = *(const f32x4*)(swr + bj * HALF + 4 * n);
#pragma unroll
        for (int ai = 0; ai < 2; ++ai)
#pragma unroll
            for (int m = 0; m < 4; ++m) { bf16* rowp = O + (size_t)(row0 + ai * HALF + m * 16) * ldc + col0;
                const float rinv = __builtin_amdgcn_rsqf(rowsq[row0 + ai * HALF + m * 16] * (1.0f / DM) + RMS_EPS);
#pragma unroll
                for (int bj = 0; bj < 2; ++bj) { f32x4 v0 = __builtin_elementwise_max(acc[ai][bj][m][0] * rinv + bv[bj][0], z), v1 = __builtin_elementwise_max(acc[ai][bj][m][1] * rinv + bv[bj][1], z);
                    *(u32x4*)(rowp + bj * HALF) = pack8(v0 * v0, v1 * v1); } }
    }
};

template <bool ATOMIC> struct EpiResidT {
    static constexpr bool PERM = false, AFTER_DRAIN = false;
    const float* srcL; const float* srcC; float* dstL; float* dstC; const float* mod; int slot; const float* colscale;
    bf16* Hout; float* rowsq; const float* gamma; const float* hscale;
    const float* pend; const float* pgate;
    __device__ __forceinline__ void operator()(const f32x4 (&acc)[2][2][4][2], const Unit& u, int wr_, int wc_, int fr_, int fq_) const {
        int wr = wr_, wc = wc_, fr = fr_, fq = fq_; asm volatile("" : "+s"(wr), "+s"(wc), "+v"(fr), "+v"(fq));
        const int b = u.pm / 17, tt = u.pm - b * 17; const bool ctx = (tt == 16);
        const size_t tb = ctx ? (size_t)b * CTXL * DM : ((size_t)b * SEQ + (size_t)tt * 256) * DM;
        const float* s = (ctx ? srcC : srcL) + tb; float* d = (ctx ? dstC : dstL) + tb;
        const int col0 = u.pn * BM + wc * 32 + 4 * fq;
        const float* gate = mod + (size_t)(ctx ? 16 : b) * NMOD + slot * DM + col0;
        f32x4 gv[2][2];
#pragma unroll
        for (int bj = 0; bj < 2; ++bj)
#pragma unroll
            for (int n = 0; n < 2; ++n) { gv[bj][n] = *(const f32x4*)(gate + bj * HALF + n * 16); if (colscale) gv[bj][n] = gv[bj][n] * *(const f32x4*)(colscale + col0 + bj * HALF + n * 16); }
        f32x4 gs[2][2];
        if (Hout != nullptr) { const float* sc4 = hscale + (size_t)(ctx ? 16 : b) * NMOD + col0;
#pragma unroll
            for (int bj = 0; bj < 2; ++bj)
#pragma unroll
                for (int n = 0; n < 2; ++n) gs[bj][n] = *(const f32x4*)(gamma + col0 + bj * HALF + n * 16) * (*(const f32x4*)(sc4 + bj * HALF + n * 16) + 1.0f); }
#pragma unroll
        for (int ai = 0; ai < 2; ++ai)
#pragma unroll
            for (int m = 0; m < 4; ++m) { const size_t off = (size_t)(ai * HALF + wr * 64 + m * 16 + fr) * DM + col0; float ssq = 0.f; const size_t grow = (size_t)u.pm * BM + (ai * HALF + wr * 64 + m * 16 + fr);
#pragma unroll
                for (int bj = 0; bj < 2; ++bj)
#pragma unroll
                    for (int n = 0; n < 2; ++n) {
                        if constexpr (ATOMIC) { const f32x4 v = gv[bj][n] * acc[ai][bj][m][n]; float* p = d + off + bj * HALF + n * 16;
#pragma unroll
                            for (int e = 0; e < 4; ++e) (void)__hip_atomic_fetch_add(p + e, v[e], __ATOMIC_RELAXED, __HIP_MEMORY_SCOPE_AGENT); }
                        else { f32x4 bs = *(const f32x4*)(s + off + bj * HALF + n * 16);
                            if (pend != nullptr && ctx) { const float* pp = pend + tb + off + bj * HALF + n * 16; const f32x4 pg = *(const f32x4*)(pgate + col0 + bj * HALF + n * 16);
                                bs += pg * ((*(const f32x4*)(pp) + *(const f32x4*)(pp + (size_t)NB * CTXL * DM)) + (*(const f32x4*)(pp + (size_t)2 * NB * CTXL * DM) + *(const f32x4*)(pp + (size_t)3 * NB * CTXL * DM))); }
                            const f32x4 xn = bs + gv[bj][n] * acc[ai][bj][m][n]; *(f32x4*)(d + off + bj * HALF + n * 16) = xn;
                            if (Hout != nullptr) { ssq += (xn[0] * xn[0] + xn[1] * xn[1]) + (xn[2] * xn[2] + xn[3] * xn[3]); const f32x4 hq = xn * gs[bj][n];
                                u32x2 w2; w2.x = cvt_pk_bf16(hq[0], hq[1]); w2.y = cvt_pk_bf16(hq[2], hq[3]); *(u32x2*)(Hout + grow * DM + col0 + bj * HALF + n * 16) = w2; } } }
                if (Hout != nullptr) { ssq += __shfl_xor(ssq, 16); ssq += __shfl_xor(ssq, 32); if (fq == 0) (void)__hip_atomic_fetch_add(rowsq + grow, ssq, __ATOMIC_RELAXED, __HIP_MEMORY_SCOPE_AGENT); }
                if (m == 3) asm volatile("" ::: "memory"); }
    }
};

typedef EpiResidT<false> EpiResid;
struct EpiPartial {
    static constexpr bool PERM = false, AFTER_DRAIN = false;
    float* part; int kq_len;
    __device__ __forceinline__ void operator()(const f32x4 (&acc)[2][2][4][2], const Unit& u, int wr_, int wc_, int fr_, int fq_) const {
        int wr = wr_, wc = wc_, fr = fr_, fq = fq_; asm volatile("" : "+s"(wr), "+s"(wc), "+v"(fr), "+v"(fq));
        const int b = u.pm / 17; const int kq = u.kofs / kq_len; const int col0 = u.pn * BM + wc * 32 + 4 * fq;
        float* d = part + ((size_t)kq * NB * CTXL + (size_t)b * CTXL) * DM + col0;
#pragma unroll
        for (int ai = 0; ai < 2; ++ai)
#pragma unroll
            for (int m = 0; m < 4; ++m) { const size_t off = (size_t)(ai * HALF + wr * 64 + m * 16 + fr) * DM;
#pragma unroll
                for (int bj = 0; bj < 2; ++bj)
#pragma unroll
                    for (int n = 0; n < 2; ++n) *(f32x4*)(d + off + bj * HALF + n * 16) = acc[ai][bj][m][n]; }
    }
};

struct EpiQKV {
    static constexpr bool PERM = true, AFTER_DRAIN = false;
    bf16* Q; bf16* Kb; bf16* Vb; const float* qg; const float* kg; const float* rope;
    __device__ __forceinline__ void operator()(const f32x4 (&acc)[2][2][4][2], const Unit& u, int wr_, int wc_, int fr_, int fq_) const {
        int wr = wr_, wc = wc_, fr = fr_, fq = fq_; asm volatile("" : "+s"(wr), "+s"(wc), "+v"(fr), "+v"(fq));
        const int tt = u.pm % 17; const int row0 = u.pm * BM + wr * 64 + fr;
        if (u.pn == 5) {
#pragma unroll
            for (int ai = 0; ai < 2; ++ai)
#pragma unroll
                for (int m = 0; m < 4; ++m) { bf16* rp = Vb + (size_t)(row0 + ai * HALF + m * 16) * 256 + wc * 64 + 8 * fq;
#pragma unroll
                    for (int bj = 0; bj < 2; ++bj) *(u32x4*)(rp + 32 * bj) = pack8(acc[ai][bj][m][0], acc[ai][bj][m][1]); }
            return;
        }
        const bool isq = u.pn < 4; const float* gain = isq ? qg : kg; const float osc = isq ? QSCALE : 1.0f;
        f32x4 g[2][2];
#pragma unroll
        for (int bj = 0; bj < 2; ++bj)
#pragma unroll
            for (int n = 0; n < 2; ++n) g[bj][n] = *(const f32x4*)(gain + 32 * bj + 8 * fq + 4 * n) * osc;
#pragma unroll
        for (int ai = 0; ai < 2; ++ai)
#pragma unroll
            for (int m = 0; m < 4; ++m) {
                float ss = 0.f;
#pragma unroll
                for (int bj = 0; bj < 2; ++bj)
#pragma unroll
                    for (int n = 0; n < 2; ++n) { const f32x4 x = acc[ai][bj][m][n]; ss += (x[0] * x[0] + x[1] * x[1]) + (x[2] * x[2] + x[3] * x[3]); }
                ss += __shfl_xor(ss, 16); ss += __shfl_xor(ss, 32);
                const float rinv = __builtin_amdgcn_rsqf(ss * (1.0f / 64.0f) + RMS_EPS);
                const int rl = ai * HALF + wr * 64 + m * 16 + fr;
                const int t = tt * 256 + rl;
                const float* rp = rope + (size_t)t * 64 + 8 * fq;
                f32x4 o1[2], o2[2];
#pragma unroll
                for (int n = 0; n < 2; ++n) { const f32x4 c = *(const f32x4*)(rp + 4 * n), s = *(const f32x4*)(rp + 32 + 4 * n);
                    const f32x4 x1 = acc[ai][0][m][n] * rinv * g[0][n], x2 = acc[ai][1][m][n] * rinv * g[1][n];
                    o1[n] = x1 * c - x2 * s; o2[n] = x1 * s + x2 * c; }
                const size_t grow = (size_t)(u.pm * BM + rl);
                bf16* dst = isq ? Q + grow * DM + (u.pn * 4 + wc) * 64 + 8 * fq : Kb + grow * 256 + wc * 64 + 8 * fq;
                *(u32x4*)(dst) = pack8(o1[0], o1[1]); *(u32x4*)(dst + 32) = pack8(o2[0], o2[1]);
            }
    }
};

struct EpiRwkv1 {
    static constexpr bool PERM = true, AFTER_DRAIN = false;
    bf16* Oo; bf16* KK; bf16* P; const float* k_k; int pn_base;
    __device__ __forceinline__ void operator()(const f32x4 (&acc)[2][2][4][2], const Unit& u, int wr_, int wc_, int fr_, int fq_) const {
        int wr = wr_, wc = wc_, fr = fr_, fq = fq_; asm volatile("" : "+s"(wr), "+s"(wc), "+v"(fr), "+v"(fq));
        const int row0 = u.pm * BM + wr * 64 + fr; const int pn = u.pn + pn_base;
        if (pn >= 12) {
            const int ob = 256 * (pn - 12) + 64 * wc + 8 * fq;
#pragma unroll
            for (int ai = 0; ai < 2; ++ai)
#pragma unroll
                for (int m = 0; m < 4; ++m) { bf16* rp = P + (size_t)(row0 + ai * HALF + m * 16) * 512 + ob;
#pragma unroll
                    for (int bj = 0; bj < 2; ++bj) { const int o = ob + 32 * bj; f32x4 v0 = acc[ai][bj][m][0], v1 = acc[ai][bj][m][1];
                        if (o < 128) {
#pragma unroll
                            for (int e = 0; e < 4; ++e) { v0[e] = 2.0f * fsigmoid(2.0f * v0[e]) - 1.0f; v1[e] = 2.0f * fsigmoid(2.0f * v1[e]) - 1.0f; }
                        } else if (o < 256) {
                        } else if (o < 416) {
#pragma unroll
                            for (int e = 0; e < 4; ++e) { v0[e] = fsigmoid(v0[e]); v1[e] = fsigmoid(v1[e]); }
                        } else { v0 = (f32x4){0.f, 0.f, 0.f, 0.f}; v1 = v0; }
                        *(u32x4*)(rp + 32 * bj) = pack8(v0, v1); } }
            return;
        }
        const int sel = pn >> 2; const int cb = (pn & 3) * 256 + wc * 64 + 8 * fq;
        bf16* O = Oo;
        f32x4 kkg[2][2];
        if (sel == 1) {
#pragma unroll
            for (int bj = 0; bj < 2; ++bj)
#pragma unroll
                for (int n = 0; n < 2; ++n) kkg[bj][n] = *(const f32x4*)(k_k + cb + 32 * bj + 4 * n);
        }
#pragma unroll
        for (int ai = 0; ai < 2; ++ai)
#pragma unroll
            for (int m = 0; m < 4; ++m) { const size_t ro = (size_t)(row0 + ai * HALF + m * 16) * DM + cb;
#pragma unroll
                for (int bj = 0; bj < 2; ++bj) *(u32x4*)(O + ro + 32 * bj) = pack8(acc[ai][bj][m][0], acc[ai][bj][m][1]);
                if (sel == 1) {
                    f32x4 q[2][2]; float ss = 0.f;
#pragma unroll
                    for (int bj = 0; bj < 2; ++bj)
#pragma unroll
                        for (int n = 0; n < 2; ++n) { q[bj][n] = acc[ai][bj][m][n] * kkg[bj][n]; const f32x4 x = q[bj][n]; ss += (x[0] * x[0] + x[1] * x[1]) + (x[2] * x[2] + x[3] * x[3]); }
                    ss += __shfl_xor(ss, 16); ss += __shfl_xor(ss, 32);
                    const float rn = 1.0f / fmaxf(sqrtf(ss), 1e-12f);
#pragma unroll
                    for (int bj = 0; bj < 2; ++bj) *(u32x4*)(KK + ro + 32 * bj) = pack8(q[bj][0] * rn, q[bj][1] * rn);
                }
                if (m & 1) asm volatile("" ::: "memory"); }
    }
};

struct EpiFinish {
    static constexpr bool PERM = true, AFTER_DRAIN = false;
    const bf16* Y0; const bf16* Y1; const bf16* Vb; const float* bonus; const float* ln_g; const float* ln_b; bf16* Z;
    __device__ __forceinline__ void operator()(const f32x4 (&acc)[2][2][4][2], const Unit& u, int wr_, int wc_, int fr_, int fq_) const {
        int wr = wr_, wc = wc_, fr = fr_, fq = fq_; asm volatile("" : "+s"(wr), "+s"(wc), "+v"(fr), "+v"(fq));
        const int row0 = u.pm * BM + wr * 64 + fr; const int head = u.pn * 4 + wc; const int cb = head * 64 + 8 * fq;
#pragma unroll
        for (int ai = 0; ai < 2; ++ai)
#pragma unroll
            for (int m = 0; m < 4; ++m) { const size_t grow = (size_t)(row0 + ai * HALF + m * 16); const size_t ro = grow * DM + cb;
                float sum = 0.f, sq = 0.f;
#pragma unroll
                for (int bj = 0; bj < 2; ++bj) { f32x4 a0, a1, b0, b1; unpack8(*(const u32x4*)(Y0 + ro + 32 * bj), a0, a1); unpack8(*(const u32x4*)(Y1 + ro + 32 * bj), b0, b1);
                    a0 += b0; a1 += b1; sum += (a0[0] + a0[1]) + (a0[2] + a0[3]) + (a1[0] + a1[1]) + (a1[2] + a1[3]);
                    sq += (a0[0] * a0[0] + a0[1] * a0[1]) + (a0[2] * a0[2] + a0[3] * a0[3]) + (a1[0] * a1[0] + a1[1] * a1[1]) + (a1[2] * a1[2] + a1[3] * a1[3]); }
                sum += __shfl_xor(sum, 16); sq += __shfl_xor(sq, 16); sum += __shfl_xor(sum, 32); sq += __shfl_xor(sq, 32);
                const float mean = sum * (1.0f / 64.0f); const float var = fmaxf(sq * (1.0f / 64.0f) - mean * mean, 0.f);
                const float rstd = __builtin_amdgcn_rsqf(var + GN_EPS_F);
                const f32x2 bo = *(const f32x2*)(bonus + (grow * 16 + head) * 2); const float bsum = bo.x + bo.y;

#pragma unroll
                for (int bj = 0; bj < 2; ++bj) { f32x4 a0, a1, b0, b1, v0, v1; unpack8(*(const u32x4*)(Y0 + ro + 32 * bj), a0, a1); unpack8(*(const u32x4*)(Y1 + ro + 32 * bj), b0, b1); unpack8(*(const u32x4*)(Vb + ro + 32 * bj), v0, v1);
                    const f32x4 lg0 = *(const f32x4*)(ln_g + cb + 32 * bj), lg1 = *(const f32x4*)(ln_g + cb + 32 * bj + 4), lb0 = *(const f32x4*)(ln_b + cb + 32 * bj), lb1 = *(const f32x4*)(ln_b + cb + 32 * bj + 4);
                    const f32x4 z0 = ((a0 + b0 - mean) * rstd * lg0 + lb0 + v0 * bsum) * acc[ai][bj][m][0];
                    const f32x4 z1 = ((a1 + b1 - mean) * rstd * lg1 + lb1 + v1 * bsum) * acc[ai][bj][m][1];
                    *(u32x4*)(Z + ro + 32 * bj) = pack8(z0, z1);
                    if (bj == 1) asm volatile("" ::: "memory"); }
            }
    }
};

struct WJob { const float* src; const float* kscale; bf16* dst; int ld_src, k_src, ldt, row_off, col_base, k_off, nblk, mode; };
constexpr int NJOBS = 33;
struct Args { const float* in[32]; float* out; unsigned char* ws; WJob job[NJOBS]; int istart[NJOBS + 2]; };

struct Frame { LAS unsigned char* lds; int tid, lane, wave, vcu, G; };

__device__ __forceinline__ int perm256(int o) { return (o & ~255) | (((o >> 5) & 1) << 7) | (((o >> 6) & 3) << 5) | (o & 31); }

__device__ __forceinline__ void wconv_item(const __attribute__((address_space(4))) WJob* Jp, int item, LAS float* scr, int lane) {
    WJob J; J.src = Jp->src; J.kscale = Jp->kscale; J.dst = Jp->dst; J.ld_src = Jp->ld_src; J.k_src = Jp->k_src; J.ldt = Jp->ldt; J.row_off = Jp->row_off; J.col_base = Jp->col_base; J.k_off = Jp->k_off; J.nblk = Jp->nblk; J.mode = Jp->mode;
    const int kb = item / J.nblk, nb = item - kb * J.nblk, k0 = 64 * kb, n0 = 32 * nb;
#pragma unroll 8
    for (int i = 0; i < 32; ++i) { const int kk = 2 * i + (lane >> 5), k = k0 + kk; float v = 0.f;
        if (J.src != nullptr && k < J.k_src) { v = J.src[(size_t)k * J.ld_src + n0 + (lane & 31)]; if (J.kscale) v *= J.kscale[k]; }
        scr[kk * 33 + (lane & 31)] = v; }
    asm volatile("s_waitcnt lgkmcnt(0)" ::: "memory");
    const int c = lane & 7;
#pragma unroll
    for (int j = 0; j < 4; ++j) { const int n = (lane >> 3) + 8 * j; const LAS float* s = scr + (8 * c) * 33 + n;
        u32x4 o; o.x = cvt_pk_bf16(s[0 * 33], s[1 * 33]); o.y = cvt_pk_bf16(s[2 * 33], s[3 * 33]); o.z = cvt_pk_bf16(s[4 * 33], s[5 * 33]); o.w = cvt_pk_bf16(s[6 * 33], s[7 * 33]);
        const int oc = J.col_base + n0 + n; const int drow = J.row_off + (J.mode ? perm256(oc) : oc);
        *(u32x4*)(J.dst + (size_t)drow * J.ldt + J.k_off + k0 + 8 * c) = o; }
    asm volatile("s_waitcnt lgkmcnt(0)" ::: "memory");
}

__device__ __forceinline__ void p0a(Frame& F, const __attribute__((address_space(4))) Args* A) {
    LAS float* sl = (LAS float*)F.lds;
    const float* c = A->in[1]; const float* cc = A->in[3];
    for (int idx = F.tid; idx < 17 * DM; idx += NWAVES * 64) { const int r = idx >> 10, k = idx & 1023; const float x = r < 16 ? c[r * DM + k] : cc[k]; sl[idx] = x * fsigmoid(x); }
    __syncthreads();
    const int gw = F.vcu * NWAVES + F.wave, NGW = F.G * NWAVES;
    float* modp = (float*)(A->ws + WS_MODP);
    for (int it = gw; it < 4 * 96 * 4; it += NGW) {
        const int l = it / 384, rem = it - l * 384, cgp = rem >> 2, kq = rem & 3, col = cgp * 64 + F.lane;
        const float* w = A->in[4] + ((size_t)l * DM + kq * 256) * NMOD + col;
        float acc[17];
#pragma unroll
        for (int r = 0; r < 17; ++r) acc[r] = 0.f;
#pragma unroll 4
        for (int k4 = 0; k4 < 256; k4 += 4) {
            const float w0 = w[(size_t)(k4 + 0) * NMOD], w1 = w[(size_t)(k4 + 1) * NMOD], w2 = w[(size_t)(k4 + 2) * NMOD], w3 = w[(size_t)(k4 + 3) * NMOD];
#pragma unroll
            for (int r = 0; r < 17; ++r) { const f32x4 sv = *(const LAS f32x4*)(sl + r * DM + kq * 256 + k4); acc[r] += (sv[0] * w0 + sv[1] * w1) + (sv[2] * w2 + sv[3] * w3); }
        }
#pragma unroll
        for (int r = 0; r < 17; ++r) modp[((size_t)(kq * 4 + l) * 17 + r) * NMOD + col] = acc[r];
    }
    __syncthreads();
    LAS float* scr = (LAS float*)(F.lds + F.wave * 16384);
    const int total = A->istart[NJOBS];
    for (int it = gw; it < total; it += NGW) {
        int j = 0;
        while (it >= A->istart[j + 1]) ++j;
        wconv_item(&A->job[j], it - A->istart[j], scr, F.lane);
    }
    { const f32x4* cs = (const f32x4*)A->in[2]; f32x4* cd = (f32x4*)(A->ws + WS_CTX);
      for (int idx = (F.vcu * NWAVES * 64) + F.tid; idx < NB * CTXL * DM / 4; idx += F.G * NWAVES * 64) cd[idx] = cs[idx]; }
    float* rope = (float*)(A->ws + WS_ROPE);
    for (int idx = (F.vcu * NWAVES * 64) + F.tid; idx < TPB * 32; idx += F.G * NWAVES * 64) {
        const int t = idx >> 5, p = idx & 31; float cs = 1.f, sn = 0.f;
        if (t < SEQ) { const int f = p & 15; const int pos = p < 16 ? (t >> 6) : (t & 63);
            const float inv = __builtin_amdgcn_exp2f(-(float)f * (13.287712379549449f / 16.0f)); const float ang = (float)pos * inv;
            float x = ang * 0.15915494309189535f; x = x - floorf(x); cs = __builtin_amdgcn_cosf(x); sn = __builtin_amdgcn_sinf(x); }
        rope[(size_t)t * 64 + p] = cs; rope[(size_t)t * 64 + 32 + p] = sn;
    }
}
__device__ __forceinline__ void p0b(Frame& F, const __attribute__((address_space(4))) Args* A) {
    const float* modp = (const float*)(A->ws + WS_MODP); float* mod = (float*)(A->ws + WS_MOD); const float* bm = A->in[5];
    const int n = 4 * 17 * NMOD;
    for (int idx = (F.vcu * NWAVES * 64) + F.tid; idx < n; idx += F.G * NWAVES * 64) {
        const int l = idx / (17 * NMOD), rem = idx - l * 17 * NMOD, col = rem % NMOD;
        float s = bm[l * NMOD + col];
#pragma unroll
        for (int kq = 0; kq < 4; ++kq) s += modp[(size_t)(kq * 4 + l) * 17 * NMOD + rem];
        mod[idx] = s;
    }
}

__device__ __forceinline__ void p0c(Frame& F, const __attribute__((address_space(4))) Args* A) {
    LAS float* sl = (LAS float*)F.lds; LAS float* red = (LAS float*)(F.lds + 17 * DM * 4);
    const float* mod = (const float*)(A->ws + WS_MOD); float* swt = (float*)(A->ws + WS_SW);
    for (int it = F.vcu; it < 4 * 64; it += F.G) {
        const int l = it >> 6, cgp = it & 63;
        for (int idx = F.tid; idx < 17 * DM; idx += NWAVES * 64) sl[idx] = mod[((size_t)l * 17 + (idx >> 10)) * NMOD + 3 * DM + (idx & 1023)];
        __syncthreads();
        const float* w = A->in[8] + ((size_t)l * DM + F.wave * 128) * FF + cgp * 64 + F.lane;
        float acc[17];
#pragma unroll
        for (int r = 0; r < 17; ++r) acc[r] = 0.f;
#pragma unroll 4
        for (int k4 = 0; k4 < 128; k4 += 4) {
            const float w0 = w[(size_t)(k4 + 0) * FF], w1 = w[(size_t)(k4 + 1) * FF], w2 = w[(size_t)(k4 + 2) * FF], w3 = w[(size_t)(k4 + 3) * FF];
#pragma unroll
            for (int r = 0; r < 17; ++r) { const f32x4 sv = *(const LAS f32x4*)(sl + r * DM + F.wave * 128 + k4); acc[r] += (sv[0] * w0 + sv[1] * w1) + (sv[2] * w2 + sv[3] * w3); }
        }
#pragma unroll
        for (int r = 0; r < 17; ++r) red[(F.wave * 17 + r) * 64 + F.lane] = acc[r];
        __syncthreads();
        for (int idx = F.tid; idx < 17 * 64; idx += NWAVES * 64) { float t = 0.f;
#pragma unroll
            for (int wv = 0; wv < 8; ++wv) t += red[wv * 17 * 64 + idx];
            swt[((size_t)l * 17 + (idx >> 6)) * FF + cgp * 64 + (idx & 63)] = t; }
        __syncthreads();
    }
}

struct LnPar { f32x4 g[4], sc[4], sh[4]; };
__device__ __forceinline__ void ln_load_par(LnPar& P, const float* gamma, const float* modrow, int slot, int lane) {
#pragma unroll
    for (int j = 0; j < 4; ++j) { const int c = 4 * lane + 256 * j; P.g[j] = *(const f32x4*)(gamma + c); P.sh[j] = *(const f32x4*)(modrow + slot * DM + c); P.sc[j] = *(const f32x4*)(modrow + (slot + 1) * DM + c) + 1.0f; P.g[j] = P.g[j] * P.sc[j]; }
}
__device__ __forceinline__ void ln_row(f32x4 (&h)[4], const float* xrow, const LnPar& P, int lane, const float* prow = nullptr, const float* pgate = nullptr) {
    float ss = 0.f;
#pragma unroll
    for (int j = 0; j < 4; ++j) { h[j] = *(const f32x4*)(xrow + 4 * lane + 256 * j);
        if (prow != nullptr) { const float* pp = prow + 4 * lane + 256 * j; h[j] += *(const f32x4*)(pgate + 4 * lane + 256 * j) * ((*(const f32x4*)(pp) + *(const f32x4*)(pp + (size_t)NB * CTXL * DM)) + (*(const f32x4*)(pp + (size_t)2 * NB * CTXL * DM) + *(const f32x4*)(pp + (size_t)3 * NB * CTXL * DM))); } ss += (h[j][0] * h[j][0] + h[j][1] * h[j][1]) + (h[j][2] * h[j][2] + h[j][3] * h[j][3]); }
    const float rinv = __builtin_amdgcn_rsqf(wave_sum(ss) * (1.0f / DM) + RMS_EPS);
#pragma unroll
    for (int j = 0; j < 4; ++j) h[j] = h[j] * rinv * P.g[j] + P.sh[j];
}
__device__ __forceinline__ const float* prow_ptr(const float* pend, int b, int t) { return (pend != nullptr && t >= SEQ) ? pend + ((size_t)b * CTXL + (t - SEQ)) * DM : nullptr; }
__device__ __forceinline__ const float* xrow_ptr(const float* L, const float* C, int b, int t) { return t < SEQ ? L + ((size_t)b * SEQ + t) * DM : C + ((size_t)b * CTXL + (t - SEQ)) * DM; }
__device__ __forceinline__ void st_row_bf16(bf16* orow, const f32x4 (&h)[4], int lane) {
#pragma unroll
    for (int j = 0; j < 4; ++j) { u32x2 w; w.x = cvt_pk_bf16(h[j][0], h[j][1]); w.y = cvt_pk_bf16(h[j][2], h[j][3]); *(u32x2*)(orow + 4 * lane + 256 * j) = w; }
}
__device__ __forceinline__ void ln_phase(Frame& F, const float* xl, const float* xc, const float* gamma, const float* modL, int slot, bf16* H, const float* pend = nullptr, const float* pgate = nullptr) {
    const int gw = F.vcu * NWAVES + F.wave, NGW = F.G * NWAVES;
    for (int run = gw; run < MROWS / 8; run += NGW) {
        const int row0 = run * 8, b = row0 / TPB, t0 = row0 - b * TPB;
        LnPar P; ln_load_par(P, gamma, modL + (size_t)(t0 < SEQ ? b : 16) * NMOD, slot, F.lane);
#pragma unroll 2
        for (int i = 0; i < 8; ++i) {
            f32x4 h[4]; ln_row(h, xrow_ptr(xl, xc, b, t0 + i), P, F.lane, prow_ptr(pend, b, t0 + i), pgate);
            st_row_bf16(H + (size_t)(row0 + i) * DM, h, F.lane);
        }
    }
}
__device__ __forceinline__ void hn_row(f32x4 (&h)[4], const bf16* hrow, float rsq, const LnPar& P, int lane) {
    const float rinv = __builtin_amdgcn_rsqf(rsq * (1.0f / DM) + RMS_EPS);
#pragma unroll
    for (int j = 0; j < 4; ++j) { const u32x2 w = *(const u32x2*)(hrow + 4 * lane + 256 * j); h[j] = (f32x4){bflo(w.x), bfhi(w.x), bflo(w.y), bfhi(w.y)} * rinv + P.sh[j]; }
}
__device__ __forceinline__ void ln_rwkv_phase(Frame& F, const bf16* Hn, const float* rq, const float* gamma, const float* modL, bf16* XR, bf16* XK, bf16* XV, bf16* A1, const float* mu) {
    const int gw = F.vcu * NWAVES + F.wave, NGW = F.G * NWAVES;
    for (int run = gw; run < MROWS / 8; run += NGW) {
        const int row0 = run * 8, b = row0 / TPB, t0 = row0 - b * TPB;
        const int slo = t0 < SEQ ? 0 : SEQ, shi = t0 < SEQ ? SEQ : TPB;
        LnPar P; ln_load_par(P, gamma, modL + (size_t)(t0 < SEQ ? b : 16) * NMOD, 0, F.lane);
        f32x4 mur[4], muk[4], muv[4];
#pragma unroll
        for (int j = 0; j < 4; ++j) { const int c = 4 * F.lane + 256 * j; mur[j] = *(const f32x4*)(mu + c); muk[j] = *(const f32x4*)(mu + 2 * DM + c); muv[j] = *(const f32x4*)(mu + 3 * DM + c); }
        f32x4 prev[4], cur[4], nxt[4];
        if (t0 > slo) hn_row(prev, Hn + (size_t)(row0 - 1) * DM, rq[row0 - 1], P, F.lane);
        else {
#pragma unroll
            for (int j = 0; j < 4; ++j) prev[j] = (f32x4){0.f, 0.f, 0.f, 0.f}; }
        hn_row(cur, Hn + (size_t)row0 * DM, rq[row0], P, F.lane);
#pragma unroll 4
        for (int i = 0; i < 8; ++i) {
            const int t = t0 + i;
            if (t + 1 < shi) hn_row(nxt, Hn + (size_t)(row0 + i + 1) * DM, rq[row0 + i + 1], P, F.lane);
            else {
#pragma unroll
                for (int j = 0; j < 4; ++j) nxt[j] = (f32x4){0.f, 0.f, 0.f, 0.f}; }
            f32x4 xx[4];
#pragma unroll
            for (int j = 0; j < 4; ++j) xx[j] = (prev[j] + nxt[j]) * 0.5f - cur[j];
            bf16* o = A1 + (size_t)(row0 + i) * 2048;
            st_row_bf16(o, cur, F.lane); st_row_bf16(o + DM, xx, F.lane);
            { f32x4 t4[4];
#pragma unroll
              for (int j = 0; j < 4; ++j) t4[j] = cur[j] + xx[j] * mur[j];
              st_row_bf16(XR + (size_t)(row0 + i) * DM, t4, F.lane);
#pragma unroll
              for (int j = 0; j < 4; ++j) t4[j] = cur[j] + xx[j] * muk[j];
              st_row_bf16(XK + (size_t)(row0 + i) * DM, t4, F.lane);
#pragma unroll
              for (int j = 0; j < 4; ++j) t4[j] = cur[j] + xx[j] * muv[j];
              st_row_bf16(XV + (size_t)(row0 + i) * DM, t4, F.lane); }
#pragma unroll
            for (int j = 0; j < 4; ++j) { prev[j] = cur[j]; cur[j] = nxt[j]; }
        }
    }
}
__device__ __forceinline__ void pool_phase(Frame& F, const bf16* H, const float* rq, bf16* PL) {
    const int gt = F.vcu * NWAVES * 64 + F.tid, NT_ = F.G * NWAVES * 64;
    for (int it = gt; it < (MROWS / 16) * 128; it += NT_) {
        const int run = it >> 7, ch = it & 127, half = 1 << (ch >> 5);
        const int row0 = run * 16, b = row0 / TPB, t0 = row0 - b * TPB;
        const int slo = t0 < SEQ ? 0 : SEQ, shi = t0 < SEQ ? SEQ : TPB;
        const bf16* hb = H + (size_t)b * TPB * DM + ch * 8;
        const float* rqb = rq + (size_t)b * TPB;
#define LDROW(r_, a_, c_) do { unpack8(*(const u32x4*)(hb + (size_t)(r_) * DM), a_, c_); const float ri_ = __builtin_amdgcn_rsqf(rqb[r_] * (1.0f / DM) + RMS_EPS); a_ = a_ * ri_; c_ = c_ * ri_; } while (0)
        f32x4 s0 = (f32x4){0.f, 0.f, 0.f, 0.f}, s1 = s0;
        { const int lo = max(t0 - half, slo), hi = min(t0 + half, shi);
          for (int r = lo; r < hi; ++r) { f32x4 a, c2; LDROW(r, a, c2); s0 += a; s1 += c2; } }
#pragma unroll 4
        for (int i = 0; i < 16; ++i) {
            const int t = t0 + i; const int lo = max(t - half, slo), hi = min(t + half, shi);
            f32x4 a, c2; LDROW(t, a, c2);
            const float ic = 1.0f / (float)(hi - lo);
            *(u32x4*)(PL + (size_t)(row0 + i) * DM + ch * 8) = pack8(s0 * ic - a, s1 * ic - c2);
            if (t + half < shi) { f32x4 p, q; LDROW(t + half, p, q); s0 += p; s1 += q; }
            if (t - half >= slo) { f32x4 p, q; LDROW(t - half, p, q); s0 -= p; s1 -= q; }
        }
    }
#undef LDROW
}

__device__ __forceinline__ float dpp_x1(float x) { return __int_as_float(__builtin_amdgcn_update_dpp(0, __float_as_int(x), 0xB1, 0xF, 0xF, true)); }
__device__ __forceinline__ float dpp_x2(float x) { return __int_as_float(__builtin_amdgcn_update_dpp(0, __float_as_int(x), 0x4E, 0xF, 0xF, true)); }
__device__ __forceinline__ float dpp_hm(float x) { return __int_as_float(__builtin_amdgcn_update_dpp(0, __float_as_int(x), 0x141, 0xF, 0xF, true)); }
__device__ __forceinline__ float fma_s(float a, float b, float c) { float d; asm("v_fma_f32 %0, %1, %2, %3" : "=v"(d) : "v"(a), "v"(b), "v"(c)); return d; }
__device__ __forceinline__ float mul_s(float a, float b) { float d; asm("v_mul_f32_e32 %0, %1, %2" : "=v"(d) : "v"(a), "v"(b)); return d; }
__device__ __forceinline__ float red8(float x) { x += dpp_x1(x); x += dpp_x2(x); x += dpp_hm(x); return x; }
__device__ __forceinline__ int scan_tok(int dir, int s) { return dir ? (TPB - 1 - s) : (s < CTXL ? SEQ + s : s - CTXL); }
constexpr int NCHUNK = TPB / 16;
#ifndef PSUB
#define PSUB 0
#endif
#define PSUB_T0(x) unsigned long long ps0_##x = (PSUB & (x)) ? __builtin_amdgcn_s_memrealtime() : 0ull
#define PSUB_T1(x) do { if (PSUB & (x)) psum_ += __builtin_amdgcn_s_memrealtime() - ps0_##x; } while (0)
#define PSUB_SPIN() do { if (PSUB) { const unsigned long long t1_ = __builtin_amdgcn_s_memrealtime(); while (__builtin_amdgcn_s_memrealtime() - t1_ < psum_) __builtin_amdgcn_s_sleep(8); } } while (0)

__device__ __forceinline__ void scan_phase(Frame& F, const bf16* Rg, const bf16* Kg, const bf16* KKg, const bf16* Vg, const bf16* P, bf16* Y0, bf16* Y1, float* bonus,
                                           const float* w0, const float* w2, const float* a0, const float* a2, const float* k_a, const float* r_k) {
    LAS float* L = (LAS float*)F.lds;
    const int lane = F.lane, dir = F.wave >> 2, wq = F.wave & 3, vg = lane >> 3, kg = lane & 7, fr = lane & 15, fq = lane >> 4;
    const int mm = wq >> 1, cth = wq & 1;
    for (int bh = F.vcu; bh < NB * 16; bh += F.G) {
        const int b = bh >> 4, h = bh & 15; const size_t rb = (size_t)b * TPB;
        const float* W2 = (mm == 0 ? w2 : a2) + (size_t)dir * 64 * DM + h * 64;
        bf16x8 Bf[2][2]; float bias[2], ka[2];
#pragma unroll
        for (int ct2 = 0; ct2 < 2; ++ct2) { const int j = 16 * (2 * cth + ct2) + fr;
            bias[ct2] = (mm == 0 ? w0 : a0)[dir * DM + h * 64 + j]; ka[ct2] = k_a[h * 64 + j];
#pragma unroll
            for (int ks = 0; ks < 2; ++ks) { const float* wp = W2 + (size_t)(32 * ks + 8 * fq) * DM + j;
                u32x4 pk; pk.x = cvt_pk_bf16(wp[0], wp[DM]); pk.y = cvt_pk_bf16(wp[2 * DM], wp[3 * DM]); pk.z = cvt_pk_bf16(wp[4 * DM], wp[5 * DM]); pk.w = cvt_pk_bf16(wp[6 * DM], wp[7 * DM]);
                Bf[ct2][ks] = __builtin_bit_cast(bf16x8, pk); } }
        f32x4 rkb[4];
#pragma unroll
        for (int q4 = 0; q4 < 4; ++q4) rkb[q4] = *(const f32x4*)(r_k + h * 64 + 16 * (lane & 3) + 4 * q4);
        f32x2 S[2][4];
#pragma unroll
        for (int rr = 0; rr < 2; ++rr)
#pragma unroll
            for (int jp = 0; jp < 4; ++jp) S[rr][jp] = (f32x2){0.f, 0.f};
        unsigned long long psum_ = 0ull; (void)psum_;
        bf16* Yd = dir ? Y1 : Y0;
        const bf16* srcA = mm == 0 ? Rg : Kg; const bf16* srcB = mm == 0 ? Vg : KKg;
        bf16x8 Pa[2]; unsigned short ga[8], gb[8];
#define SC_LOAD(c) do { const int s0_ = 16 * (c); const size_t ra_ = rb + scan_tok(dir, s0_ + fr); \
        _Pragma("unroll") for (int ks = 0; ks < 2; ++ks) Pa[ks] = *(const bf16x8*)(P + ra_ * 512 + 128 * mm + 64 * dir + 32 * ks + 8 * fq); \
        _Pragma("unroll") for (int e = 0; e < 4; ++e) { const size_t ri_ = (rb + scan_tok(dir, s0_ + 4 * fq + e)) * DM + h * 64 + 32 * cth + fr; \
            _Pragma("unroll") for (int ct2 = 0; ct2 < 2; ++ct2) { ga[e * 2 + ct2] = srcA[ri_ + 16 * ct2]; gb[e * 2 + ct2] = srcB[ri_ + 16 * ct2]; } } } while (0)
#define SC_COMPUTE(buf) do { LAS float* Lb_ = L + ((buf) * 2 + dir) * 6 * 1024; \
        _Pragma("unroll") for (int ct2 = 0; ct2 < 2; ++ct2) { f32x4 D_ = (f32x4){0.f, 0.f, 0.f, 0.f}; \
            D_ = __builtin_amdgcn_mfma_f32_16x16x32_bf16(Pa[0], Bf[ct2][0], D_, 0, 0, 0); D_ = __builtin_amdgcn_mfma_f32_16x16x32_bf16(Pa[1], Bf[ct2][1], D_, 0, 0, 0); \
            _Pragma("unroll") for (int e = 0; e < 4; ++e) { const int idx_ = (4 * fq + e) * 64 + 16 * (2 * cth + ct2) + fr; const float xa_ = bf2f(ga[e * 2 + ct2]), xb_ = bf2f(gb[e * 2 + ct2]); \
                if (mm == 0) { const float sg_ = fsigmoid(bias[ct2] + D_[e]); Lb_[1 * 1024 + idx_] = __builtin_amdgcn_exp2f(-0.8750387749f * sg_); Lb_[4 * 1024 + idx_] = xa_; Lb_[5 * 1024 + idx_] = xb_; } \
                else { const float a_ = fsigmoid(bias[ct2] + D_[e]); Lb_[3 * 1024 + idx_] = xa_ * (1.0f + (a_ - 1.0f) * ka[ct2]); Lb_[2 * 1024 + idx_] = xb_ * a_; Lb_[0 * 1024 + idx_] = xb_; } } } } while (0)
        SC_LOAD(0); SC_COMPUTE(0); __syncthreads();
#define ST_LOAD(X, i) do { const LAS float* q_ = Lb + (i) * 64; \
            X##kk0 = *(const LAS f32x4*)(q_); X##kk1 = *(const LAS f32x4*)(q_ + 4); X##w0 = *(const LAS f32x4*)(q_ + 1024); X##w1 = *(const LAS f32x4*)(q_ + 1024 + 4); \
            X##ka0 = *(const LAS f32x4*)(q_ + 2048); X##ka1 = *(const LAS f32x4*)(q_ + 2048 + 4); X##kt0 = *(const LAS f32x4*)(q_ + 3072); X##kt1 = *(const LAS f32x4*)(q_ + 3072 + 4); \
            X##r0 = *(const LAS f32x4*)(q_ + 4096); X##r1 = *(const LAS f32x4*)(q_ + 4096 + 4); X##v = *(const LAS f32x2*)(Lv + (i) * 64); } while (0)
#define LOHI(v4, jp) ((jp) & 1 ? (f32x2){v4[2], v4[3]} : (f32x2){v4[0], v4[1]})
#define ST_COMPUTE(X, i) do { \
            const f32x2 kk2_[4] = {LOHI(X##kk0, 0), LOHI(X##kk0, 1), LOHI(X##kk1, 0), LOHI(X##kk1, 1)}; const f32x2 w2_[4] = {LOHI(X##w0, 0), LOHI(X##w0, 1), LOHI(X##w1, 0), LOHI(X##w1, 1)}; \
            const f32x2 ka2_[4] = {LOHI(X##ka0, 0), LOHI(X##ka0, 1), LOHI(X##ka1, 0), LOHI(X##ka1, 1)}; const f32x2 kt2_[4] = {LOHI(X##kt0, 0), LOHI(X##kt0, 1), LOHI(X##kt1, 0), LOHI(X##kt1, 1)}; \
            const f32x2 r2_[4] = {LOHI(X##r0, 0), LOHI(X##r0, 1), LOHI(X##r1, 0), LOHI(X##r1, 1)}; \
            float sa_[2], yv_[2]; \
            _Pragma("unroll") for (int rr = 0; rr < 2; ++rr) { f32x2 t2 = S[rr][0] * kk2_[0]; t2 += S[rr][1] * kk2_[1]; t2 += S[rr][2] * kk2_[2]; t2 += S[rr][3] * kk2_[3]; sa_[rr] = red8(t2.x + t2.y); } \
            _Pragma("unroll") for (int rr = 0; rr < 2; ++rr) { const float nsa = -sa_[rr]; const float vr = rr == 0 ? X##v.x : X##v.y; f32x2 t2 = (f32x2){0.f, 0.f}; \
                _Pragma("unroll") for (int jp = 0; jp < 4; ++jp) { S[rr][jp] = S[rr][jp] * w2_[jp] + ka2_[jp] * nsa + kt2_[jp] * vr; t2 += S[rr][jp] * r2_[jp]; } \
                yv_[rr] = red8(t2.x + t2.y); } \
            if (kg == 0) *(unsigned*)(Yd + (rb + scan_tok(dir, 16 * c + (i))) * DM + h * 64 + 16 * wq + 2 * vg) = cvt_pk_bf16(yv_[0], yv_[1]); } while (0)
        for (int c = 0; c < NCHUNK; ++c) {
            if (c + 1 < NCHUNK) SC_LOAD(c + 1);
            const LAS float* Lb = L + ((c & 1) * 2 + dir) * 6 * 1024 + 8 * kg;
            const LAS float* Lv = L + ((c & 1) * 2 + dir) * 6 * 1024 + 5 * 1024 + 16 * wq + 2 * vg;
            f32x4 Akk0, Akk1, Aw0, Aw1, Aka0, Aka1, Akt0, Akt1, Ar0, Ar1, Bkk0, Bkk1, Bw0, Bw1, Bka0, Bka1, Bkt0, Bkt1, Br0, Br1; f32x2 Av, Bv;
            ST_LOAD(A, 0);
            if (wq == 0) {
                const LAS float* Lq = L + ((c & 1) * 2 + dir) * 6 * 1024 + (lane >> 2) * 64 + 16 * (lane & 3); float bs = 0.f;
#pragma unroll
                for (int q4 = 0; q4 < 4; ++q4) { const f32x4 rr4 = *(const LAS f32x4*)(Lq + 4096 + 4 * q4), kt4 = *(const LAS f32x4*)(Lq + 3072 + 4 * q4); const f32x4 p4 = rr4 * kt4 * rkb[q4]; bs += (p4[0] + p4[1]) + (p4[2] + p4[3]); }
                bs += dpp_x1(bs); bs += dpp_x2(bs);
                if ((lane & 3) == 0) bonus[((rb + scan_tok(dir, 16 * c + (lane >> 2))) * 16 + h) * 2 + dir] = bs;
            }
            PSUB_T0(1);
#pragma unroll 1
            for (int i = 0; i < 16; i += 2) {
                ST_LOAD(B, i + 1);
                ST_COMPUTE(A, i);
                if (i + 2 < 16) ST_LOAD(A, i + 2);
                ST_COMPUTE(B, i + 1);
            }
            PSUB_T1(1); PSUB_T0(2);
            if (c + 1 < NCHUNK) SC_COMPUTE((c + 1) & 1);
            PSUB_T1(2); PSUB_T0(4);
            __syncthreads();
            PSUB_T1(4);
        }
        PSUB_SPIN();
#undef ST_LOAD
#undef ST_COMPUTE
#undef LOHI
#undef SC_LOAD
#undef SC_COMPUTE
    }
}

#define XB_TMO      128
#define XB_XCNT(j)  (256  + 64 * (j))
#define XB_XSUB(j)  (1280 + 64 * (j))
#define XB_XGEN(j)  (2304 + 64 * (j))
#define XB_TOP      3328
#define XB_TOPGEN   3392
#define XCD_BAR_WORDS 3456
#define XB_SPIN_CAP (1u << 18)

__device__ __forceinline__ unsigned xb_ld(unsigned* p)              { return __hip_atomic_load(p, __ATOMIC_RELAXED, __HIP_MEMORY_SCOPE_AGENT); }
__device__ __forceinline__ unsigned xb_add(unsigned* p, unsigned v) { return __hip_atomic_fetch_add(p, v, __ATOMIC_RELAXED, __HIP_MEMORY_SCOPE_AGENT); }
__device__ __forceinline__ unsigned xb_xcc_id() { return (unsigned)__builtin_amdgcn_s_getreg((3 << 11) | 20) & 0xFu; }
#define XB_SPIN(cond, bar) do { unsigned _sp = 0; while (cond) { __builtin_amdgcn_s_sleep(1); \
    if ((++_sp & 255u) == 0u) { if (xb_ld(&(bar)[XB_TMO])) break; if (_sp > XB_SPIN_CAP) { atomicAdd(&(bar)[XB_TMO], 1u); break; } } } } while (0)

struct XcdBarrier {
    unsigned* bar; unsigned x;
    volatile LAS unsigned* st;
};

__device__ __forceinline__ XcdBarrier xcd_barrier_post(unsigned* bar, volatile LAS unsigned* st) {
    XcdBarrier b; b.bar = bar; b.x = xb_xcc_id(); b.st = st;
    if (threadIdx.x == 0) (void)xb_add(&bar[XB_XCNT(b.x)], 1u);
    return b;
}
__device__ __forceinline__ void xcd_barrier_complete(unsigned* bar, unsigned x, unsigned& nloc, unsigned& nx) {
    const unsigned G = gridDim.x * gridDim.y * gridDim.z;
    unsigned sum, cnt, mine, sp = 0u;
    for (;;) {
        sum = 0u; cnt = 0u; mine = 0u;
#pragma unroll
        for (unsigned j = 0; j < 16; ++j) { const unsigned c = xb_ld(&bar[XB_XCNT(j)]); sum += c; cnt += (c > 0u) ? 1u : 0u; mine = (j == x) ? c : mine; }
        if (sum == G) break;
        __builtin_amdgcn_s_sleep(1);
        if ((++sp & 255u) == 0u) { if (xb_ld(&bar[XB_TMO])) break; if (sp > XB_SPIN_CAP) { atomicAdd(&bar[XB_TMO], 1u); break; } }
    }
    nloc = mine > 0u ? mine : 1u; nx = cnt > 0u ? cnt : 1u;
}

__device__ __forceinline__ void xcd_barrier(const XcdBarrier& b) {
    asm volatile("s_waitcnt vmcnt(0)" ::: "memory");
    __syncthreads();
    if (threadIdx.x == 0) {
        unsigned* bar = b.bar;
        __builtin_amdgcn_s_waitcnt(0);
        unsigned nloc = b.st[0], nx = b.st[1];
        if (nloc == 0u) { xcd_barrier_complete(bar, b.x, nloc, nx); b.st[0] = nloc; b.st[1] = nx; }
        const unsigned old = xb_add(&bar[XB_XSUB(b.x)], 1u);
        const unsigned gen = old / nloc;
        if (old + 1u == (gen + 1u) * nloc) {
            __builtin_amdgcn_fence(__ATOMIC_RELEASE, "agent");
            asm volatile("s_waitcnt vmcnt(0)" ::: "memory");
            const unsigned og = xb_add(&bar[XB_TOP], 1u);
            const unsigned tg = og / nx;
            if (og + 1u == (tg + 1u) * nx) xb_add(&bar[XB_TOPGEN], 1u);
            else XB_SPIN(xb_ld(&bar[XB_TOPGEN]) == tg, bar);
            __builtin_amdgcn_fence(__ATOMIC_ACQUIRE, "agent");
            xb_add(&bar[XB_XGEN(b.x)], 1u);
            asm volatile("s_waitcnt vmcnt(0)" ::: "memory");
        } else {
            XB_SPIN(xb_ld(&bar[XB_XGEN(b.x)]) == gen, bar);
            __builtin_amdgcn_fence(__ATOMIC_ACQUIRE, "agent");
            asm volatile("s_waitcnt vmcnt(0)" ::: "memory");
        }
    }
    __syncthreads();
}

constexpr int MISC_OFF = 131072 + 320;

typedef const __attribute__((address_space(4))) Args* ArgsP;
__device__ __forceinline__ ArgsP get_args() { ArgsP p = (ArgsP)__builtin_amdgcn_kernarg_segment_ptr(); asm volatile("" : "+s"(p)); return p; }
#define PHASE_BEGIN() Frame F; { int t_ = threadIdx.x; asm volatile("" : "+v"(t_)); F.tid = t_; F.lane = t_ & 63; F.wave = __builtin_amdgcn_readfirstlane(t_ >> 6); \
        F.lds = (LAS unsigned char*)lds; F.G = gridDim.x; const int bx_ = blockIdx.x; F.vcu = (F.G % 8 == 0) ? (bx_ % 8) * (F.G / 8) + bx_ / 8 : bx_; } \
    ArgsP A = get_args(); unsigned char* const ws = A->ws; float* const xout = A->out; float* const ctxb = (float*)(ws + WS_CTX); bf16* const Wb = (bf16*)(ws + WS_W); unsigned char* const act = ws + WS_ACT; \
    const float* const modL = (const float*)(ws + WS_MOD) + (size_t)layer * 17 * NMOD; \
    const float* const srcL = layer == 0 ? A->in[0] : xout; const float* const srcC = ctxb; \
      \
    const float* const pendP = nullptr; const float* const pendG = modL - (size_t)17 * NMOD + (size_t)16 * NMOD + 5 * DM; \
    (void)xout; (void)ctxb; (void)Wb; (void)act; (void)modL; (void)srcL; (void)srcC; (void)pendP; (void)pendG
#ifndef PHM
#define PHM 0xFFFF
#endif
#define PH(x) if (PHM & (x))
#ifndef PROBE_MASK
#define PROBE_MASK 0
#endif
#define TIC() const unsigned long long t0_ = PROBE_MASK ? __builtin_amdgcn_s_memrealtime() : 0ull
#define TOC(x) do { if (PROBE_MASK & (x)) { const unsigned long long t1_ = __builtin_amdgcn_s_memrealtime(); while (__builtin_amdgcn_s_memrealtime() - t1_ < t1_ - t0_) __builtin_amdgcn_s_sleep(8); } } while (0)
#define GSYNC_CG() cg::this_grid().sync()
#ifndef XSYNC
#define XSYNC 0
#endif
#define GSYNC() do { GSYNC1(); if (XSYNC) GSYNC1(); } while (0)
#define GSYNC1() do { XcdBarrier b_; b_.bar = (unsigned*)get_args()->ws; b_.x = xb_xcc_id(); b_.st = (volatile LAS unsigned*)((LAS unsigned char*)lds + MISC_OFF) + 8; xcd_barrier(b_); } while (0)
#define GEMM(EpiT, gg, EE) do { pg8::StaticOrder S_; S_.init((gg).M, (gg).N, F.G, (int)blockIdx.x); pg8::gemm_phase<EpiT, pg8::StaticOrder, true, true>(F.lds, gg, S_, EE); } while (0)
#define GEMM_SK(EpiT, gg, EE, sk) do { pg8::StaticOrder S_; S_.init((gg).M, (gg).N, F.G, (int)blockIdx.x, (sk) ? 1 : 0); pg8::gemm_phase<EpiT, pg8::StaticOrder, true, true>(F.lds, gg, S_, EE); } while (0)

__global__ void __launch_bounds__(NWAVES * 64, 2) hybrid_fwd(Args args_unused) {
    extern __shared__ __attribute__((aligned(16))) unsigned char lds[];
    { volatile LAS unsigned* misc = (volatile LAS unsigned*)((LAS unsigned char*)lds + MISC_OFF); if (threadIdx.x < 32) misc[threadIdx.x] = 0u; __syncthreads();
      (void)xcd_barrier_post((unsigned*)get_args()->ws, misc + 8); }
    { const int layer = 0; TIC(); PHASE_BEGIN(); PH(1) p0a(F, A); TOC(1); } GSYNC_CG();
    { const int layer = 0; TIC(); PHASE_BEGIN(); PH(1) p0b(F, A); TOC(1); } GSYNC();
    { const int layer = 0; TIC(); PHASE_BEGIN(); PH(1) p0c(F, A); TOC(1); } GSYNC();

#pragma unroll 1
    for (int layer = 0; layer < 4; ++layer) {
        const int kind = layer % 3;
        if (layer > 0) {
            { TIC(); PHASE_BEGIN(); const float* pp = (const float*)(act + 680 * MiB); const float* pg = modL - (size_t)17 * NMOD + (size_t)16 * NMOD + 5 * DM;
              constexpr size_t NQ = (size_t)NB * CTXL * DM;
              const bool fuse = layer < 3;
              bf16* Hn = (bf16*)(act + (layer == 1 ? 748 * MiB : 0)); float* rq = (float*)(ws + WS_ROWSQ) + (size_t)(3 + layer) * MROWS;
              const float* g1 = A->in[6] + layer * DM; const float* sc1 = modL + (size_t)16 * NMOD + 1 * DM;
              for (int r = F.vcu * NWAVES + F.wave; r < NB * CTXL; r += F.G * NWAVES) { float ss = 0.f; const size_t grow = (size_t)(r >> 8) * TPB + SEQ + (r & 255);
#pragma unroll
                  for (int j = 0; j < 4; ++j) { const int c = 4 * F.lane + 256 * j; const float* p = pp + (size_t)r * DM + c;
                      const f32x4 xn = *(const f32x4*)(ctxb + (size_t)r * DM + c) + *(const f32x4*)(pg + c) * ((*(const f32x4*)(p) + *(const f32x4*)(p + NQ)) + (*(const f32x4*)(p + 2 * NQ) + *(const f32x4*)(p + 3 * NQ)));
                      *(f32x4*)(ctxb + (size_t)r * DM + c) = xn;
                      if (fuse) { ss += (xn[0] * xn[0] + xn[1] * xn[1]) + (xn[2] * xn[2] + xn[3] * xn[3]); const f32x4 hq = xn * (*(const f32x4*)(g1 + c) * (*(const f32x4*)(sc1 + c) + 1.0f));
                          u32x2 w; w.x = cvt_pk_bf16(hq[0], hq[1]); w.y = cvt_pk_bf16(hq[2], hq[3]); *(u32x2*)(Hn + grow * DM + c) = w; } }
                  if (fuse) { ss = wave_sum(ss); if (F.lane == 0) rq[grow] = ss; } }
              TOC(2); } GSYNC();
        }
        if (kind == 0) {
            PH(2) { TIC(); PHASE_BEGIN(); ln_phase(F, srcL, srcC, A->in[6] + layer * DM, modL, 0, (bf16*)act, pendP, pendG); TOC(2); } GSYNC();
            PH(4) { TIC(); PHASE_BEGIN(); const int j = layer / 3; bf16* Q = (bf16*)(act + ACT1); bf16* Kb = (bf16*)(act + 2 * ACT1); bf16* Vb = (bf16*)(act + 2 * ACT1 + 34 * MiB);
              pg8::Gemm g{(bf16*)act, Wb + (W_QKV + (size_t)j * 3 * MiB) / 2, MROWS, 1536, DM, DM, DM, 0};
              EpiQKV E{Q, Kb, Vb, A->in[11] + j * 64, A->in[12] + j * 64, (const float*)(ws + WS_ROPE)};
              GEMM(EpiQKV, g, E); TOC(4); } GSYNC();
            PH(8) { TIC(); PHASE_BEGIN(); const bool with_ctx = layer != 3; bf16* Q = (bf16*)(act + ACT1); bf16* Kb = (bf16*)(act + 2 * ACT1); bf16* Vb = (bf16*)(act + 2 * ACT1 + 34 * MiB);
              for (int bh = F.vcu; bh < NB * 16; bh += F.G) { const int b = bh >> 4, h = bh & 15; const long rb = (long)b * TPB;
                  for (int qb = 0; qb < 16; ++qb) attn_body::attn_unit<8>(rb + qb * 256, rb, TPB / 64, h, (const attn_body::bf16*)Q, (const attn_body::bf16*)Kb, (const attn_body::bf16*)Vb, (attn_body::bf16*)Q, (char*)lds);
                  if (with_ctx) attn_body::attn_unit<8>(rb + SEQ, rb + SEQ, CTXL / 64, h, (const attn_body::bf16*)Q, (const attn_body::bf16*)Kb, (const attn_body::bf16*)Vb, (attn_body::bf16*)Q, (char*)lds); } TOC(8); } GSYNC();
            PH(16) { TIC(); PHASE_BEGIN(); const int j = layer / 3; bf16* Q = (bf16*)(act + ACT1);
              pg8::Gemm g{Q, Wb + (W_WO + (size_t)j * 2 * MiB) / 2, MROWS, DM, DM, DM, DM, 0};
              EpiResid E{srcL, srcC, xout, ctxb, modL, 2, nullptr, (bf16*)act, (float*)(ws + WS_ROWSQ) + (size_t)layer * MROWS, A->in[7] + layer * DM, modL + 4 * DM, pendP, pendG};
              GEMM_SK(EpiResid, g, E, layer == 3); TOC(16); } GSYNC();
        } else if (kind == 1) {
            PH(32) { TIC(); PHASE_BEGIN(); ln_rwkv_phase(F, (const bf16*)(act + 748 * MiB), (const float*)(ws + WS_ROWSQ) + (size_t)4 * MROWS, A->in[6] + layer * DM, modL, (bf16*)act, (bf16*)(act + 136 * MiB), (bf16*)(act + 272 * MiB), (bf16*)(act + 408 * MiB), A->in[14]); TOC(32); } GSYNC();
#pragma unroll 1
            for (int q = 0; q < 4; ++q) {
                PH(64) { TIC(); PHASE_BEGIN();
                  const size_t aoff = q == 0 ? 408 * MiB : (size_t)(q - 1) * 136 * MiB; const size_t ooff = q == 1 ? 748 * MiB : (q == 2 ? 408 * MiB : 0);
                  const size_t woff = q == 0 ? 6 * MiB : (size_t)(q - 1) * 2 * MiB; const int kk_ = q == 0 ? 2048 : DM;
                  pg8::Gemm g{(bf16*)(act + aoff), Wb + (W_R1 + woff) / 2, MROWS, q == 0 ? 512 : DM, kk_, kk_, kk_, 0};
                  EpiRwkv1 E{(bf16*)(act + ooff), (bf16*)(act + 544 * MiB), (bf16*)(act + 680 * MiB), A->in[24], q == 0 ? 12 : 4 * (q - 1)};
                  GEMM(EpiRwkv1, g, E); TOC(64); } GSYNC();
            }
            PH(128) { TIC(); PHASE_BEGIN(); bf16* R = (bf16*)(act + 748 * MiB); bf16* Kb = (bf16*)(act + 408 * MiB); bf16* Vb = (bf16*)(act); bf16* KK = (bf16*)(act + 544 * MiB); bf16* P = (bf16*)(act + 680 * MiB);
              scan_phase(F, R, Kb, KK, Vb, P, (bf16*)(act + 136 * MiB), (bf16*)(act + 272 * MiB), (float*)(ws + WS_BONUS), A->in[16], A->in[18], A->in[19], A->in[21], A->in[25], A->in[26]); TOC(128); } GSYNC();
            PH(256) { TIC(); PHASE_BEGIN(); bf16* Vb = (bf16*)(act); bf16* P = (bf16*)(act + 680 * MiB); bf16* Z = (bf16*)(act + 408 * MiB);
              pg8::Gemm g{P + 256, Wb + W_G2 / 2, MROWS, DM, 256, 512, 256, 0};
              EpiFinish E{(bf16*)(act + 136 * MiB), (bf16*)(act + 272 * MiB), Vb, (const float*)(ws + WS_BONUS), A->in[27], A->in[28], Z};
              GEMM(EpiFinish, g, E); TOC(256); } GSYNC();
            PH(512) { TIC(); PHASE_BEGIN(); bf16* Z = (bf16*)(act + 408 * MiB);
              pg8::Gemm g{Z, Wb + W_RWO / 2, MROWS, DM, DM, DM, DM, 0};
              EpiResid E{srcL, srcC, xout, ctxb, modL, 2, nullptr, (bf16*)act, (float*)(ws + WS_ROWSQ) + (size_t)layer * MROWS, A->in[7] + layer * DM, modL + 4 * DM, pendP, pendG};
              GEMM(EpiResid, g, E); TOC(512); } GSYNC();
        } else {
            PH(1024) { TIC(); PHASE_BEGIN(); pool_phase(F, (bf16*)act, (const float*)(ws + WS_ROWSQ) + (size_t)5 * MROWS, (bf16*)(act + ACT1)); TOC(1024); } GSYNC();
            PH(2048) { TIC(); PHASE_BEGIN(); bf16* PL = (bf16*)(act + ACT1);
              pg8::Gemm g{PL, Wb + W_POOL / 2, MROWS, DM, 256, DM, 256, 256};
              EpiResid E{srcL, srcC, xout, ctxb, modL, 2, A->in[31], (bf16*)act, (float*)(ws + WS_ROWSQ) + (size_t)layer * MROWS, A->in[7] + layer * DM, modL + 4 * DM, pendP, pendG};
              GEMM(EpiResid, g, E); TOC(2048); } GSYNC();
        }
        PH(4096) { TIC(); PHASE_BEGIN(); bf16* U = (bf16*)(act + ACT1);
          pg8::Gemm g{(bf16*)act, Wb + (W_IN + (size_t)layer * 8 * MiB) / 2, MROWS, FF, DM, DM, DM, 0};
          EpiRelu2 E{U, FF, (const float*)(ws + WS_ROWSQ) + (size_t)layer * MROWS, (const float*)(ws + WS_SW) + (size_t)layer * 17 * FF};
          { pg8::StaticOrder S_; S_.init(g.M, g.N, F.G, (int)blockIdx.x, layer == 3 ? 1 : 0); pg8::gemm_phase<EpiRelu2, pg8::StaticOrder, true, true>(F.lds, g, S_, E); } TOC(4096); } GSYNC();
        PH(8192) { TIC(); PHASE_BEGIN(); bf16* U = (bf16*)(act + ACT1);
          pg8::Gemm g{U, Wb + (W_OUT + (size_t)layer * 8 * MiB) / 2, MROWS, DM, FF, FF, FF, 0};
          const bool f1 = layer < 2;
          EpiResid E{xout, ctxb, xout, ctxb, modL, 5, nullptr, f1 ? (bf16*)(act + (layer == 0 ? 748 * MiB : 0)) : nullptr, (float*)(ws + WS_ROWSQ) + (size_t)(4 + layer) * MROWS, A->in[6] + (layer + 1) * DM, modL + (size_t)17 * NMOD + 1 * DM, nullptr, nullptr};
          GEMM_SK(EpiResid, g, E, 1);
          if (layer != 3) { pg8::Gemm g4 = g; g4.K = FF / 4; EpiPartial Ep{(float*)(act + 680 * MiB), FF / 4}; pg8::CtxSplitK S_; S_.init(FF, F.G, (int)blockIdx.x);
              pg8::gemm_phase<EpiPartial, pg8::CtxSplitK, true, true>(F.lds, g4, S_, Ep); } TOC(8192); }
        if (layer != 3) GSYNC();
    }
}

extern "C" void kernel_launch(void* const* d_in, const int* in_sizes, int n_in, void* d_out, int out_size, void* d_ws, size_t ws_size, hipStream_t stream) {
    static int grid = 0;
    if (grid == 0) {
        if (n_in != 32 || in_sizes[0] != NB * SEQ * DM || out_size != NB * SEQ * DM || ws_size < WS_NEED) { fprintf(stderr, "kernel_launch: unexpected shapes (n_in %d, in0 %d, out %d, ws %zu); nothing launched\n", n_in, n_in > 0 ? in_sizes[0] : -1, out_size, ws_size); grid = -1; return; }
        int dev = 0, cus = 0, per_cu = 0;
        if (hipGetDevice(&dev) != hipSuccess || hipDeviceGetAttribute(&cus, hipDeviceAttributeMultiprocessorCount, dev) != hipSuccess) { grid = -1; return; }
        if (hipFuncSetAttribute((const void*)hybrid_fwd, hipFuncAttributeMaxDynamicSharedMemorySize, LDS_BYTES) != hipSuccess) { fprintf(stderr, "kernel_launch: hipFuncSetAttribute failed\n"); grid = -1; return; }
        if (hipOccupancyMaxActiveBlocksPerMultiprocessor(&per_cu, (const void*)hybrid_fwd, NWAVES * 64, LDS_BYTES) != hipSuccess || per_cu < 1) { fprintf(stderr, "kernel_launch: occupancy query says %d\n", per_cu); per_cu = 1; }
        (void)hipGetLastError();
        grid = cus * per_cu;
    }
    if (grid < 0) return;
    Args a{};
    for (int i = 0; i < 32; ++i) a.in[i] = (const float*)d_in[i];
    a.out = (float*)d_out; a.ws = (unsigned char*)d_ws;
    bf16* Wb = (bf16*)((unsigned char*)d_ws + WS_W);
    int nj = 0, items = 0;
    auto add = [&](const float* src, const float* kscale, bf16* dst, int ld_src, int k_src, int k_pad, int ncols, int ldt, int row_off, int col_base, int k_off, int mode) {
        WJob& J = a.job[nj]; J.src = src; J.kscale = kscale; J.dst = dst; J.ld_src = ld_src; J.k_src = k_src; J.ldt = ldt; J.row_off = row_off; J.col_base = col_base; J.k_off = k_off; J.nblk = ncols / 32; J.mode = mode;
        a.istart[nj] = items; items += (k_pad / 64) * (ncols / 32); ++nj; };
    const float* in10 = a.in[10]; const float* in13 = a.in[13];
    for (int j = 0; j < 2; ++j) add(in10 + (size_t)j * DM * 1536, nullptr, Wb + (W_QKV + (size_t)j * 3 * MiB) / 2, 1536, DM, DM, 1536, DM, 0, 0, 0, 1);
    for (int j = 0; j < 2; ++j) add(in13 + (size_t)j * DM * DM, nullptr, Wb + (W_WO + (size_t)j * 2 * MiB) / 2, DM, DM, DM, DM, DM, 0, 0, 0, 0);
    for (int i = 0; i < 4; ++i) add(a.in[8] + (size_t)i * DM * FF, nullptr, Wb + (W_IN + (size_t)i * 8 * MiB) / 2, FF, DM, DM, FF, DM, 0, 0, 0, 0);
    for (int i = 0; i < 4; ++i) add(a.in[9] + (size_t)i * FF * DM, nullptr, Wb + (W_OUT + (size_t)i * 8 * MiB) / 2, DM, FF, FF, DM, FF, 0, 0, 0, 0);
    { bf16* W1 = Wb + W_R1 / 2; const float* mu = a.in[14]; const float* rkv = a.in[15];
      for (int i = 0; i < 3; ++i) add(rkv + (size_t)i * DM * DM, nullptr, W1 + (size_t)i * DM * DM, DM, DM, DM, DM, DM, 0, 0, 0, 1);
      bf16* WL = W1 + (size_t)3 * DM * DM;
      for (int hf = 0; hf < 2; ++hf) { const int ko = hf * DM;
          for (int d = 0; d < 2; ++d) add(a.in[17] + (size_t)d * DM * 64, hf ? mu + 1 * DM : nullptr, WL, 64, DM, DM, 64, 2048, 0, 64 * d, ko, 1);
          for (int d = 0; d < 2; ++d) add(a.in[20] + (size_t)d * DM * 64, hf ? mu + 4 * DM : nullptr, WL, 64, DM, DM, 64, 2048, 0, 128 + 64 * d, ko, 1);
          add(a.in[22], hf ? mu + 5 * DM : nullptr, WL, 160, DM, DM, 160, 2048, 0, 256, ko, 1);
          add(nullptr, nullptr, WL, 96, DM, DM, 96, 2048, 0, 416, ko, 1); } }
    add(a.in[23], nullptr, Wb + W_G2 / 2, DM, 160, 256, DM, 256, 0, 0, 0, 1);
    add(a.in[29], nullptr, Wb + W_RWO / 2, DM, DM, DM, DM, DM, 0, 0, 0, 0);
    for (int gi = 0; gi < 4; ++gi) add(a.in[30] + (size_t)gi * 256 * 256, nullptr, Wb + W_POOL / 2, 256, 256, 256, 256, 256, 256 * gi, 0, 0, 0);
    if (nj != NJOBS) { fprintf(stderr, "kernel_launch: job count %d != %d\n", nj, NJOBS); return; }
    a.istart[NJOBS] = items; a.istart[NJOBS + 1] = 0;
    if (hipMemsetAsync(d_ws, 0, WS_ZERO_BYTES, stream) != hipSuccess) { fprintf(stderr, "kernel_launch: memset of the barrier words failed\n"); return; }
    void* kargs[] = {&a};
    hipError_t e = hipLaunchCooperativeKernel((const void*)hybrid_fwd, dim3(grid), dim3(NWAVES * 64), kargs, LDS_BYTES, stream);
    if (e != hipSuccess) fprintf(stderr, "kernel_launch: cooperative launch failed: %s (grid %d)\n", hipGetErrorString(e), grid);
}
```

```cpp
#include <hip/hip_runtime.h>
#include <hip/hip_cooperative_groups.h>
#include <cstdio>
#include <cstdint>
namespace cg = cooperative_groups;
namespace pg8 {
#define PG8_LAS __attribute__((address_space(3)))
typedef unsigned short bf16_t;
typedef short bf16x8 __attribute__((ext_vector_type(8)));
typedef float f32x4 __attribute__((ext_vector_type(4)));
typedef unsigned u32x4 __attribute__((ext_vector_type(4)));
constexpr int BM = 256, BK = 64, HALF = 128, HTB = HALF * BK * 2  , STAGE_BYTES = 8 * HTB, NXCD = 8, WGM = 8;

__host__ __device__ __forceinline__ int lds_byte(int r, int c) { const int st = (r >> 4) * 2 + (c >> 5), rr = r & 15, cc = c & 31, ob = rr * 64 + cc * 2; return st * 1024 + (ob ^ (((ob >> 9) & 1) << 5)); }
__host__ __device__ __forceinline__ void stage_rc(int b, int& R, int& C) { const int st = b / 1024, sb = b % 1024, swz = sb ^ (((sb >> 9) & 1) << 5); R = (st >> 1) * 16 + swz / 64; C = (st & 1) * 32 + (swz % 64) / 2; }
__host__ __device__ __forceinline__ int perm32(int rho) { const int n = rho >> 4, i = rho & 15; return 8 * (i >> 2) + 4 * n + (i & 3); }

struct Unit { int pm, pn, kofs; };
struct Gemm { const bf16_t* A; const bf16_t* Bt; int M, N, K; int lda, ldb; long a_pn_off; };

struct StaticOrder {
    int nM, nN, nwg, G, c, skip;
    __host__ __device__ void init(int M, int N, int G_, int c_, int skip_ = 0) { skip = skip_; nM = M / BM; if (skip) nM = nM / 17 * 16; nN = N / BM; nwg = nM * nN; G = G_; c = c_; }
    __host__ __device__ bool next(int i, Unit& u) const {
        const long L = (long)i * G + c; if (L >= nwg) return false;
        int wgid = (int)L; { const int q = nwg / NXCD, r = nwg % NXCD, xcd = wgid % NXCD, off = wgid / NXCD; wgid = (xcd < r ? xcd * (q + 1) : r * (q + 1) + (xcd - r) * q) + off; }
        const int nig = WGM * nN, gid = wgid / nig, fm = gid * WGM, gsz = (nM - fm) < WGM ? (nM - fm) : WGM;
        u.pm = fm + ((wgid % nig) % gsz); u.pn = (wgid % nig) / gsz; u.kofs = 0; if (skip) u.pm += u.pm / 16; return true;
    }
    __device__ __forceinline__ void a_ready(const Unit&) const {}
    __device__ __forceinline__ void done(const Unit&) const {}
};

struct CtxSplitK {
    int G, c, kq;
    __host__ __device__ void init(int Kfull, int G_, int c_) { G = G_; c = c_; kq = Kfull / 4; }
    __host__ __device__ bool next(int i, Unit& u) const { const long L = (long)i * G + c; if (L >= 256) return false; const int l = (int)L; u.pm = (l >> 4) * 17 + 16; u.pn = (l >> 2) & 3; u.kofs = (l & 3) * kq; return true; }
    __device__ __forceinline__ void a_ready(const Unit&) const {}
    __device__ __forceinline__ void done(const Unit&) const {}
};
__device__ __forceinline__ unsigned cvt_pk_bf16(float lo, float hi) { unsigned r; asm volatile("v_cvt_pk_bf16_f32 %0, %1, %2" : "=v"(r) : "v"(lo), "v"(hi)); return r; }
typedef float f32x2 __attribute__((ext_vector_type(2)));
template <class Epi, class Sched, bool ALIGN_EPI = false, bool SP2 = false>
__device__ __forceinline__ void gemm_phase(PG8_LAS unsigned char* lds, const Gemm g, const Sched& S, const Epi& E) {
    int tid_ = threadIdx.x; asm volatile("" : "+v"(tid_)); const int tid = tid_, wid = __builtin_amdgcn_readfirstlane(tid >> 6), lane = tid & 63, wr = wid >> 2, wc = wid & 3, fr = lane & 15, fq = lane >> 4;
    const int K = g.K, nt = K / BK;
    unsigned voffA[2], voffB[2];
#pragma unroll
    for (int i = 0; i < 2; ++i) { int R, C; stage_rc(tid * 16 + i * 8192, R, C); const int Rb = Epi::PERM ? ((R & ~31) + perm32(R & 31)) : R;
        voffA[i] = (unsigned)(R * g.lda + C) * 2u; voffB[i] = (unsigned)(Rb * g.ldb + C) * 2u; }
    const size_t kstep = (size_t)(BK * 2);
    const size_t hA = (size_t)HALF * g.lda * 2, hB = (size_t)HALF * g.ldb * 2;
    const size_t tA = 2 * hA, tB = 2 * hB, pnA = (size_t)g.a_pn_off * 2;
    const unsigned ldsw = (unsigned)wid * 1024u;
    const int aoff = lds_byte(wr * 64 + fr, fq * 8), boff = lds_byte(wc * 32 + fr, fq * 8);
#define PG8_SA(b, h) (((b) * 2 + (h)) * HTB)
#define PG8_SB(b, h) ((4 + (b) * 2 + (h)) * HTB)
#define PG8_STAGE(bufoff, gbase, voff) do { _Pragma("unroll") for (int _i = 0; _i < 2; ++_i) \
        __builtin_amdgcn_global_load_lds((const unsigned*)((const char*)(gbase) + (voff)[_i]), (PG8_LAS unsigned*)(lds + (bufoff) + ldsw + _i * 8192), 16, 0, 0); } while (0)
#define PG8_LDA(dst, b, h) do { _Pragma("unroll") for (int m = 0; m < 4; ++m) _Pragma("unroll") for (int k = 0; k < 2; ++k) dst[m][k] = *(const PG8_LAS bf16x8*)(lds + PG8_SA(b, h) + aoff + m * 2048 + k * 1024); } while (0)
#define PG8_LDB(dst, b, h) do { _Pragma("unroll") for (int n = 0; n < 2; ++n) _Pragma("unroll") for (int k = 0; k < 2; ++k) dst[n][k] = *(const PG8_LAS bf16x8*)(lds + PG8_SB(b, h) + boff + n * 2048 + k * 1024); } while (0)
#define PG8_MMA(ai, bj, At, Bt) do { __builtin_amdgcn_s_setprio(1); _Pragma("unroll") for (int m = 0; m < 4; ++m) _Pragma("unroll") for (int n = 0; n < 2; ++n) _Pragma("unroll") for (int k = 0; k < 2; ++k) \
        acc[ai][bj][m][n] = __builtin_amdgcn_mfma_f32_16x16x32_bf16(Bt[n][k], At[m][k], acc[ai][bj][m][n], 0, 0, 0); __builtin_amdgcn_s_setprio(0); } while (0)
#define PG8_WAIT_V(n) asm volatile("s_waitcnt vmcnt(" #n ")" ::: "memory")
#define PG8_WAIT_L(n) asm volatile("s_waitcnt lgkmcnt(" #n ")" ::: "memory")
#define PG8_BAR __builtin_amdgcn_s_barrier()
#define PG8_SCHED __builtin_amdgcn_sched_barrier(0)
    Unit cur, nxt; int ui = 0;
    if (!S.next(0, cur)) return;
    f32x4 acc[2][2][4][2];
#pragma unroll
    for (int a = 0; a < 2; ++a)
#pragma unroll
        for (int b = 0; b < 2; ++b)
#pragma unroll
            for (int m = 0; m < 4; ++m)
#pragma unroll
                for (int n = 0; n < 2; ++n) acc[a][b][m][n] = (f32x4){0.f, 0.f, 0.f, 0.f};
    bf16x8 At[4][2], B0[2][2], B1[2][2];
    const char* cA = (const char*)g.A + (size_t)cur.pm * tA + (size_t)cur.pn * pnA + (size_t)cur.kofs * 2; const char* cB = (const char*)g.Bt + (size_t)cur.pn * tB + (size_t)cur.kofs * 2;
    S.a_ready(cur);
    if constexpr (SP2) {
        PG8_STAGE(PG8_SB(0, 0), cB, voffB); PG8_STAGE(PG8_SB(0, 1), cB + hB, voffB); PG8_STAGE(PG8_SA(0, 0), cA, voffA); PG8_STAGE(PG8_SA(0, 1), cA + hA, voffA);
        if (wr == 1) PG8_BAR;
        PG8_WAIT_V(2); PG8_BAR;
        PG8_STAGE(PG8_SB(1, 0), cB + kstep, voffB); PG8_STAGE(PG8_SA(1, 0), cA + kstep, voffA); PG8_STAGE(PG8_SB(1, 1), cB + hB + kstep, voffB);
        PG8_WAIT_V(6); PG8_BAR;
    } else {
        PG8_STAGE(PG8_SB(0, 0), cB, voffB); PG8_STAGE(PG8_SA(0, 0), cA, voffA); PG8_STAGE(PG8_SB(0, 1), cB + hB, voffB); PG8_STAGE(PG8_SA(0, 1), cA + hA, voffA);
        if (wr == 1) PG8_BAR;
        PG8_WAIT_V(4); PG8_BAR;
        PG8_STAGE(PG8_SB(1, 0), cB + kstep, voffB); PG8_STAGE(PG8_SA(1, 0), cA + kstep, voffA); PG8_STAGE(PG8_SB(1, 1), cB + hB + kstep, voffB);
        PG8_WAIT_V(6); PG8_BAR;
    }
    for (;;) {
        const bool has_next = S.next(ui + 1, nxt);
        const char* nA = has_next ? (const char*)g.A + (size_t)nxt.pm * tA + (size_t)nxt.pn * pnA + (size_t)nxt.kofs * 2 : cA; const char* nB = has_next ? (const char*)g.Bt + (size_t)nxt.pn * tB + (size_t)nxt.kofs * 2 : cB;
#pragma unroll 1
        for (int t = 0; t < nt; t += 2) {
            const bool last = (t == nt - 2);
            const char* a1 = cA + (size_t)(t + 1) * kstep;
            const char* a2 = last ? nA : cA + (size_t)(t + 2) * kstep; const char* b2 = last ? nB : cB + (size_t)(t + 2) * kstep;
            const char* a3 = a2 + kstep; const char* b3 = b2 + kstep;
            if (last && has_next) S.a_ready(nxt);
            if constexpr (SP2) {
            PG8_LDB(B0, 0, 0); PG8_LDB(B1, 0, 1); PG8_SCHED; PG8_LDA(At, 0, 0); PG8_STAGE(PG8_SA(1, 1), a1 + hA, voffA);
            PG8_WAIT_V(8); PG8_WAIT_L(0); PG8_BAR; PG8_MMA(0, 0, At, B0); PG8_MMA(0, 1, At, B1); PG8_BAR; PG8_SCHED;
            PG8_LDA(At, 0, 1); PG8_STAGE(PG8_SB(0, 0), b2, voffB); PG8_STAGE(PG8_SB(0, 1), b2 + hB, voffB); PG8_STAGE(PG8_SA(0, 0), a2, voffA);
            PG8_WAIT_V(8); PG8_WAIT_L(0); PG8_BAR; PG8_MMA(1, 0, At, B0); PG8_MMA(1, 1, At, B1); PG8_BAR; PG8_SCHED;
            PG8_LDB(B0, 1, 0); PG8_LDB(B1, 1, 1); PG8_SCHED; PG8_LDA(At, 1, 0); PG8_STAGE(PG8_SA(0, 1), a2 + hA, voffA);
            PG8_WAIT_V(8); PG8_WAIT_L(0); PG8_BAR; PG8_MMA(0, 0, At, B0); PG8_MMA(0, 1, At, B1); PG8_BAR; PG8_SCHED;
            PG8_LDA(At, 1, 1); PG8_STAGE(PG8_SB(1, 0), b3, voffB); PG8_STAGE(PG8_SB(1, 1), b3 + hB, voffB); PG8_STAGE(PG8_SA(1, 0), a3, voffA);
            PG8_WAIT_V(8); PG8_WAIT_L(0); PG8_BAR; PG8_MMA(1, 0, At, B0); PG8_MMA(1, 1, At, B1); PG8_BAR; PG8_SCHED;
            } else {
            PG8_LDB(B0, 0, 0); PG8_SCHED; PG8_LDA(At, 0, 0); PG8_STAGE(PG8_SA(1, 1), a1 + hA, voffA);
            PG8_WAIT_L(8); PG8_BAR; PG8_WAIT_L(0); PG8_MMA(0, 0, At, B0); PG8_BAR; PG8_SCHED;
            PG8_LDB(B1, 0, 1); PG8_STAGE(PG8_SB(0, 0), b2, voffB);
            PG8_BAR; PG8_WAIT_L(0); PG8_MMA(0, 1, At, B1); PG8_BAR;
            PG8_LDA(At, 0, 1); PG8_STAGE(PG8_SA(0, 0), a2, voffA);
            PG8_BAR; PG8_WAIT_L(0); PG8_MMA(1, 0, At, B0); PG8_BAR; PG8_SCHED;
            PG8_STAGE(PG8_SB(0, 1), b2 + hB, voffB);
            PG8_WAIT_V(6); PG8_BAR; PG8_MMA(1, 1, At, B1); PG8_BAR;
            PG8_LDB(B0, 1, 0); PG8_SCHED; PG8_LDA(At, 1, 0); PG8_STAGE(PG8_SA(0, 1), a2 + hA, voffA);
            PG8_WAIT_L(8); PG8_BAR; PG8_WAIT_L(0); PG8_MMA(0, 0, At, B0); PG8_BAR; PG8_SCHED;
            PG8_LDB(B1, 1, 1); PG8_STAGE(PG8_SB(1, 0), b3, voffB);
            PG8_BAR; PG8_WAIT_L(0); PG8_MMA(0, 1, At, B1); PG8_BAR;
            PG8_LDA(At, 1, 1); PG8_STAGE(PG8_SA(1, 0), a3, voffA);
            PG8_BAR; PG8_WAIT_L(0); PG8_MMA(1, 0, At, B0); PG8_BAR; PG8_SCHED;
            PG8_STAGE(PG8_SB(1, 1), b3 + hB, voffB);
            PG8_WAIT_V(6); PG8_BAR; PG8_MMA(1, 1, At, B1); PG8_BAR;
            }
        }
        if constexpr (ALIGN_EPI) { if (wr == 0) PG8_BAR; }
        if constexpr (!Epi::AFTER_DRAIN) { E(acc, cur, wr, wc, fr, fq); S.done(cur); }
        if (!has_next) break;
#pragma unroll
        for (int a = 0; a < 2; ++a)
#pragma unroll
            for (int b = 0; b < 2; ++b)
#pragma unroll
                for (int m = 0; m < 4; ++m)
#pragma unroll
                    for (int n = 0; n < 2; ++n) acc[a][b][m][n] = (f32x4){0.f, 0.f, 0.f, 0.f};
        cur = nxt; cA = nA; cB = nB; ++ui;
        if constexpr (ALIGN_EPI) { if (wr == 1) PG8_BAR; }
    }
    PG8_WAIT_V(0);
    if constexpr (!ALIGN_EPI) { if (wr == 0) PG8_BAR; }
    PG8_BAR;
    if constexpr (Epi::AFTER_DRAIN) { E.fused(acc, cur, wr, wc, fr, fq, lds, wid, lane); S.done(cur); }
#undef PG8_SA
#undef PG8_SB
#undef PG8_STAGE
#undef PG8_LDA
#undef PG8_LDB
#undef PG8_MMA
#undef PG8_WAIT_V
#undef PG8_WAIT_L
#undef PG8_BAR
#undef PG8_SCHED
}
}
#include <hip/hip_bf16.h>
#include <cmath>
namespace attn_body {
using bf16=__hip_bfloat16;
using bf16x8=__attribute__((ext_vector_type(8)))short;
using s16x4=__attribute__((ext_vector_type(4)))short;
using f32x16=__attribute__((ext_vector_type(16)))float;
using u32x4=__attribute__((ext_vector_type(4)))unsigned;
constexpr int D=64,DM=1024,KVP=256;
constexpr int NW=8,QBLK=32,QB=QBLK*NW,KVBLK=64;
constexpr int ATTN_PITCH=DM, ATTN_UNIT_ROWS=QB;
__device__ __forceinline__ int crow(int r,int hi){return (r&3)+8*(r>>2)+4*hi;}
#define SBAR() __builtin_amdgcn_sched_barrier(0)
__device__ __forceinline__ void cmask(f32x16&p0,f32x16&p1,int jb,int qrel,int hi){
  const float NEG=-INFINITY; int kb=64*jb+4*hi;
  #pragma unroll
  for(int r=0;r<16;++r){int kv=kb+(r&3)+8*(r>>2); if(kv>qrel)p0[r]=NEG; if(kv+32>qrel)p1[r]=NEG;}
}

constexpr int NSLOT=3, SLOTB=8192;
constexpr int LDS_K=0, LDS_V=NSLOT*SLOTB, LDS_WS=2*NSLOT*SLOTB, LDS_OST=LDS_WS+NW*64*4, LDS_BYTES=LDS_OST+NW*4096;
constexpr float C2=0.125f*1.4426950408889634f;
__device__ __forceinline__ void glds16(const void*gsrc,unsigned lds_dst){unsigned keep;
  asm volatile("s_mov_b32 %0, m0\n\ts_mov_b32 m0, %2\n\ts_nop 0\n\tglobal_load_lds_dwordx4 %1, off\n\ts_mov_b32 m0, %0":"=&s"(keep):"v"(gsrc),"s"(lds_dst):"memory");}
__device__ __forceinline__ float max3f(float a,float b,float c){float r;asm("v_max3_f32 %0, %1, %2, %3":"=v"(r):"v"(a),"v"(b),"v"(c));return r;}
__device__ __forceinline__ float max2f(float a,float b){float r;asm("v_max_f32_e32 %0, %1, %2":"=v"(r):"v"(a),"v"(b));return r;}
__device__ __forceinline__ float fadd_s(float a,float b){float r;asm("v_add_f32_e32 %0, %1, %2":"=v"(r):"v"(a),"v"(b));return r;}
__device__ __forceinline__ float fsub_s(float a,float b){float r;asm("v_sub_f32_e32 %0, %1, %2":"=v"(r):"v"(a),"v"(b));return r;}
typedef float f32x2_t __attribute__((ext_vector_type(2))); typedef __bf16 bf16x2_t __attribute__((ext_vector_type(2)));
__device__ __forceinline__ unsigned cvtpk_s(float lo,float hi){f32x2_t v={lo,hi};bf16x2_t b=__builtin_convertvector(v,bf16x2_t);return __builtin_bit_cast(unsigned,b);}
#define WAIT_BAR(N) asm volatile("s_waitcnt vmcnt(" #N ") lgkmcnt(0)\n\ts_barrier":::"memory")

__device__ __forceinline__ void qkt(f32x16&p0,f32x16&p1,const char*Kslot,const bf16x8*qr,const f32x16&negm,int r32,int hi){
  const char*kb=Kslot+hi*1024+r32*16;
  #pragma unroll
  for(int d0=0;d0<4;++d0){
    const bf16x8 b0=*reinterpret_cast<const bf16x8*>(kb+d0*2048);
    const bf16x8 b1=*reinterpret_cast<const bf16x8*>(kb+d0*2048+512);
    if(d0==0){p0=__builtin_amdgcn_mfma_f32_32x32x16_bf16(b0,qr[0],negm,0,0,0);p1=__builtin_amdgcn_mfma_f32_32x32x16_bf16(b1,qr[0],negm,0,0,0);}
    else{p0=__builtin_amdgcn_mfma_f32_32x32x16_bf16(b0,qr[d0],p0,0,0,0);p1=__builtin_amdgcn_mfma_f32_32x32x16_bf16(b1,qr[d0],p1,0,0,0);}}
}
typedef __attribute__((address_space(3))) const char* lds_cptr;
typedef short v4i16_t __attribute__((ext_vector_type(4)));
__device__ __forceinline__ void kload8(bf16x8*kf,lds_cptr kp){
  kf[0]=*(const __attribute__((address_space(3))) bf16x8*)(kp);      kf[1]=*(const __attribute__((address_space(3))) bf16x8*)(kp+512);
  kf[2]=*(const __attribute__((address_space(3))) bf16x8*)(kp+2048); kf[3]=*(const __attribute__((address_space(3))) bf16x8*)(kp+2560);
  kf[4]=*(const __attribute__((address_space(3))) bf16x8*)(kp+4096); kf[5]=*(const __attribute__((address_space(3))) bf16x8*)(kp+4608);
  kf[6]=*(const __attribute__((address_space(3))) bf16x8*)(kp+6144); kf[7]=*(const __attribute__((address_space(3))) bf16x8*)(kp+6656);
}
__device__ __forceinline__ void kload2(bf16x8*kf,lds_cptr kp,int j){ kf[2*j]=*(const __attribute__((address_space(3))) bf16x8*)(kp+j*2048); kf[2*j+1]=*(const __attribute__((address_space(3))) bf16x8*)(kp+j*2048+512); }
__device__ __forceinline__ s16x4 vtr(lds_cptr p){ return __builtin_bit_cast(s16x4,__builtin_amdgcn_ds_read_tr16_b64_v4i16((__attribute__((address_space(3))) v4i16_t*)p)); }
__device__ __forceinline__ float rowmax(const f32x16&p0,const f32x16&p1){
  float a=max3f(p0[0],p0[1],p1[0]),b=max3f(p0[2],p0[3],p1[1]);a=max3f(a,p1[2],p1[3]);
  #pragma unroll
  for(int r=4;r<16;r+=4){a=max3f(a,p0[r],p0[r+1]);b=max3f(b,p0[r+2],p0[r+3]);a=max3f(a,p1[r],p1[r+1]);b=max3f(b,p1[r+2],p1[r+3]);}
  const float m=max2f(a,b);
  auto rr=__builtin_amdgcn_permlane32_swap(__float_as_uint(m),__float_as_uint(m),false,false);
  return max2f(__uint_as_float(rr[0]),__uint_as_float(rr[1]));
}
__device__ __forceinline__ void pv(f32x16*o,int vb,bf16x8 pa0,bf16x8 pa1,bf16x8 pa2,bf16x8 pa3){
  #pragma unroll
  for(int d0=0;d0<2;++d0){s16x4 lo[4],hi[4];
    #pragma unroll
    for(int ks=0;ks<4;++ks){
      asm volatile("ds_read_b64_tr_b16 %0,%1 offset:%c2":"=&v"(lo[ks]):"v"(vb),"i"(d0*4096+ks*1024):"memory");
      asm volatile("ds_read_b64_tr_b16 %0,%1 offset:%c2":"=&v"(hi[ks]):"v"(vb),"i"(d0*4096+ks*1024+512):"memory");}
    asm volatile("s_waitcnt lgkmcnt(0)":::"memory");SBAR();
    #define PK(k) (bf16x8){lo[k][0],lo[k][1],lo[k][2],lo[k][3],hi[k][0],hi[k][1],hi[k][2],hi[k][3]}
    o[d0]=__builtin_amdgcn_mfma_f32_32x32x16_bf16(pa0,PK(0),o[d0],0,0,0);
    o[d0]=__builtin_amdgcn_mfma_f32_32x32x16_bf16(pa1,PK(1),o[d0],0,0,0);
    o[d0]=__builtin_amdgcn_mfma_f32_32x32x16_bf16(pa2,PK(2),o[d0],0,0,0);
    o[d0]=__builtin_amdgcn_mfma_f32_32x32x16_bf16(pa3,PK(3),o[d0],0,0,0);
    #undef PK
  }
}

#ifndef ATTN_STORE16
#define ATTN_STORE16(p,v) (*(u32x4*)(p)=(v))
#endif
template<int THRL> __device__ __forceinline__ void attn_unit(long qrow0,long kvrow0,const int NT,int h,const bf16*Q,const bf16*__restrict__ K,const bf16*__restrict__ V,bf16*O,char*shm){
  int tid_=threadIdx.x; asm volatile("":"+v"(tid_)); const int tid=tid_,lane=tid&63,r32=lane&31,hi=lane>>5; const int wid=__builtin_amdgcn_readfirstlane(tid>>6);
  const int g=h>>2;
  const bf16*Qw=Q+(qrow0+wid*QBLK)*DM+h*D;
  const bf16*Kh=K+kvrow0*KVP+g*D,*Vh=V+kvrow0*KVP+g*D;
  const unsigned lds0=(unsigned)(uintptr_t)shm;
  float*wsf=(float*)(shm+LDS_WS)+wid*64;
  const bf16*ksrc=Kh+(long)lane*KVP+wid*8;
  const bf16*vsrc=Vh+(long)(16*(wid&3)+(lane>>2))*KVP+(wid>>2)*32+(lane&3)*8;
  const unsigned kdst=lds0+LDS_K+wid*1024, vdst=lds0+LDS_V+wid*1024;
  #define DMA_K(t,slot) glds16(ksrc+(long)(t)*KVBLK*KVP,(unsigned)__builtin_amdgcn_readfirstlane(kdst+(slot)))
  #define DMA_V(t,slot) glds16(vsrc+(long)(t)*KVBLK*KVP,(unsigned)__builtin_amdgcn_readfirstlane(vdst+(slot)))
  const int vb0=(int)(lds0+LDS_V)+((lane>>4)&1)*32+(lane&3)*8+(4*hi+((lane&15)>>2))*64;
  const char*Kbase=shm+LDS_K; bf16x8 kf[8];
  const lds_cptr shm3=(lds_cptr)shm; const lds_cptr kp0=shm3+LDS_K+hi*1024+r32*16; const lds_cptr vp0=shm3+LDS_V+((lane>>4)&1)*32+(lane&3)*8+(4*hi+((lane&15)>>2))*64;
  DMA_K(0,0);DMA_V(0,0);DMA_K(1,SLOTB);
  bf16x8 qr[4];
  #pragma unroll
  for(int d0=0;d0<4;++d0)qr[d0]=*reinterpret_cast<const bf16x8*>(&Qw[(long)r32*DM+d0*16+hi*8]);
  float mhat=0.f,l_reg=0.f;f32x16 o[2];o[0]=f32x16{};o[1]=f32x16{};f32x16 negm=f32x16{};asm volatile("":"+v"(negm));
  const int qrel=wid*QBLK+r32;
  #define CMASK(P0,P1,t) do{}while(0)
  bool resc=false;
  #define START(P0,P1) do{ const float rm=rowmax(P0,P1); resc=false; \
    { const float dl=rm; mhat=fadd_s(mhat,dl); \
      _Pragma("unroll") for(int r=0;r<16;++r){P0[r]=fsub_s(P0[r],dl);P1[r]=fsub_s(P1[r],dl);} \
      _Pragma("unroll") for(int r=0;r<16;++r)negm[r]=-mhat; asm volatile("":"+v"(negm)); } \
    _Pragma("unroll") for(int r=0;r<16;++r)P0[r]=__builtin_amdgcn_exp2f(P0[r]); }while(0)
  #define RESC() do{ if(resc){ asm volatile("s_waitcnt lgkmcnt(0)":::"memory"); \
      _Pragma("unroll") for(int d_=0;d_<2;++d_) _Pragma("unroll") for(int r=0;r<16;++r)o[d_][r]*=wsf[crow(r,hi)]; } }while(0)
  f32x16 pA0,pA1,pB0,pB1;
  int sl_prev=0,sl_cur=0,sl_next=SLOTB;
  #define ROT() do{sl_prev=sl_cur;sl_cur=sl_next;sl_next=(sl_next==(NSLOT-1)*SLOTB)?0:sl_next+SLOTB;}while(0)
  DMA_K(2,2*SLOTB);
  WAIT_BAR(3);
  qkt(pA0,pA1,Kbase,qr,negm,r32,hi);asm volatile("s_nop 15\n\ts_nop 7":"+v"(pA0),"+v"(pA1));CMASK(pA0,pA1,0);
  START(pA0,pA1);
  _Pragma("unroll") for(int r=0;r<16;++r)pA1[r]=__builtin_amdgcn_exp2f(pA1[r]);
  WAIT_BAR(0);
  DMA_K(3,0);DMA_V(1,SLOTB);
  ROT();
  kload8(kf,kp0+sl_cur);
  WAIT_BAR(2);
  s16x4 vlo[8],vhi[8]; u32x4 pw0,pw1,pw2,pw3;
  #define PKW(P,B) cvtpk_s(P[B],P[B+1])
  #define PAF(k) __builtin_bit_cast(bf16x8,pw##k)
  #define VFR(i) (bf16x8){vlo[i][0],vlo[i][1],vlo[i][2],vlo[i][3],vhi[i][0],vhi[i][1],vhi[i][2],vhi[i][3]}
  #define PIN(x) asm volatile("":"+v"(x))
  #define MX3(a,b,c) __builtin_fmaxf(__builtin_fmaxf((a),(b)),(c))
  #define GAPA(MF,A0,A1,A2,A3,W0,W1,PW) do{ MF; sacc+=A0; sacc+=A1; sacc+=A2; sacc+=A3; PIN(sacc); W0; W1; PIN(PW); SBAR(); }while(0)
  #define EX(v) __builtin_amdgcn_exp2f(v)
  #define GAPB(MF,X,B) do{ MF; X[B]=EX(X[B]); X[B+1]=EX(X[B+1]); X[B+2]=EX(X[B+2]); X[B+3]=EX(X[B+3]); PIN(X); SBAR(); }while(0)
  #define VRD(i) do{ vlo[i]=vtr(vp_+(((i)>>2)*4096+((i)&3)*1024)); vhi[i]=vtr(vp_+(((i)>>2)*4096+((i)&3)*1024+512)); }while(0)
  #define KRD(G,j) do{ if(G){ kload2(kf,kp0+sl_next,j); SBAR(); } }while(0)
  #define STEP(C0,C1,P0,P1,t,GK,GV,GL) do{ SBAR(); \
    const lds_cptr vp_=vp0+sl_prev; \
    VRD(0); SBAR(); float sacc=(P0[0]+P0[1]); \
    GAPA(C0=__builtin_amdgcn_mfma_f32_32x32x16_bf16(kf[0],qr[0],negm,0,0,0), P0[2],P0[3],P0[4],P0[5],     pw0[0]=PKW(P0,0), pw0[1]=PKW(P0,2), pw0); \
    VRD(4); SBAR(); GAPA(C1=__builtin_amdgcn_mfma_f32_32x32x16_bf16(kf[1],qr[0],negm,0,0,0), P0[6],P0[7],P0[8],P0[9],     pw0[2]=PKW(P0,4), pw0[3]=PKW(P0,6), pw0); \
    VRD(1); SBAR(); GAPA(C0=__builtin_amdgcn_mfma_f32_32x32x16_bf16(kf[2],qr[1],C0,0,0,0),   P0[10],P0[11],P0[12],P0[13], pw1[0]=PKW(P0,8), pw1[1]=PKW(P0,10), pw1); \
    VRD(5); SBAR(); GAPA(C1=__builtin_amdgcn_mfma_f32_32x32x16_bf16(kf[3],qr[1],C1,0,0,0),   P0[14],P0[15],P1[0],P1[1],   pw1[2]=PKW(P0,12),pw1[3]=PKW(P0,14), pw1); \
    VRD(2); SBAR(); GAPA(C0=__builtin_amdgcn_mfma_f32_32x32x16_bf16(kf[4],qr[2],C0,0,0,0),   P1[2],P1[3],P1[4],P1[5],     pw2[0]=PKW(P1,0), pw2[1]=PKW(P1,2), pw2); \
    VRD(6); SBAR(); GAPA(C1=__builtin_amdgcn_mfma_f32_32x32x16_bf16(kf[5],qr[2],C1,0,0,0),   P1[6],P1[7],P1[8],P1[9],     pw2[2]=PKW(P1,4), pw2[3]=PKW(P1,6), pw2); \
    VRD(3); SBAR(); GAPA(C0=__builtin_amdgcn_mfma_f32_32x32x16_bf16(kf[6],qr[3],C0,0,0,0),   P1[10],P1[11],P1[12],P1[13], pw3[0]=PKW(P1,8), pw3[1]=PKW(P1,10), pw3); \
    VRD(7); SBAR(); GAPA(C1=__builtin_amdgcn_mfma_f32_32x32x16_bf16(kf[7],qr[3],C1,0,0,0),   P1[14],P1[15],0.f,0.f,       pw3[2]=PKW(P1,12),pw3[3]=PKW(P1,14), pw3); \
    l_reg+=sacc; \
    if(GK){DMA_K((t)+3,sl_cur);} if(GV){DMA_V((t)+1,sl_next);} \
    CMASK(C0,C1,t); \
    { float a=MX3(C0[0],C0[1],C1[0]),b=MX3(C0[2],C0[3],C1[1]); a=MX3(a,C1[2],C1[3]); \
      _Pragma("unroll") for(int r=4;r<16;r+=4){a=MX3(a,C0[r],C0[r+1]);b=MX3(b,C0[r+2],C0[r+3]);a=MX3(a,C1[r],C1[r+1]);b=MX3(b,C1[r+2],C1[r+3]);} \
      float rm=__builtin_fmaxf(a,b); { auto rr=__builtin_amdgcn_permlane32_swap(__float_as_uint(rm),__float_as_uint(rm),false,false); rm=__builtin_fmaxf(__uint_as_float(rr[0]),__uint_as_float(rr[1])); } \
      resc=false; \
      if(__builtin_expect(__any(rm>(float)THRL),0)){ const float dl=__builtin_fmaxf(rm,0.f); mhat+=dl; \
        _Pragma("unroll") for(int r=0;r<16;++r){C0[r]-=dl;C1[r]-=dl;} \
        _Pragma("unroll") for(int r=0;r<16;++r)negm[r]=-mhat; asm volatile("":"+v"(negm)); \
        const float f=__builtin_amdgcn_exp2f(-dl); l_reg*=f; if(hi==0)wsf[r32]=f; resc=true; } } \
    SBAR(); \
    GAPB(o[0]=__builtin_amdgcn_mfma_f32_32x32x16_bf16(PAF(0),VFR(0),o[0],0,0,0), C0,0); \
    GAPB(o[1]=__builtin_amdgcn_mfma_f32_32x32x16_bf16(PAF(0),VFR(4),o[1],0,0,0), C0,4); \
    KRD(GL,0); GAPB(o[0]=__builtin_amdgcn_mfma_f32_32x32x16_bf16(PAF(1),VFR(1),o[0],0,0,0), C0,8); \
    KRD(GL,1); GAPB(o[1]=__builtin_amdgcn_mfma_f32_32x32x16_bf16(PAF(1),VFR(5),o[1],0,0,0), C0,12); \
    KRD(GL,2); GAPB(o[0]=__builtin_amdgcn_mfma_f32_32x32x16_bf16(PAF(2),VFR(2),o[0],0,0,0), C1,0); \
    KRD(GL,3); GAPB(o[1]=__builtin_amdgcn_mfma_f32_32x32x16_bf16(PAF(2),VFR(6),o[1],0,0,0), C1,4); \
    GAPB(o[0]=__builtin_amdgcn_mfma_f32_32x32x16_bf16(PAF(3),VFR(3),o[0],0,0,0), C1,8); \
    GAPB(o[1]=__builtin_amdgcn_mfma_f32_32x32x16_bf16(PAF(3),VFR(7),o[1],0,0,0), C1,12); \
    }while(0)
  int t=1;
  #undef CMASK
  #define CMASK(P0,P1,t) do{}while(0)
  for(;t+5<NT;t+=2){
    STEP(pB0,pB1,pA0,pA1,t,true,true,true);     WAIT_BAR(2); RESC(); ROT();
    STEP(pA0,pA1,pB0,pB1,t+1,true,true,true);   WAIT_BAR(2); RESC(); ROT();
  }
  #undef CMASK
  #define CMASK(P0,P1,t) do{}while(0)
  #define ENDW(tt) do{ if((tt)+3<NT){WAIT_BAR(2);} else if((tt)+2<NT){WAIT_BAR(1);} else {WAIT_BAR(0);} }while(0)
  for(;t+1<NT;t+=2){
    STEP(pB0,pB1,pA0,pA1,t,(t+3<NT),(t+1<NT),(t+1<NT));       ENDW(t);   RESC(); ROT();
    STEP(pA0,pA1,pB0,pB1,t+1,(t+4<NT),(t+2<NT),(t+2<NT));     ENDW(t+1); RESC(); ROT();
  }
  STEP(pB0,pB1,pA0,pA1,NT-1,false,false,false); RESC();
  { float sacc=pB0[0]+pB0[1]; _Pragma("unroll") for(int r=2;r<16;++r)sacc+=pB0[r]; _Pragma("unroll") for(int r=0;r<16;++r)sacc+=pB1[r]; l_reg+=sacc;
    pw0=(u32x4){PKW(pB0,0),PKW(pB0,2),PKW(pB0,4),PKW(pB0,6)};pw1=(u32x4){PKW(pB0,8),PKW(pB0,10),PKW(pB0,12),PKW(pB0,14)};pw2=(u32x4){PKW(pB1,0),PKW(pB1,2),PKW(pB1,4),PKW(pB1,6)};pw3=(u32x4){PKW(pB1,8),PKW(pB1,10),PKW(pB1,12),PKW(pB1,14)};
    SBAR(); pv(o,vb0+sl_cur,PAF(0),PAF(1),PAF(2),PAF(3)); }
  #undef PKW
  #undef PAF
  #undef VFR
  #undef PIN
  #undef MX3
  #undef GAPA
  #undef GAPB
  #undef EX
  #undef VRD
  #undef KRD
  #undef STEP
  #undef ENDW
  {auto rr=__builtin_amdgcn_permlane32_swap(__float_as_uint(l_reg),__float_as_uint(l_reg),false,false);l_reg=__uint_as_float(rr[0])+__uint_as_float(rr[1]);}
  if(hi==0)wsf[32+r32]=l_reg;asm volatile("s_waitcnt lgkmcnt(0)":::"memory");
  float rli[16];
  #pragma unroll
  for(int r=0;r<16;++r)rli[r]=__builtin_amdgcn_rcpf(wsf[32+crow(r,hi)]);
  bf16*Ow=O+(qrow0+wid*QBLK)*DM+h*D;
  { bf16*stg=(bf16*)(shm+LDS_OST)+wid*2048;
    #pragma unroll
    for(int r=0;r<16;++r){const int orow=crow(r,hi);
      #pragma unroll
      for(int d0=0;d0<2;++d0)stg[orow*64+d0*32+r32]=__float2bfloat16(o[d0][r]*rli[r]);}
    asm volatile("s_waitcnt lgkmcnt(0)":::"memory");
    #pragma unroll
    for(int i=0;i<4;++i){const int row=i*8+(lane>>3),ch=lane&7; const u32x4 v=*(const u32x4*)(stg+row*64+ch*8); ATTN_STORE16(Ow+(long)row*DM+ch*8,v);} }
  asm volatile("s_waitcnt lgkmcnt(0)\n\ts_barrier":::"memory");
  #undef DMA_K
  #undef DMA_V
  #undef CMASK
  #undef START
  #undef RESC
  #undef ROT
}
constexpr int ATTN_LDS_BYTES=LDS_BYTES;
#undef SBAR
#undef WAIT_BAR
}
constexpr int NB = 16, SEQ = 4096, CTXL = 256, TPB = SEQ + CTXL, DM = 1024, FF = 4096, MROWS = NB * TPB;
constexpr int NMOD = 6 * DM;
constexpr int NWAVES = 8;
constexpr int LDS_BYTES = 147456;
constexpr float RMS_EPS = 1e-6f, GN_EPS_F = 64.0f * 1e-5f;
constexpr float QSCALE = 0.125f * 1.4426950408889634f;

#define LAS __attribute__((address_space(3)))
typedef unsigned short bf16;
typedef float f32x4 __attribute__((ext_vector_type(4)));
typedef float f32x2 __attribute__((ext_vector_type(2)));
typedef unsigned u32x4 __attribute__((ext_vector_type(4)));
typedef unsigned u32x2 __attribute__((ext_vector_type(2)));
typedef short bf16x8 __attribute__((ext_vector_type(8)));
using pg8::Unit; using pg8::cvt_pk_bf16;
constexpr int HALF = 128, BM = 256;

constexpr size_t MiB = 1u << 20;
constexpr size_t WS_ROWSQ = 64 * 1024  , WS_SW = 2 * MiB  , WS_ZERO_BYTES = 2 * MiB;
constexpr size_t WS_MODP = 4 * MiB, WS_MOD = 11 * MiB, WS_ROPE = 13 * MiB, WS_BONUS = 15 * MiB, WS_CTX = 24 * MiB, WS_W = 40 * MiB, WS_ACT = 132 * MiB, WS_NEED = 1024 * MiB;
constexpr size_t W_QKV = 0, W_WO = 6 * MiB, W_IN = 10 * MiB, W_OUT = 42 * MiB, W_R1 = 74 * MiB, W_G2 = 88 * MiB, W_RWO = 89 * MiB, W_POOL = 91 * MiB;
constexpr size_t ACT1 = 136 * MiB;

__device__ __forceinline__ float bflo(unsigned u) { return __uint_as_float(u << 16); }
__device__ __forceinline__ float bfhi(unsigned u) { return __uint_as_float(u & 0xffff0000u); }
__device__ __forceinline__ float bf2f(unsigned short u) { return __uint_as_float(((unsigned)u) << 16); }
__device__ __forceinline__ float fsigmoid(float x) { return __builtin_amdgcn_rcpf(1.0f + __builtin_amdgcn_exp2f(-1.4426950408889634f * x)); }
__device__ __forceinline__ u32x4 pack8(f32x4 a, f32x4 b) { u32x4 w; w.x = cvt_pk_bf16(a[0], a[1]); w.y = cvt_pk_bf16(a[2], a[3]); w.z = cvt_pk_bf16(b[0], b[1]); w.w = cvt_pk_bf16(b[2], b[3]); return w; }
__device__ __forceinline__ void unpack8(u32x4 w, f32x4& a, f32x4& b) { a = (f32x4){bflo(w.x), bfhi(w.x), bflo(w.y), bfhi(w.y)}; b = (f32x4){bflo(w.z), bfhi(w.z), bflo(w.w), bfhi(w.w)}; }
__device__ __forceinline__ float wave_sum(float v) {
#pragma unroll
    for (int o = 1; o < 64; o <<= 1) v += __shfl_xor(v, o);
    return v;
}


struct EpiRelu2 {
    static constexpr bool PERM = true, AFTER_DRAIN = false;
    bf16* O; int ldc; const float* rowsq; const float* sw;
    __device__ __forceinline__ void operator()(const f32x4 (&acc)[2][2][4][2], const Unit& u, int wr_, int wc_, int fr_, int fq_) const {
        int wr = wr_, wc = wc_, fr = fr_, fq = fq_; asm volatile("" : "+s"(wr), "+s"(wc), "+v"(fr), "+v"(fq));
        const int row0 = u.pm * BM + wr * 64 + fr, col0 = u.pn * BM + wc * 32 + 8 * fq;
        const f32x4 z = (f32x4){0.f, 0.f, 0.f, 0.f};
        const int bb = u.pm / 17; const float* swr = sw + (size_t)((u.pm - bb * 17 == 16) ? 16 : bb) * FF + col0;
        f32x4 bv[2][2];
#pragma unroll
        for (int bj = 0; bj < 2; ++bj)
#pragma unroll
            for (int n = 0; n < 2; ++n) bv[bj][n] = *(const f32x4*)(swr + bj * HALF + 4 * n);
#pragma unroll
        for (int ai = 0; ai < 2; ++ai)
#pragma unroll
            for (int m = 0; m < 4; ++m) { bf16* rowp = O + (size_t)(row0 + ai * HALF + m * 16) * ldc + col0;
                const float rinv = __builtin_amdgcn_rsqf(rowsq[row0 + ai * HALF + m * 16] * (1.0f / DM) + RMS_EPS);
#pragma unroll
                for (int bj = 0; bj < 2; ++bj) { f32x4 v0 = __builtin_elementwise_max(acc[ai][bj][m][0] * rinv + bv[bj][0], z), v1 = __builtin_elementwise_max(acc[ai][bj][m][1] * rinv + bv[bj][1], z);
                    *(u32x4*)(rowp + bj * HALF) = pack8(v0 * v0, v1 * v1); } }
    }
};

template <bool ATOMIC> struct EpiResidT {
    static constexpr bool PERM = true, AFTER_DRAIN = false;
    const float* srcL; const float* srcC; float* dstL; float* dstC; const float* mod; int slot; const float* colscale;
    bf16* Hout; float* rowsq; const float* gamma; const float* hscale;
    const float* pend; const float* pgate;
    __device__ __forceinline__ void operator()(const f32x4 (&acc)[2][2][4][2], const Unit& u, int wr_, int wc_, int fr_, int fq_) const {
        int wr = wr_, wc = wc_, fr = fr_, fq = fq_; asm volatile("" : "+s"(wr), "+s"(wc), "+v"(fr), "+v"(fq));
        const int b = u.pm / 17, tt = u.pm - b * 17; const bool ctx = (tt == 16);
        const size_t tb = ctx ? (size_t)b * CTXL * DM : ((size_t)b * SEQ + (size_t)tt * 256) * DM;
        const float* s = (ctx ? srcC : srcL) + tb; float* d = (ctx ? dstC : dstL) + tb;
        const int col0 = u.pn * BM + wc * 32 + 8 * fq;
        const float* gate = mod + (size_t)(ctx ? 16 : b) * NMOD + slot * DM + col0;
        f32x4 gv[2][2];
#pragma unroll
        for (int bj = 0; bj < 2; ++bj)
#pragma unroll
            for (int n = 0; n < 2; ++n) { gv[bj][n] = *(const f32x4*)(gate + bj * HALF + n * 4); if (colscale) gv[bj][n] = gv[bj][n] * *(const f32x4*)(colscale + col0 + bj * HALF + n * 4); }
        f32x4 gs[2][2];
        if (Hout != nullptr) { const float* sc4 = hscale + (size_t)(ctx ? 16 : b) * NMOD + col0;
#pragma unroll
            for (int bj = 0; bj < 2; ++bj)
#pragma unroll
                for (int n = 0; n < 2; ++n) gs[bj][n] = *(const f32x4*)(gamma + col0 + bj * HALF + n * 4) * (*(const f32x4*)(sc4 + bj * HALF + n * 4) + 1.0f); }
#pragma unroll
        for (int ai = 0; ai < 2; ++ai)
#pragma unroll
            for (int m = 0; m < 4; ++m) { const size_t off = (size_t)(ai * HALF + wr * 64 + m * 16 + fr) * DM + col0; float ssq = 0.f; const size_t grow = (size_t)u.pm * BM + (ai * HALF + wr * 64 + m * 16 + fr);
#pragma unroll
                for (int bj = 0; bj < 2; ++bj) { f32x4 hq2[2];
#pragma unroll
                    for (int n = 0; n < 2; ++n) {
                        if constexpr (ATOMIC) { const f32x4 v = gv[bj][n] * acc[ai][bj][m][n]; float* p = d + off + bj * HALF + n * 4;
#pragma unroll
                            for (int e = 0; e < 4; ++e) (void)__hip_atomic_fetch_add(p + e, v[e], __ATOMIC_RELAXED, __HIP_MEMORY_SCOPE_AGENT); }
                        else { f32x4 bs = *(const f32x4*)(s + off + bj * HALF + n * 4);
                            if (pend != nullptr && ctx) { const float* pp = pend + tb + off + bj * HALF + n * 4; const f32x4 pg = *(const f32x4*)(pgate + col0 + bj * HALF + n * 4);
                                bs += pg * ((*(const f32x4*)(pp) + *(const f32x4*)(pp + (size_t)NB * CTXL * DM)) + (*(const f32x4*)(pp + (size_t)2 * NB * CTXL * DM) + *(const f32x4*)(pp + (size_t)3 * NB * CTXL * DM))); }
                            const f32x4 xn = bs + gv[bj][n] * acc[ai][bj][m][n]; *(f32x4*)(d + off + bj * HALF + n * 4) = xn;
                            if (Hout != nullptr) { ssq += (xn[0] * xn[0] + xn[1] * xn[1]) + (xn[2] * xn[2] + xn[3] * xn[3]); hq2[n] = xn * gs[bj][n];
                                if (n == 1) *(u32x4*)(Hout + grow * DM + col0 + bj * HALF) = pack8(hq2[0], hq2[1]); } } } }
                if (Hout != nullptr) { ssq += __shfl_xor(ssq, 16); ssq += __shfl_xor(ssq, 32); if (fq == 0) (void)__hip_atomic_fetch_add(rowsq + grow, ssq, __ATOMIC_RELAXED, __HIP_MEMORY_SCOPE_AGENT); }
                if (m == 3) asm volatile("" ::: "memory"); }
    }
};

typedef EpiResidT<false> EpiResid;
struct EpiPartial {
    static constexpr bool PERM = false, AFTER_DRAIN = false;
    float* part; int kq_len;
    __device__ __forceinline__ void operator()(const f32x4 (&acc)[2][2][4][2], const Unit& u, int wr_, int wc_, int fr_, int fq_) const {
        int wr = wr_, wc = wc_, fr = fr_, fq = fq_; asm volatile("" : "+s"(wr), "+s"(wc), "+v"(fr), "+v"(fq));
        const int b = u.pm / 17; const int kq = u.kofs / kq_len; const int col0 = u.pn * BM + wc * 32 + 4 * fq;
        float* d = part + ((size_t)kq * NB * CTXL + (size_t)b * CTXL) * DM + col0;
#pragma unroll
        for (int ai = 0; ai < 2; ++ai)
#pragma unroll
            for (int m = 0; m < 4; ++m) { const size_t off = (size_t)(ai * HALF + wr * 64 + m * 16 + fr) * DM;
#pragma unroll
                for (int bj = 0; bj < 2; ++bj)
#pragma unroll
                    for (int n = 0; n < 2; ++n) *(f32x4*)(d + off + bj * HALF + n * 16) = acc[ai][bj][m][n]; }
    }
};

struct EpiQKV {
    static constexpr bool PERM = true, AFTER_DRAIN = false;
    bf16* Q; bf16* Kb; bf16* Vb; const float* qg; const float* kg; const float* rope;
    __device__ __forceinline__ void operator()(const f32x4 (&acc)[2][2][4][2], const Unit& u, int wr_, int wc_, int fr_, int fq_) const {
        int wr = wr_, wc = wc_, fr = fr_, fq = fq_; asm volatile("" : "+s"(wr), "+s"(wc), "+v"(fr), "+v"(fq));
        const int tt = u.pm % 17; const int row0 = u.pm * BM + wr * 64 + fr;
        if (u.pn == 5) {
#pragma unroll
            for (int ai = 0; ai < 2; ++ai)
#pragma unroll
                for (int m = 0; m < 4; ++m) { bf16* rp = Vb + (size_t)(row0 + ai * HALF + m * 16) * 256 + wc * 64 + 8 * fq;
#pragma unroll
                    for (int bj = 0; bj < 2; ++bj) *(u32x4*)(rp + 32 * bj) = pack8(acc[ai][bj][m][0], acc[ai][bj][m][1]); }
            return;
        }
        const bool isq = u.pn < 4; const float* gain = isq ? qg : kg; const float osc = isq ? QSCALE : 1.0f;
        f32x4 g[2][2];
#pragma unroll
        for (int bj = 0; bj < 2; ++bj)
#pragma unroll
            for (int n = 0; n < 2; ++n) g[bj][n] = *(const f32x4*)(gain + 32 * bj + 8 * fq + 4 * n) * osc;
#pragma unroll
        for (int ai = 0; ai < 2; ++ai)
#pragma unroll
            for (int m = 0; m < 4; ++m) {
                float ss = 0.f;
#pragma unroll
                for (int bj = 0; bj < 2; ++bj)
#pragma unroll
                    for (int n = 0; n < 2; ++n) { const f32x4 x = acc[ai][bj][m][n]; ss += (x[0] * x[0] + x[1] * x[1]) + (x[2] * x[2] + x[3] * x[3]); }
                ss += __shfl_xor(ss, 16); ss += __shfl_xor(ss, 32);
                const float rinv = __builtin_amdgcn_rsqf(ss * (1.0f / 64.0f) + RMS_EPS);
                const int rl = ai * HALF + wr * 64 + m * 16 + fr;
                const int t = tt * 256 + rl;
                const float* rp = rope + (size_t)t * 64 + 8 * fq;
                f32x4 o1[2], o2[2];
#pragma unroll
                for (int n = 0; n < 2; ++n) { const f32x4 c = *(const f32x4*)(rp + 4 * n), s = *(const f32x4*)(rp + 32 + 4 * n);
                    const f32x4 x1 = acc[ai][0][m][n] * rinv * g[0][n], x2 = acc[ai][1][m][n] * rinv * g[1][n];
                    o1[n] = x1 * c - x2 * s; o2[n] = x1 * s + x2 * c; }
                const size_t grow = (size_t)(u.pm * BM + rl);
                bf16* dst = isq ? Q + grow * DM + (u.pn * 4 + wc) * 64 + 8 * fq : Kb + grow * 256 + wc * 64 + 8 * fq;
                *(u32x4*)(dst) = pack8(o1[0], o1[1]); *(u32x4*)(dst + 32) = pack8(o2[0], o2[1]);
            }
    }
};

struct EpiRwkv1 {
    static constexpr bool PERM = true, AFTER_DRAIN = false;
    bf16* Oo; bf16* KK; bf16* P; const float* k_k; int pn_base;
    __device__ __forceinline__ void operator()(const f32x4 (&acc)[2][2][4][2], const Unit& u, int wr_, int wc_, int fr_, int fq_) const {
        int wr = wr_, wc = wc_, fr = fr_, fq = fq_; asm volatile("" : "+s"(wr), "+s"(wc), "+v"(fr), "+v"(fq));
        const int row0 = u.pm * BM + wr * 64 + fr; const int pn = u.pn + pn_base;
        if (pn >= 12) {
            const int ob = 256 * (pn - 12) + 64 * wc + 8 * fq;
#pragma unroll
            for (int ai = 0; ai < 2; ++ai)
#pragma unroll
                for (int m = 0; m < 4; ++m) { bf16* rp = P + (size_t)(row0 + ai * HALF + m * 16) * 512 + ob;
#pragma unroll
                    for (int bj = 0; bj < 2; ++bj) { const int o = ob + 32 * bj; f32x4 v0 = acc[ai][bj][m][0], v1 = acc[ai][bj][m][1];
                        if (o < 128) {
#pragma unroll
                            for (int e = 0; e < 4; ++e) { v0[e] = 2.0f * fsigmoid(2.0f * v0[e]) - 1.0f; v1[e] = 2.0f * fsigmoid(2.0f * v1[e]) - 1.0f; }
                        } else if (o < 256) {
                        } else if (o < 416) {
#pragma unroll
                            for (int e = 0; e < 4; ++e) { v0[e] = fsigmoid(v0[e]); v1[e] = fsigmoid(v1[e]); }
                        } else { v0 = (f32x4){0.f, 0.f, 0.f, 0.f}; v1 = v0; }
                        *(u32x4*)(rp + 32 * bj) = pack8(v0, v1); } }
            return;
        }
        const int sel = pn >> 2; const int cb = (pn & 3) * 256 + wc * 64 + 8 * fq;
        bf16* O = Oo;
        f32x4 kkg[2][2];
        if (sel == 1) {
#pragma unroll
            for (int bj = 0; bj < 2; ++bj)
#pragma unroll
                for (int n = 0; n < 2; ++n) kkg[bj][n] = *(const f32x4*)(k_k + cb + 32 * bj + 4 * n);
        }
#pragma unroll
        for (int ai = 0; ai < 2; ++ai)
#pragma unroll
            for (int m = 0; m < 4; ++m) { const size_t ro = (size_t)(row0 + ai * HALF + m * 16) * DM + cb;
#pragma unroll
                for (int bj = 0; bj < 2; ++bj) *(u32x4*)(O + ro + 32 * bj) = pack8(acc[ai][bj][m][0], acc[ai][bj][m][1]);
                if (sel == 1) {
                    f32x4 q[2][2]; float ss = 0.f;
#pragma unroll
                    for (int bj = 0; bj < 2; ++bj)
#pragma unroll
                        for (int n = 0; n < 2; ++n) { q[bj][n] = acc[ai][bj][m][n] * kkg[bj][n]; const f32x4 x = q[bj][n]; ss += (x[0] * x[0] + x[1] * x[1]) + (x[2] * x[2] + x[3] * x[3]); }
                    ss += __shfl_xor(ss, 16); ss += __shfl_xor(ss, 32);
                    const float rn = 1.0f / fmaxf(sqrtf(ss), 1e-12f);
#pragma unroll
                    for (int bj = 0; bj < 2; ++bj) *(u32x4*)(KK + ro + 32 * bj) = pack8(q[bj][0] * rn, q[bj][1] * rn);
                }
                if (m & 1) asm volatile("" ::: "memory"); }
    }
};

struct EpiFinish {
    static constexpr bool PERM = true, AFTER_DRAIN = false;
    const bf16* Y0; const bf16* Y1; const bf16* Vb; const float* bonus; const float* ln_g; const float* ln_b; bf16* Z;
    __device__ __forceinline__ void operator()(const f32x4 (&acc)[2][2][4][2], const Unit& u, int wr_, int wc_, int fr_, int fq_) const {
        int wr = wr_, wc = wc_, fr = fr_, fq = fq_; asm volatile("" : "+s"(wr), "+s"(wc), "+v"(fr), "+v"(fq));
        const int row0 = u.pm * BM + wr * 64 + fr; const int head = u.pn * 4 + wc; const int cb = head * 64 + 8 * fq;
#pragma unroll
        for (int ai = 0; ai < 2; ++ai)
#pragma unroll
            for (int m = 0; m < 4; ++m) { const size_t grow = (size_t)(row0 + ai * HALF + m * 16); const size_t ro = grow * DM + cb;
                float sum = 0.f, sq = 0.f;
#pragma unroll
                for (int bj = 0; bj < 2; ++bj) { f32x4 a0, a1, b0, b1; unpack8(*(const u32x4*)(Y0 + ro + 32 * bj), a0, a1); unpack8(*(const u32x4*)(Y1 + ro + 32 * bj), b0, b1);
                    a0 += b0; a1 += b1; sum += (a0[0] + a0[1]) + (a0[2] + a0[3]) + (a1[0] + a1[1]) + (a1[2] + a1[3]);
                    sq += (a0[0] * a0[0] + a0[1] * a0[1]) + (a0[2] * a0[2] + a0[3] * a0[3]) + (a1[0] * a1[0] + a1[1] * a1[1]) + (a1[2] * a1[2] + a1[3] * a1[3]); }
                sum += __shfl_xor(sum, 16); sq += __shfl_xor(sq, 16); sum += __shfl_xor(sum, 32); sq += __shfl_xor(sq, 32);
                const float mean = sum * (1.0f / 64.0f); const float var = fmaxf(sq * (1.0f / 64.0f) - mean * mean, 0.f);
                const float rstd = __builtin_amdgcn_rsqf(var + GN_EPS_F);
                const f32x2 bo = *(const f32x2*)(bonus + (grow * 16 + head) * 2); const float bsum = bo.x + bo.y;

#pragma unroll
                for (int bj = 0; bj < 2; ++bj) { f32x4 a0, a1, b0, b1, v0, v1; unpack8(*(const u32x4*)(Y0 + ro + 32 * bj), a0, a1); unpack8(*(const u32x4*)(Y1 + ro + 32 * bj), b0, b1); unpack8(*(const u32x4*)(Vb + ro + 32 * bj), v0, v1);
                    const f32x4 lg0 = *(const f32x4*)(ln_g + cb + 32 * bj), lg1 = *(const f32x4*)(ln_g + cb + 32 * bj + 4), lb0 = *(const f32x4*)(ln_b + cb + 32 * bj), lb1 = *(const f32x4*)(ln_b + cb + 32 * bj + 4);
                    const f32x4 z0 = ((a0 + b0 - mean) * rstd * lg0 + lb0 + v0 * bsum) * acc[ai][bj][m][0];
                    const f32x4 z1 = ((a1 + b1 - mean) * rstd * lg1 + lb1 + v1 * bsum) * acc[ai][bj][m][1];
                    *(u32x4*)(Z + ro + 32 * bj) = pack8(z0, z1);
                    if (bj == 1) asm volatile("" ::: "memory"); }
            }
    }
};

struct WJob { const float* src; const float* kscale; bf16* dst; int ld_src, k_src, ldt, row_off, col_base, k_off, nblk, mode; };
constexpr int NJOBS = 33;
struct Args { const float* in[32]; float* out; unsigned char* ws; WJob job[NJOBS]; int istart[NJOBS + 2]; };

struct Frame { LAS unsigned char* lds; int tid, lane, wave, vcu, G; };

__device__ __forceinline__ int perm256(int o) { return (o & ~255) | (((o >> 5) & 1) << 7) | (((o >> 6) & 3) << 5) | (o & 31); }

__device__ __forceinline__ void wconv_item(const __attribute__((address_space(4))) WJob* Jp, int item, LAS float* scr, int lane) {
    WJob J; J.src = Jp->src; J.kscale = Jp->kscale; J.dst = Jp->dst; J.ld_src = Jp->ld_src; J.k_src = Jp->k_src; J.ldt = Jp->ldt; J.row_off = Jp->row_off; J.col_base = Jp->col_base; J.k_off = Jp->k_off; J.nblk = Jp->nblk; J.mode = Jp->mode;
    const int kb = item / J.nblk, nb = item - kb * J.nblk, k0 = 64 * kb, n0 = 32 * nb;
#pragma unroll 8
    for (int i = 0; i < 32; ++i) { const int kk = 2 * i + (lane >> 5), k = k0 + kk; float v = 0.f;
        if (J.src != nullptr && k < J.k_src) { v = J.src[(size_t)k * J.ld_src + n0 + (lane & 31)]; if (J.kscale) v *= J.kscale[k]; }
        scr[kk * 33 + (lane & 31)] = v; }
    asm volatile("s_waitcnt lgkmcnt(0)" ::: "memory");
    const int c = lane & 7;
#pragma unroll
    for (int j = 0; j < 4; ++j) { const int n = (lane >> 3) + 8 * j; const LAS float* s = scr + (8 * c) * 33 + n;
        u32x4 o; o.x = cvt_pk_bf16(s[0 * 33], s[1 * 33]); o.y = cvt_pk_bf16(s[2 * 33], s[3 * 33]); o.z = cvt_pk_bf16(s[4 * 33], s[5 * 33]); o.w = cvt_pk_bf16(s[6 * 33], s[7 * 33]);
        const int oc = J.col_base + n0 + n; const int drow = J.row_off + (J.mode ? perm256(oc) : oc);
        *(u32x4*)(J.dst + (size_t)drow * J.ldt + J.k_off + k0 + 8 * c) = o; }
    asm volatile("s_waitcnt lgkmcnt(0)" ::: "memory");
}

__device__ __forceinline__ void p0a(Frame& F, const __attribute__((address_space(4))) Args* A) {
    LAS float* sl = (LAS float*)F.lds;
    const float* c = A->in[1]; const float* cc = A->in[3];
    for (int idx = F.tid; idx < 17 * DM; idx += NWAVES * 64) { const int r = idx >> 10, k = idx & 1023; const float x = r < 16 ? c[r * DM + k] : cc[k]; sl[idx] = x * fsigmoid(x); }
    __syncthreads();
    const int gw = F.vcu * NWAVES + F.wave, NGW = F.G * NWAVES;
    float* modp = (float*)(A->ws + WS_MODP);
    for (int it = gw; it < 4 * 96 * 4; it += NGW) {
        const int l = it / 384, rem = it - l * 384, cgp = rem >> 2, kq = rem & 3, col = cgp * 64 + F.lane;
        const float* w = A->in[4] + ((size_t)l * DM + kq * 256) * NMOD + col;
        float acc[17];
#pragma unroll
        for (int r = 0; r < 17; ++r) acc[r] = 0.f;
#pragma unroll 4
        for (int k4 = 0; k4 < 256; k4 += 4) {
            const float w0 = w[(size_t)(k4 + 0) * NMOD], w1 = w[(size_t)(k4 + 1) * NMOD], w2 = w[(size_t)(k4 + 2) * NMOD], w3 = w[(size_t)(k4 + 3) * NMOD];
#pragma unroll
            for (int r = 0; r < 17; ++r) { const f32x4 sv = *(const LAS f32x4*)(sl + r * DM + kq * 256 + k4); acc[r] += (sv[0] * w0 + sv[1] * w1) + (sv[2] * w2 + sv[3] * w3); }
        }
#pragma unroll
        for (int r = 0; r < 17; ++r) modp[((size_t)(kq * 4 + l) * 17 + r) * NMOD + col] = acc[r];
    }
    __syncthreads();
    LAS float* scr = (LAS float*)(F.lds + F.wave * 16384);
    const int total = A->istart[NJOBS];
    for (int it = gw; it < total; it += NGW) {
        int j = 0;
        while (it >= A->istart[j + 1]) ++j;
        wconv_item(&A->job[j], it - A->istart[j], scr, F.lane);
    }
    { const f32x4* cs = (const f32x4*)A->in[2]; f32x4* cd = (f32x4*)(A->ws + WS_CTX);
      for (int idx = (F.vcu * NWAVES * 64) + F.tid; idx < NB * CTXL * DM / 4; idx += F.G * NWAVES * 64) cd[idx] = cs[idx]; }
    float* rope = (float*)(A->ws + WS_ROPE);
    for (int idx = (F.vcu * NWAVES * 64) + F.tid; idx < TPB * 32; idx += F.G * NWAVES * 64) {
        const int t = idx >> 5, p = idx & 31; float cs = 1.f, sn = 0.f;
        if (t < SEQ) { const int f = p & 15; const int pos = p < 16 ? (t >> 6) : (t & 63);
            const float inv = __builtin_amdgcn_exp2f(-(float)f * (13.287712379549449f / 16.0f)); const float ang = (float)pos * inv;
            float x = ang * 0.15915494309189535f; x = x - floorf(x); cs = __builtin_amdgcn_cosf(x); sn = __builtin_amdgcn_sinf(x); }
        rope[(size_t)t * 64 + p] = cs; rope[(size_t)t * 64 + 32 + p] = sn;
    }
}
__device__ __forceinline__ void p0b(Frame& F, const __attribute__((address_space(4))) Args* A) {
    const float* modp = (const float*)(A->ws + WS_MODP); float* mod = (float*)(A->ws + WS_MOD); const float* bm = A->in[5];
    const int n = 4 * 17 * NMOD;
    for (int idx = (F.vcu * NWAVES * 64) + F.tid; idx < n; idx += F.G * NWAVES * 64) {
        const int l = idx / (17 * NMOD), rem = idx - l * 17 * NMOD, col = rem % NMOD;
        float s = bm[l * NMOD + col];
#pragma unroll
        for (int kq = 0; kq < 4; ++kq) s += modp[(size_t)(kq * 4 + l) * 17 * NMOD + rem];
        mod[idx] = s;
    }
}

__device__ __forceinline__ void p0c(Frame& F, const __attribute__((address_space(4))) Args* A) {
    LAS float* sl = (LAS float*)F.lds; LAS float* red = (LAS float*)(F.lds + 17 * DM * 4);
    const float* mod = (const float*)(A->ws + WS_MOD); float* swt = (float*)(A->ws + WS_SW);
    for (int it = F.vcu; it < 4 * 64; it += F.G) {
        const int l = it >> 6, cgp = it & 63;
        for (int idx = F.tid; idx < 17 * DM; idx += NWAVES * 64) sl[idx] = mod[((size_t)l * 17 + (idx >> 10)) * NMOD + 3 * DM + (idx & 1023)];
        __syncthreads();
        const float* w = A->in[8] + ((size_t)l * DM + F.wave * 128) * FF + cgp * 64 + F.lane;
        float acc[17];
#pragma unroll
        for (int r = 0; r < 17; ++r) acc[r] = 0.f;
#pragma unroll 4
        for (int k4 = 0; k4 < 128; k4 += 4) {
            const float w0 = w[(size_t)(k4 + 0) * FF], w1 = w[(size_t)(k4 + 1) * FF], w2 = w[(size_t)(k4 + 2) * FF], w3 = w[(size_t)(k4 + 3) * FF];
#pragma unroll
            for (int r = 0; r < 17; ++r) { const f32x4 sv = *(const LAS f32x4*)(sl + r * DM + F.wave * 128 + k4); acc[r] += (sv[0] * w0 + sv[1] * w1) + (sv[2] * w2 + sv[3] * w3); }
        }
#pragma unroll
        for (int r = 0; r < 17; ++r) red[(F.wave * 17 + r) * 64 + F.lane] = acc[r];
        __syncthreads();
        for (int idx = F.tid; idx < 17 * 64; idx += NWAVES * 64) { float t = 0.f;
#pragma unroll
            for (int wv = 0; wv < 8; ++wv) t += red[wv * 17 * 64 + idx];
            swt[((size_t)l * 17 + (idx >> 6)) * FF + cgp * 64 + (idx & 63)] = t; }
        __syncthreads();
    }
}

struct LnPar { f32x4 g[4], sc[4], sh[4]; };
__device__ __forceinline__ void ln_load_par(LnPar& P, const float* gamma, const float* modrow, int slot, int lane) {
#pragma unroll
    for (int j = 0; j < 4; ++j) { const int c = 4 * lane + 256 * j; P.g[j] = *(const f32x4*)(gamma + c); P.sh[j] = *(const f32x4*)(modrow + slot * DM + c); P.sc[j] = *(const f32x4*)(modrow + (slot + 1) * DM + c) + 1.0f; P.g[j] = P.g[j] * P.sc[j]; }
}
__device__ __forceinline__ void ln_row(f32x4 (&h)[4], const float* xrow, const LnPar& P, int lane, const float* prow = nullptr, const float* pgate = nullptr) {
    float ss = 0.f;
#pragma unroll
    for (int j = 0; j < 4; ++j) { h[j] = *(const f32x4*)(xrow + 4 * lane + 256 * j);
        if (prow != nullptr) { const float* pp = prow + 4 * lane + 256 * j; h[j] += *(const f32x4*)(pgate + 4 * lane + 256 * j) * ((*(const f32x4*)(pp) + *(const f32x4*)(pp + (size_t)NB * CTXL * DM)) + (*(const f32x4*)(pp + (size_t)2 * NB * CTXL * DM) + *(const f32x4*)(pp + (size_t)3 * NB * CTXL * DM))); } ss += (h[j][0] * h[j][0] + h[j][1] * h[j][1]) + (h[j][2] * h[j][2] + h[j][3] * h[j][3]); }
    const float rinv = __builtin_amdgcn_rsqf(wave_sum(ss) * (1.0f / DM) + RMS_EPS);
#pragma unroll
    for (int j = 0; j < 4; ++j) h[j] = h[j] * rinv * P.g[j] + P.sh[j];
}
__device__ __forceinline__ const float* prow_ptr(const float* pend, int b, int t) { return (pend != nullptr && t >= SEQ) ? pend + ((size_t)b * CTXL + (t - SEQ)) * DM : nullptr; }
__device__ __forceinline__ const float* xrow_ptr(const float* L, const float* C, int b, int t) { return t < SEQ ? L + ((size_t)b * SEQ + t) * DM : C + ((size_t)b * CTXL + (t - SEQ)) * DM; }
__device__ __forceinline__ void st_row_bf16(bf16* orow, const f32x4 (&h)[4], int lane) {
#pragma unroll
    for (int j = 0; j < 4; ++j) { u32x2 w; w.x = cvt_pk_bf16(h[j][0], h[j][1]); w.y = cvt_pk_bf16(h[j][2], h[j][3]); *(u32x2*)(orow + 4 * lane + 256 * j) = w; }
}
__device__ __forceinline__ void ln_phase(Frame& F, const float* xl, const float* xc, const float* gamma, const float* modL, int slot, bf16* H, const float* pend = nullptr, const float* pgate = nullptr) {
    const int gw = F.vcu * NWAVES + F.wave, NGW = F.G * NWAVES;
    for (int run = gw; run < MROWS / 8; run += NGW) {
        const int row0 = run * 8, b = row0 / TPB, t0 = row0 - b * TPB;
        LnPar P; ln_load_par(P, gamma, modL + (size_t)(t0 < SEQ ? b : 16) * NMOD, slot, F.lane);
#pragma unroll 2
        for (int i = 0; i < 8; ++i) {
            f32x4 h[4]; ln_row(h, xrow_ptr(xl, xc, b, t0 + i), P, F.lane, prow_ptr(pend, b, t0 + i), pgate);
            st_row_bf16(H + (size_t)(row0 + i) * DM, h, F.lane);
        }
    }
}
__device__ __forceinline__ void hn_row(f32x4 (&h)[4], const bf16* hrow, float rsq, const LnPar& P, int lane) {
    const float rinv = __builtin_amdgcn_rsqf(rsq * (1.0f / DM) + RMS_EPS);
#pragma unroll
    for (int j = 0; j < 4; ++j) { const u32x2 w = *(const u32x2*)(hrow + 4 * lane + 256 * j); h[j] = (f32x4){bflo(w.x), bfhi(w.x), bflo(w.y), bfhi(w.y)} * rinv + P.sh[j]; }
}
__device__ __forceinline__ void ln_rwkv_phase(Frame& F, const bf16* Hn, const float* rq, const float* gamma, const float* modL, bf16* XR, bf16* XK, bf16* XV, bf16* A1, const float* mu) {
    const int gw = F.vcu * NWAVES + F.wave, NGW = F.G * NWAVES;
    for (int run = gw; run < MROWS / 8; run += NGW) {
        const int row0 = run * 8, b = row0 / TPB, t0 = row0 - b * TPB;
        const int slo = t0 < SEQ ? 0 : SEQ, shi = t0 < SEQ ? SEQ : TPB;
        LnPar P; ln_load_par(P, gamma, modL + (size_t)(t0 < SEQ ? b : 16) * NMOD, 0, F.lane);
        f32x4 mur[4], muk[4], muv[4];
#pragma unroll
        for (int j = 0; j < 4; ++j) { const int c = 4 * F.lane + 256 * j; mur[j] = *(const f32x4*)(mu + c); muk[j] = *(const f32x4*)(mu + 2 * DM + c); muv[j] = *(const f32x4*)(mu + 3 * DM + c); }
        f32x4 prev[4], cur[4], nxt[4];
        if (t0 > slo) hn_row(prev, Hn + (size_t)(row0 - 1) * DM, rq[row0 - 1], P, F.lane);
        else {
#pragma unroll
            for (int j = 0; j < 4; ++j) prev[j] = (f32x4){0.f, 0.f, 0.f, 0.f}; }
        hn_row(cur, Hn + (size_t)row0 * DM, rq[row0], P, F.lane);
        for (int i = 0; i < 8; ++i) {
            const int t = t0 + i;
            if (t + 1 < shi) hn_row(nxt, Hn + (size_t)(row0 + i + 1) * DM, rq[row0 + i + 1], P, F.lane);
            else {
#pragma unroll
                for (int j = 0; j < 4; ++j) nxt[j] = (f32x4){0.f, 0.f, 0.f, 0.f}; }
            f32x4 xx[4];
#pragma unroll
            for (int j = 0; j < 4; ++j) xx[j] = (prev[j] + nxt[j]) * 0.5f - cur[j];
            bf16* o = A1 + (size_t)(row0 + i) * 2048;
            st_row_bf16(o, cur, F.lane); st_row_bf16(o + DM, xx, F.lane);
            { f32x4 t4[4];
#pragma unroll
              for (int j = 0; j < 4; ++j) t4[j] = cur[j] + xx[j] * mur[j];
              st_row_bf16(XR + (size_t)(row0 + i) * DM, t4, F.lane);
#pragma unroll
              for (int j = 0; j < 4; ++j) t4[j] = cur[j] + xx[j] * muk[j];
              st_row_bf16(XK + (size_t)(row0 + i) * DM, t4, F.lane);
#pragma unroll
              for (int j = 0; j < 4; ++j) t4[j] = cur[j] + xx[j] * muv[j];
              st_row_bf16(XV + (size_t)(row0 + i) * DM, t4, F.lane); }
#pragma unroll
            for (int j = 0; j < 4; ++j) { prev[j] = cur[j]; cur[j] = nxt[j]; }
        }
    }
}
__device__ __forceinline__ void pool_phase(Frame& F, const bf16* H, const float* rq, bf16* PL) {
    const int gt = F.vcu * NWAVES * 64 + F.tid, NT_ = F.G * NWAVES * 64;
    for (int it = gt; it < (MROWS / 16) * 128; it += NT_) {
        const int run = it >> 7, ch = it & 127, half = 1 << (ch >> 5);
        const int row0 = run * 16, b = row0 / TPB, t0 = row0 - b * TPB;
        const int slo = t0 < SEQ ? 0 : SEQ, shi = t0 < SEQ ? SEQ : TPB;
        const bf16* hb = H + (size_t)b * TPB * DM + ch * 8;
        const float* rqb = rq + (size_t)b * TPB;
#define LDROW(r_, a_, c_) do { unpack8(*(const u32x4*)(hb + (size_t)(r_) * DM), a_, c_); const float ri_ = __builtin_amdgcn_rsqf(rqb[r_] * (1.0f / DM) + RMS_EPS); a_ = a_ * ri_; c_ = c_ * ri_; } while (0)
        f32x4 s0 = (f32x4){0.f, 0.f, 0.f, 0.f}, s1 = s0;
        { const int lo = max(t0 - half, slo), hi = min(t0 + half, shi);
          for (int r = lo; r < hi; ++r) { f32x4 a, c2; LDROW(r, a, c2); s0 += a; s1 += c2; } }
        for (int i = 0; i < 16; ++i) {
            const int t = t0 + i; const int lo = max(t - half, slo), hi = min(t + half, shi);
            f32x4 a, c2; LDROW(t, a, c2);
            const float ic = 1.0f / (float)(hi - lo);
            *(u32x4*)(PL + (size_t)(row0 + i) * DM + ch * 8) = pack8(s0 * ic - a, s1 * ic - c2);
            if (t + half < shi) { f32x4 p, q; LDROW(t + half, p, q); s0 += p; s1 += q; }
            if (t - half >= slo) { f32x4 p, q; LDROW(t - half, p, q); s0 -= p; s1 -= q; }
        }
    }
#undef LDROW
}

__device__ __forceinline__ float dpp_x1(float x) { return __int_as_float(__builtin_amdgcn_update_dpp(0, __float_as_int(x), 0xB1, 0xF, 0xF, true)); }
__device__ __forceinline__ float dpp_x2(float x) { return __int_as_float(__builtin_amdgcn_update_dpp(0, __float_as_int(x), 0x4E, 0xF, 0xF, true)); }
__device__ __forceinline__ float dpp_hm(float x) { return __int_as_float(__builtin_amdgcn_update_dpp(0, __float_as_int(x), 0x141, 0xF, 0xF, true)); }
__device__ __forceinline__ float fma_s(float a, float b, float c) { float d; asm("v_fma_f32 %0, %1, %2, %3" : "=v"(d) : "v"(a), "v"(b), "v"(c)); return d; }
__device__ __forceinline__ float mul_s(float a, float b) { float d; asm("v_mul_f32_e32 %0, %1, %2" : "=v"(d) : "v"(a), "v"(b)); return d; }
__device__ __forceinline__ float red8(float x) { x += dpp_x1(x); x += dpp_x2(x); x += dpp_hm(x); return x; }
__device__ __forceinline__ int scan_tok(int dir, int s) { return dir ? (TPB - 1 - s) : (s < CTXL ? SEQ + s : s - CTXL); }
constexpr int NCHUNK = TPB / 16;
#ifndef PSUB
#define PSUB 0
#endif
#define PSUB_T0(x) unsigned long long ps0_##x = (PSUB & (x)) ? __builtin_amdgcn_s_memrealtime() : 0ull
#define PSUB_T1(x) do { if (PSUB & (x)) psum_ += __builtin_amdgcn_s_memrealtime() - ps0_##x; } while (0)
#define PSUB_SPIN() do { if (PSUB) { const unsigned long long t1_ = __builtin_amdgcn_s_memrealtime(); while (__builtin_amdgcn_s_memrealtime() - t1_ < psum_) __builtin_amdgcn_s_sleep(8); } } while (0)

__device__ __forceinline__ void scan_phase(Frame& F, const bf16* Rg, const bf16* Kg, const bf16* KKg, const bf16* Vg, const bf16* P, bf16* Y0, bf16* Y1, float* bonus,
                                           const float* w0, const float* w2, const float* a0, const float* a2, const float* k_a, const float* r_k) {
    LAS float* L = (LAS float*)F.lds;
    const int lane = F.lane, dir = F.wave >> 2, wq = F.wave & 3, vg = lane >> 3, kg = lane & 7, fr = lane & 15, fq = lane >> 4;
    const int mm = wq >> 1, cth = wq & 1;
    for (int bh = F.vcu; bh < NB * 16; bh += F.G) {
        const int b = bh >> 4, h = bh & 15; const size_t rb = (size_t)b * TPB;
        const float* W2 = (mm == 0 ? w2 : a2) + (size_t)dir * 64 * DM + h * 64;
        bf16x8 Bf[2][2]; float bias[2], ka[2];
#pragma unroll
        for (int ct2 = 0; ct2 < 2; ++ct2) { const int j = 16 * (2 * cth + ct2) + fr;
            bias[ct2] = (mm == 0 ? w0 : a0)[dir * DM + h * 64 + j]; ka[ct2] = k_a[h * 64 + j];
#pragma unroll
            for (int ks = 0; ks < 2; ++ks) { const float* wp = W2 + (size_t)(32 * ks + 8 * fq) * DM + j;
                u32x4 pk; pk.x = cvt_pk_bf16(wp[0], wp[DM]); pk.y = cvt_pk_bf16(wp[2 * DM], wp[3 * DM]); pk.z = cvt_pk_bf16(wp[4 * DM], wp[5 * DM]); pk.w = cvt_pk_bf16(wp[6 * DM], wp[7 * DM]);
                Bf[ct2][ks] = __builtin_bit_cast(bf16x8, pk); } }
        f32x4 rkb[4];
#pragma unroll
        for (int q4 = 0; q4 < 4; ++q4) rkb[q4] = *(const f32x4*)(r_k + h * 64 + 16 * (lane & 3) + 4 * q4);
        f32x2 S[2][4];
#pragma unroll
        for (int rr = 0; rr < 2; ++rr)
#pragma unroll
            for (int jp = 0; jp < 4; ++jp) S[rr][jp] = (f32x2){0.f, 0.f};
        unsigned long long psum_ = 0ull; (void)psum_;
        bf16* Yd = dir ? Y1 : Y0;
        const bf16* srcA = mm == 0 ? Rg : Kg; const bf16* srcB = mm == 0 ? Vg : KKg;
        bf16x8 Pa[2]; unsigned short ga[8], gb[8];
#define SC_LOAD(c) do { const int s0_ = 16 * (c); const size_t ra_ = rb + scan_tok(dir, s0_ + fr); \
        _Pragma("unroll") for (int ks = 0; ks < 2; ++ks) Pa[ks] = *(const bf16x8*)(P + ra_ * 512 + 128 * mm + 64 * dir + 32 * ks + 8 * fq); \
        _Pragma("unroll") for (int e = 0; e < 4; ++e) { const size_t ri_ = (rb + scan_tok(dir, s0_ + 4 * fq + e)) * DM + h * 64 + 32 * cth + fr; \
            _Pragma("unroll") for (int ct2 = 0; ct2 < 2; ++ct2) { ga[e * 2 + ct2] = srcA[ri_ + 16 * ct2]; gb[e * 2 + ct2] = srcB[ri_ + 16 * ct2]; } } } while (0)
#define SC_COMPUTE(buf) do { LAS float* Lb_ = L + ((buf) * 2 + dir) * 6 * 1024; \
        _Pragma("unroll") for (int ct2 = 0; ct2 < 2; ++ct2) { f32x4 D_ = (f32x4){0.f, 0.f, 0.f, 0.f}; \
            D_ = __builtin_amdgcn_mfma_f32_16x16x32_bf16(Pa[0], Bf[ct2][0], D_, 0, 0, 0); D_ = __builtin_amdgcn_mfma_f32_16x16x32_bf16(Pa[1], Bf[ct2][1], D_, 0, 0, 0); \
            _Pragma("unroll") for (int e = 0; e < 4; ++e) { const int idx_ = (4 * fq + e) * 64 + 16 * (2 * cth + ct2) + fr; const float xa_ = bf2f(ga[e * 2 + ct2]), xb_ = bf2f(gb[e * 2 + ct2]); \
                if (mm == 0) { const float sg_ = fsigmoid(bias[ct2] + D_[e]); Lb_[1 * 1024 + idx_] = __builtin_amdgcn_exp2f(-0.8750387749f * sg_); Lb_[4 * 1024 + idx_] = xa_; Lb_[5 * 1024 + idx_] = xb_; } \
                else { const float a_ = fsigmoid(bias[ct2] + D_[e]); Lb_[3 * 1024 + idx_] = xa_ * (1.0f + (a_ - 1.0f) * ka[ct2]); Lb_[2 * 1024 + idx_] = xb_ * a_; Lb_[0 * 1024 + idx_] = xb_; } } } } while (0)
        SC_LOAD(0); SC_COMPUTE(0); __syncthreads();
#define ST_LOAD(X, i) do { const LAS float* q_ = Lb + (i) * 64; \
            X##kk0 = *(const LAS f32x4*)(q_); X##kk1 = *(const LAS f32x4*)(q_ + 4); X##w0 = *(const LAS f32x4*)(q_ + 1024); X##w1 = *(const LAS f32x4*)(q_ + 1024 + 4); \
            X##ka0 = *(const LAS f32x4*)(q_ + 2048); X##ka1 = *(const LAS f32x4*)(q_ + 2048 + 4); X##kt0 = *(const LAS f32x4*)(q_ + 3072); X##kt1 = *(const LAS f32x4*)(q_ + 3072 + 4); \
            X##r0 = *(const LAS f32x4*)(q_ + 4096); X##r1 = *(const LAS f32x4*)(q_ + 4096 + 4); X##v = *(const LAS f32x2*)(Lv + (i) * 64); } while (0)
#define LOHI(v4, jp) ((jp) & 1 ? (f32x2){v4[2], v4[3]} : (f32x2){v4[0], v4[1]})
#define ST_COMPUTE(X, i) do { \
            const f32x2 kk2_[4] = {LOHI(X##kk0, 0), LOHI(X##kk0, 1), LOHI(X##kk1, 0), LOHI(X##kk1, 1)}; const f32x2 w2_[4] = {LOHI(X##w0, 0), LOHI(X##w0, 1), LOHI(X##w1, 0), LOHI(X##w1, 1)}; \
            const f32x2 ka2_[4] = {LOHI(X##ka0, 0), LOHI(X##ka0, 1), LOHI(X##ka1, 0), LOHI(X##ka1, 1)}; const f32x2 kt2_[4] = {LOHI(X##kt0, 0), LOHI(X##kt0, 1), LOHI(X##kt1, 0), LOHI(X##kt1, 1)}; \
            const f32x2 r2_[4] = {LOHI(X##r0, 0), LOHI(X##r0, 1), LOHI(X##r1, 0), LOHI(X##r1, 1)}; \
            float sa_[2], yv_[2]; \
            _Pragma("unroll") for (int rr = 0; rr < 2; ++rr) { f32x2 t2 = S[rr][0] * kk2_[0]; t2 += S[rr][1] * kk2_[1]; t2 += S[rr][2] * kk2_[2]; t2 += S[rr][3] * kk2_[3]; sa_[rr] = red8(t2.x + t2.y); } \
            _Pragma("unroll") for (int rr = 0; rr < 2; ++rr) { const float nsa = -sa_[rr]; const float vr = rr == 0 ? X##v.x : X##v.y; f32x2 t2 = (f32x2){0.f, 0.f}; \
                _Pragma("unroll") for (int jp = 0; jp < 4; ++jp) { S[rr][jp] = S[rr][jp] * w2_[jp] + ka2_[jp] * nsa + kt2_[jp] * vr; t2 += S[rr][jp] * r2_[jp]; } \
                yv_[rr] = red8(t2.x + t2.y); } \
            if (kg == 0) *(unsigned*)(Yd + (rb + scan_tok(dir, 16 * c + (i))) * DM + h * 64 + 16 * wq + 2 * vg) = cvt_pk_bf16(yv_[0], yv_[1]); } while (0)
        for (int c = 0; c < NCHUNK; ++c) {
            if (c + 1 < NCHUNK) SC_LOAD(c + 1);
            const LAS float* Lb = L + ((c & 1) * 2 + dir) * 6 * 1024 + 8 * kg;
            const LAS float* Lv = L + ((c & 1) * 2 + dir) * 6 * 1024 + 5 * 1024 + 16 * wq + 2 * vg;
            f32x4 Akk0, Akk1, Aw0, Aw1, Aka0, Aka1, Akt0, Akt1, Ar0, Ar1, Bkk0, Bkk1, Bw0, Bw1, Bka0, Bka1, Bkt0, Bkt1, Br0, Br1; f32x2 Av, Bv;
            ST_LOAD(A, 0);
            if (wq == 0) {
                const LAS float* Lq = L + ((c & 1) * 2 + dir) * 6 * 1024 + (lane >> 2) * 64 + 16 * (lane & 3); float bs = 0.f;
#pragma unroll
                for (int q4 = 0; q4 < 4; ++q4) { const f32x4 rr4 = *(const LAS f32x4*)(Lq + 4096 + 4 * q4), kt4 = *(const LAS f32x4*)(Lq + 3072 + 4 * q4); const f32x4 p4 = rr4 * kt4 * rkb[q4]; bs += (p4[0] + p4[1]) + (p4[2] + p4[3]); }
                bs += dpp_x1(bs); bs += dpp_x2(bs);
                if ((lane & 3) == 0) bonus[((rb + scan_tok(dir, 16 * c + (lane >> 2))) * 16 + h) * 2 + dir] = bs;
            }
            PSUB_T0(1);
#pragma unroll 1
            for (int i = 0; i < 16; i += 2) {
                ST_LOAD(B, i + 1);
                ST_COMPUTE(A, i);
                if (i + 2 < 16) ST_LOAD(A, i + 2);
                ST_COMPUTE(B, i + 1);
            }
            PSUB_T1(1); PSUB_T0(2);
            if (c + 1 < NCHUNK) SC_COMPUTE((c + 1) & 1);
            PSUB_T1(2); PSUB_T0(4);
            __syncthreads();
            PSUB_T1(4);
        }
        PSUB_SPIN();
#undef ST_LOAD
#undef ST_COMPUTE
#undef LOHI
#undef SC_LOAD
#undef SC_COMPUTE
    }
}

#define XB_TMO      128
#define XB_XCNT(j)  (256  + 64 * (j))
#define XB_XSUB(j)  (1280 + 64 * (j))
#define XB_XGEN(j)  (2304 + 64 * (j))
#define XB_TOP      3328
#define XB_TOPGEN   3392
#define XCD_BAR_WORDS 3456
#define XB_SPIN_CAP (1u << 18)

__device__ __forceinline__ unsigned xb_ld(unsigned* p)              { return __hip_atomic_load(p, __ATOMIC_RELAXED, __HIP_MEMORY_SCOPE_AGENT); }
__device__ __forceinline__ unsigned xb_add(unsigned* p, unsigned v) { return __hip_atomic_fetch_add(p, v, __ATOMIC_RELAXED, __HIP_MEMORY_SCOPE_AGENT); }
__device__ __forceinline__ unsigned xb_xcc_id() { return (unsigned)__builtin_amdgcn_s_getreg((3 << 11) | 20) & 0xFu; }
#define XB_SPIN(cond, bar) do { unsigned _sp = 0; while (cond) { __builtin_amdgcn_s_sleep(1); \
    if ((++_sp & 255u) == 0u) { if (xb_ld(&(bar)[XB_TMO])) break; if (_sp > XB_SPIN_CAP) { atomicAdd(&(bar)[XB_TMO], 1u); break; } } } } while (0)

struct XcdBarrier {
    unsigned* bar; unsigned x;
    volatile LAS unsigned* st;
};

__device__ __forceinline__ XcdBarrier xcd_barrier_post(unsigned* bar, volatile LAS unsigned* st) {
    XcdBarrier b; b.bar = bar; b.x = xb_xcc_id(); b.st = st;
    if (threadIdx.x == 0) (void)xb_add(&bar[XB_XCNT(b.x)], 1u);
    return b;
}
__device__ __forceinline__ void xcd_barrier_complete(unsigned* bar, unsigned x, unsigned& nloc, unsigned& nx) {
    const unsigned G = gridDim.x * gridDim.y * gridDim.z;
    unsigned sum, cnt, mine, sp = 0u;
    for (;;) {
        sum = 0u; cnt = 0u; mine = 0u;
#pragma unroll
        for (unsigned j = 0; j < 16; ++j) { const unsigned c = xb_ld(&bar[XB_XCNT(j)]); sum += c; cnt += (c > 0u) ? 1u : 0u; mine = (j == x) ? c : mine; }
        if (sum == G) break;
        __builtin_amdgcn_s_sleep(1);
        if ((++sp & 255u) == 0u) { if (xb_ld(&bar[XB_TMO])) break; if (sp > XB_SPIN_CAP) { atomicAdd(&bar[XB_TMO], 1u); break; } }
    }
    nloc = mine > 0u ? mine : 1u; nx = cnt > 0u ? cnt : 1u;
}

__device__ __forceinline__ void xcd_barrier(const XcdBarrier& b) {
    asm volatile("s_waitcnt vmcnt(0)" ::: "memory");
    __syncthreads();
    if (threadIdx.x == 0) {
        unsigned* bar = b.bar;
        __builtin_amdgcn_s_waitcnt(0);
        unsigned nloc = b.st[0], nx = b.st[1];
        if (nloc == 0u) { xcd_barrier_complete(bar, b.x, nloc, nx); b.st[0] = nloc; b.st[1] = nx; }
        const unsigned old = xb_add(&bar[XB_XSUB(b.x)], 1u);
        const unsigned gen = old / nloc;
        if (old + 1u == (gen + 1u) * nloc) {
            __builtin_amdgcn_fence(__ATOMIC_RELEASE, "agent");
            asm volatile("s_waitcnt vmcnt(0)" ::: "memory");
            const unsigned og = xb_add(&bar[XB_TOP], 1u);
            const unsigned tg = og / nx;
            if (og + 1u == (tg + 1u) * nx) xb_add(&bar[XB_TOPGEN], 1u);
            else XB_SPIN(xb_ld(&bar[XB_TOPGEN]) == tg, bar);
            __builtin_amdgcn_fence(__ATOMIC_ACQUIRE, "agent");
            xb_add(&bar[XB_XGEN(b.x)], 1u);
            asm volatile("s_waitcnt vmcnt(0)" ::: "memory");
        } else {
            XB_SPIN(xb_ld(&bar[XB_XGEN(b.x)]) == gen, bar);
            __builtin_amdgcn_fence(__ATOMIC_ACQUIRE, "agent");
            asm volatile("s_waitcnt vmcnt(0)" ::: "memory");
        }
    }
    __syncthreads();
}

constexpr int MISC_OFF = 131072 + 320;

typedef const __attribute__((address_space(4))) Args* ArgsP;
__device__ __forceinline__ ArgsP get_args() { ArgsP p = (ArgsP)__builtin_amdgcn_kernarg_segment_ptr(); asm volatile("" : "+s"(p)); return p; }
#define PHASE_BEGIN() Frame F; { int t_ = threadIdx.x; asm volatile("" : "+v"(t_)); F.tid = t_; F.lane = t_ & 63; F.wave = __builtin_amdgcn_readfirstlane(t_ >> 6); \
        F.lds = (LAS unsigned char*)lds; F.G = gridDim.x; const int bx_ = blockIdx.x; F.vcu = (F.G % 8 == 0) ? (bx_ % 8) * (F.G / 8) + bx_ / 8 : bx_; } \
    ArgsP A = get_args(); unsigned char* const ws = A->ws; float* const xout = A->out; float* const ctxb = (float*)(ws + WS_CTX); bf16* const Wb = (bf16*)(ws + WS_W); unsigned char* const act = ws + WS_ACT; \
    const float* const modL = (const float*)(ws + WS_MOD) + (size_t)layer * 17 * NMOD; \
    const float* const srcL = layer == 0 ? A->in[0] : xout; const float* const srcC = ctxb; \
      \
    const float* const pendP = nullptr; const float* const pendG = modL - (size_t)17 * NMOD + (size_t)16 * NMOD + 5 * DM; \
    (void)xout; (void)ctxb; (void)Wb; (void)act; (void)modL; (void)srcL; (void)srcC; (void)pendP; (void)pendG
#ifndef PHM
#define PHM 0xFFFF
#endif
#define PH(x) if (PHM & (x))
#ifndef PROBE_MASK
#define PROBE_MASK 0
#endif
#define TIC() const unsigned long long t0_ = PROBE_MASK ? __builtin_amdgcn_s_memrealtime() : 0ull
#define TOC(x) do { if (PROBE_MASK & (x)) { const unsigned long long t1_ = __builtin_amdgcn_s_memrealtime(); while (__builtin_amdgcn_s_memrealtime() - t1_ < t1_ - t0_) __builtin_amdgcn_s_sleep(8); } } while (0)
#define GSYNC_CG() cg::this_grid().sync()
#ifndef XSYNC
#define XSYNC 0
#endif
#define GSYNC() do { GSYNC1(); if (XSYNC) GSYNC1(); } while (0)
#define GSYNC1() do { XcdBarrier b_; b_.bar = (unsigned*)get_args()->ws; b_.x = xb_xcc_id(); b_.st = (volatile LAS unsigned*)((LAS unsigned char*)lds + MISC_OFF) + 8; xcd_barrier(b_); } while (0)
#define GEMM(EpiT, gg, EE) do { pg8::StaticOrder S_; S_.init((gg).M, (gg).N, F.G, (int)blockIdx.x); pg8::gemm_phase<EpiT, pg8::StaticOrder, true, true>(F.lds, gg, S_, EE); } while (0)
#define GEMM_SK(EpiT, gg, EE, sk) do { pg8::StaticOrder S_; S_.init((gg).M, (gg).N, F.G, (int)blockIdx.x, (sk) ? 1 : 0); pg8::gemm_phase<EpiT, pg8::StaticOrder, true, true>(F.lds, gg, S_, EE); } while (0)

__global__ void __launch_bounds__(NWAVES * 64, 2) hybrid_fwd(Args args_unused) {
    extern __shared__ __attribute__((aligned(16))) unsigned char lds[];
    { volatile LAS unsigned* misc = (volatile LAS unsigned*)((LAS unsigned char*)lds + MISC_OFF); if (threadIdx.x < 32) misc[threadIdx.x] = 0u; __syncthreads();
      (void)xcd_barrier_post((unsigned*)get_args()->ws, misc + 8); }
    { const int layer = 0; TIC(); PHASE_BEGIN(); PH(1) p0a(F, A); TOC(1); } GSYNC_CG();
    { const int layer = 0; TIC(); PHASE_BEGIN(); PH(1) p0b(F, A); TOC(1); } GSYNC();
    { const int layer = 0; TIC(); PHASE_BEGIN(); PH(1) p0c(F, A); TOC(1); } GSYNC();

#pragma unroll 1
    for (int layer = 0; layer < 4; ++layer) {
        const int kind = layer % 3;
        if (layer > 0) {
            { TIC(); PHASE_BEGIN(); const float* pp = (const float*)(act + 680 * MiB); const float* pg = modL - (size_t)17 * NMOD + (size_t)16 * NMOD + 5 * DM;
              constexpr size_t NQ = (size_t)NB * CTXL * DM;
              const bool fuse = layer < 3;
              bf16* Hn = (bf16*)(act + (layer == 1 ? 748 * MiB : 0)); float* rq = (float*)(ws + WS_ROWSQ) + (size_t)(3 + layer) * MROWS;
              const float* g1 = A->in[6] + layer * DM; const float* sc1 = modL + (size_t)16 * NMOD + 1 * DM;
              for (int r = F.vcu * NWAVES + F.wave; r < NB * CTXL; r += F.G * NWAVES) { float ss = 0.f; const size_t grow = (size_t)(r >> 8) * TPB + SEQ + (r & 255);
#pragma unroll
                  for (int j = 0; j < 4; ++j) { const int c = 4 * F.lane + 256 * j; const float* p = pp + (size_t)r * DM + c;
                      const f32x4 xn = *(const f32x4*)(ctxb + (size_t)r * DM + c) + *(const f32x4*)(pg + c) * ((*(const f32x4*)(p) + *(const f32x4*)(p + NQ)) + (*(const f32x4*)(p + 2 * NQ) + *(const f32x4*)(p + 3 * NQ)));
                      *(f32x4*)(ctxb + (size_t)r * DM + c) = xn;
                      if (fuse) { ss += (xn[0] * xn[0] + xn[1] * xn[1]) + (xn[2] * xn[2] + xn[3] * xn[3]); const f32x4 hq = xn * (*(const f32x4*)(g1 + c) * (*(const f32x4*)(sc1 + c) + 1.0f));
                          u32x2 w; w.x = cvt_pk_bf16(hq[0], hq[1]); w.y = cvt_pk_bf16(hq[2], hq[3]); *(u32x2*)(Hn + grow * DM + c) = w; } }
                  if (fuse) { ss = wave_sum(ss); if (F.lane == 0) rq[grow] = ss; } }
              TOC(2); } GSYNC();
        }
        if (kind == 0) {
            PH(2) { TIC(); PHASE_BEGIN(); ln_phase(F, srcL, srcC, A->in[6] + layer * DM, modL, 0, (bf16*)act, pendP, pendG); TOC(2); } GSYNC();
            PH(4) { TIC(); PHASE_BEGIN(); const int j = layer / 3; bf16* Q = (bf16*)(act + ACT1); bf16* Kb = (bf16*)(act + 2 * ACT1); bf16* Vb = (bf16*)(act + 2 * ACT1 + 34 * MiB);
              pg8::Gemm g{(bf16*)act, Wb + (W_QKV + (size_t)j * 3 * MiB) / 2, MROWS, 1536, DM, DM, DM, 0};
              EpiQKV E{Q, Kb, Vb, A->in[11] + j * 64, A->in[12] + j * 64, (const float*)(ws + WS_ROPE)};
              GEMM(EpiQKV, g, E); TOC(4); } GSYNC();
            PH(8) { TIC(); PHASE_BEGIN(); const bool with_ctx = layer != 3; bf16* Q = (bf16*)(act + ACT1); bf16* Kb = (bf16*)(act + 2 * ACT1); bf16* Vb = (bf16*)(act + 2 * ACT1 + 34 * MiB);
              for (int bh = F.vcu; bh < NB * 16; bh += F.G) { const int b = bh >> 4, h = bh & 15; const long rb = (long)b * TPB;
                  for (int qb = 0; qb < 16; ++qb) attn_body::attn_unit<8>(rb + qb * 256, rb, TPB / 64, h, (const attn_body::bf16*)Q, (const attn_body::bf16*)Kb, (const attn_body::bf16*)Vb, (attn_body::bf16*)Q, (char*)lds);
                  if (with_ctx) attn_body::attn_unit<8>(rb + SEQ, rb + SEQ, CTXL / 64, h, (const attn_body::bf16*)Q, (const attn_body::bf16*)Kb, (const attn_body::bf16*)Vb, (attn_body::bf16*)Q, (char*)lds); } TOC(8); } GSYNC();
            PH(16) { TIC(); PHASE_BEGIN(); const int j = layer / 3; bf16* Q = (bf16*)(act + ACT1);
              pg8::Gemm g{Q, Wb + (W_WO + (size_t)j * 2 * MiB) / 2, MROWS, DM, DM, DM, DM, 0};
              EpiResid E{srcL, srcC, xout, ctxb, modL, 2, nullptr, (bf16*)act, (float*)(ws + WS_ROWSQ) + (size_t)layer * MROWS, A->in[7] + layer * DM, modL + 4 * DM, pendP, pendG};
              GEMM_SK(EpiResid, g, E, layer == 3); TOC(16); } GSYNC();
        } else if (kind == 1) {
            PH(32) { TIC(); PHASE_BEGIN(); ln_rwkv_phase(F, (const bf16*)(act + 748 * MiB), (const float*)(ws + WS_ROWSQ) + (size_t)4 * MROWS, A->in[6] + layer * DM, modL, (bf16*)act, (bf16*)(act + 136 * MiB), (bf16*)(act + 272 * MiB), (bf16*)(act + 408 * MiB), A->in[14]); TOC(32); } GSYNC();
#pragma unroll 1
            for (int q = 0; q < 4; ++q) {
                PH(64) { TIC(); PHASE_BEGIN();
                  const size_t aoff = q == 0 ? 408 * MiB : (size_t)(q - 1) * 136 * MiB; const size_t ooff = q == 1 ? 748 * MiB : (q == 2 ? 408 * MiB : 0);
                  const size_t woff = q == 0 ? 6 * MiB : (size_t)(q - 1) * 2 * MiB; const int kk_ = q == 0 ? 2048 : DM;
                  pg8::Gemm g{(bf16*)(act + aoff), Wb + (W_R1 + woff) / 2, MROWS, q == 0 ? 512 : DM, kk_, kk_, kk_, 0};
                  EpiRwkv1 E{(bf16*)(act + ooff), (bf16*)(act + 544 * MiB), (bf16*)(act + 680 * MiB), A->in[24], q == 0 ? 12 : 4 * (q - 1)};
                  GEMM(EpiRwkv1, g, E); TOC(64); } GSYNC();
            }
            PH(128) { TIC(); PHASE_BEGIN(); bf16* R = (bf16*)(act + 748 * MiB); bf16* Kb = (bf16*)(act + 408 * MiB); bf16* Vb = (bf16*)(act); bf16* KK = (bf16*)(act + 544 * MiB); bf16* P = (bf16*)(act + 680 * MiB);
              scan_phase(F, R, Kb, KK, Vb, P, (bf16*)(act + 136 * MiB), (bf16*)(act + 272 * MiB), (float*)(ws + WS_BONUS), A->in[16], A->in[18], A->in[19], A->in[21], A->in[25], A->in[26]); TOC(128); } GSYNC();
            PH(256) { TIC(); PHASE_BEGIN(); bf16* Vb = (bf16*)(act); bf16* P = (bf16*)(act + 680 * MiB); bf16* Z = (bf16*)(act + 408 * MiB);
              pg8::Gemm g{P + 256, Wb + W_G2 / 2, MROWS, DM, 256, 512, 256, 0};
              EpiFinish E{(bf16*)(act + 136 * MiB), (bf16*)(act + 272 * MiB), Vb, (const float*)(ws + WS_BONUS), A->in[27], A->in[28], Z};
              GEMM(EpiFinish, g, E); TOC(256); } GSYNC();
            PH(512) { TIC(); PHASE_BEGIN(); bf16* Z = (bf16*)(act + 408 * MiB);
              pg8::Gemm g{Z, Wb + W_RWO / 2, MROWS, DM, DM, DM, DM, 0};
              EpiResid E{srcL, srcC, xout, ctxb, modL, 2, nullptr, (bf16*)act, (float*)(ws + WS_ROWSQ) + (size_t)layer * MROWS, A->in[7] + layer * DM, modL + 4 * DM, pendP, pendG};
              GEMM(EpiResid, g, E); TOC(512); } GSYNC();
        } else {
            PH(1024) { TIC(); PHASE_BEGIN(); pool_phase(F, (bf16*)act, (const float*)(ws + WS_ROWSQ) + (size_t)5 * MROWS, (bf16*)(act + ACT1)); TOC(1024); } GSYNC();
            PH(2048) { TIC(); PHASE_BEGIN(); bf16* PL = (bf16*)(act + ACT1);
              pg8::Gemm g{PL, Wb + W_POOL / 2, MROWS, DM, 256, DM, 256, 256};
              EpiResid E{srcL, srcC, xout, ctxb, modL, 2, A->in[31], (bf16*)act, (float*)(ws + WS_ROWSQ) + (size_t)layer * MROWS, A->in[7] + layer * DM, modL + 4 * DM, pendP, pendG};
              GEMM(EpiResid, g, E); TOC(2048); } GSYNC();
        }
        PH(4096) { TIC(); PHASE_BEGIN(); bf16* U = (bf16*)(act + ACT1);
          pg8::Gemm g{(bf16*)act, Wb + (W_IN + (size_t)layer * 8 * MiB) / 2, MROWS, FF, DM, DM, DM, 0};
          EpiRelu2 E{U, FF, (const float*)(ws + WS_ROWSQ) + (size_t)layer * MROWS, (const float*)(ws + WS_SW) + (size_t)layer * 17 * FF};
          { pg8::StaticOrder S_; S_.init(g.M, g.N, F.G, (int)blockIdx.x, layer == 3 ? 1 : 0); pg8::gemm_phase<EpiRelu2, pg8::StaticOrder, true, true>(F.lds, g, S_, E); } TOC(4096); } GSYNC();
        PH(8192) { TIC(); PHASE_BEGIN(); bf16* U = (bf16*)(act + ACT1);
          pg8::Gemm g{U, Wb + (W_OUT + (size_t)layer * 8 * MiB) / 2, MROWS, DM, FF, FF, FF, 0};
          const bool f1 = layer < 2;
          EpiResid E{xout, ctxb, xout, ctxb, modL, 5, nullptr, f1 ? (bf16*)(act + (layer == 0 ? 748 * MiB : 0)) : nullptr, (float*)(ws + WS_ROWSQ) + (size_t)(4 + layer) * MROWS, A->in[6] + (layer + 1) * DM, modL + (size_t)17 * NMOD + 1 * DM, nullptr, nullptr};
          GEMM_SK(EpiResid, g, E, 1);
          if (layer != 3) { pg8::Gemm g4 = g; g4.K = FF / 4; EpiPartial Ep{(float*)(act + 680 * MiB), FF / 4}; pg8::CtxSplitK S_; S_.init(FF, F.G, (int)blockIdx.x);
              pg8::gemm_phase<EpiPartial, pg8::CtxSplitK, true, true>(F.lds, g4, S_, Ep); } TOC(8192); }
        if (layer != 3) GSYNC();
    }
}

extern "C" void kernel_launch(void* const* d_in, const int* in_sizes, int n_in, void* d_out, int out_size, void* d_ws, size_t ws_size, hipStream_t stream) {
    static int grid = 0;
    if (grid == 0) {
        if (n_in != 32 || in_sizes[0] != NB * SEQ * DM || out_size != NB * SEQ * DM || ws_size < WS_NEED) { fprintf(stderr, "kernel_launch: unexpected shapes (n_in %d, in0 %d, out %d, ws %zu); nothing launched\n", n_in, n_in > 0 ? in_sizes[0] : -1, out_size, ws_size); grid = -1; return; }
        int dev = 0, cus = 0, per_cu = 0;
        if (hipGetDevice(&dev) != hipSuccess || hipDeviceGetAttribute(&cus, hipDeviceAttributeMultiprocessorCount, dev) != hipSuccess) { grid = -1; return; }
        if (hipFuncSetAttribute((const void*)hybrid_fwd, hipFuncAttributeMaxDynamicSharedMemorySize, LDS_BYTES) != hipSuccess) { fprintf(stderr, "kernel_launch: hipFuncSetAttribute failed\n"); grid = -1; return; }
        if (hipOccupancyMaxActiveBlocksPerMultiprocessor(&per_cu, (const void*)hybrid_fwd, NWAVES * 64, LDS_BYTES) != hipSuccess || per_cu < 1) { fprintf(stderr, "kernel_launch: occupancy query says %d\n", per_cu); per_cu = 1; }
        (void)hipGetLastError();
        grid = cus * per_cu;
    }
    if (grid < 0) return;
    Args a{};
    for (int i = 0; i < 32; ++i) a.in[i] = (const float*)d_in[i];
    a.out = (float*)d_out; a.ws = (unsigned char*)d_ws;
    bf16* Wb = (bf16*)((unsigned char*)d_ws + WS_W);
    int nj = 0, items = 0;
    auto add = [&](const float* src, const float* kscale, bf16* dst, int ld_src, int k_src, int k_pad, int ncols, int ldt, int row_off, int col_base, int k_off, int mode) {
        WJob& J = a.job[nj]; J.src = src; J.kscale = kscale; J.dst = dst; J.ld_src = ld_src; J.k_src = k_src; J.ldt = ldt; J.row_off = row_off; J.col_base = col_base; J.k_off = k_off; J.nblk = ncols / 32; J.mode = mode;
        a.istart[nj] = items; items += (k_pad / 64) * (ncols / 32); ++nj; };
    const float* in10 = a.in[10]; const float* in13 = a.in[13];
    for (int j = 0; j < 2; ++j) add(in10 + (size_t)j * DM * 1536, nullptr, Wb + (W_QKV + (size_t)j * 3 * MiB) / 2, 1536, DM, DM, 1536, DM, 0, 0, 0, 1);
    for (int j = 0; j < 2; ++j) add(in13 + (size_t)j * DM * DM, nullptr, Wb + (W_WO + (size_t)j * 2 * MiB) / 2, DM, DM, DM, DM, DM, 0, 0, 0, 0);
    for (int i = 0; i < 4; ++i) add(a.in[8] + (size_t)i * DM * FF, nullptr, Wb + (W_IN + (size_t)i * 8 * MiB) / 2, FF, DM, DM, FF, DM, 0, 0, 0, 0);
    for (int i = 0; i < 4; ++i) add(a.in[9] + (size_t)i * FF * DM, nullptr, Wb + (W_OUT + (size_t)i * 8 * MiB) / 2, DM, FF, FF, DM, FF, 0, 0, 0, 0);
    { bf16* W1 = Wb + W_R1 / 2; const float* mu = a.in[14]; const float* rkv = a.in[15];
      for (int i = 0; i < 3; ++i) add(rkv + (size_t)i * DM * DM, nullptr, W1 + (size_t)i * DM * DM, DM, DM, DM, DM, DM, 0, 0, 0, 1);
      bf16* WL = W1 + (size_t)3 * DM * DM;
      for (int hf = 0; hf < 2; ++hf) { const int ko = hf * DM;
          for (int d = 0; d < 2; ++d) add(a.in[17] + (size_t)d * DM * 64, hf ? mu + 1 * DM : nullptr, WL, 64, DM, DM, 64, 2048, 0, 64 * d, ko, 1);
          for (int d = 0; d < 2; ++d) add(a.in[20] + (size_t)d * DM * 64, hf ? mu + 4 * DM : nullptr, WL, 64, DM, DM, 64, 2048, 0, 128 + 64 * d, ko, 1);
          add(a.in[22], hf ? mu + 5 * DM : nullptr, WL, 160, DM, DM, 160, 2048, 0, 256, ko, 1);
          add(nullptr, nullptr, WL, 96, DM, DM, 96, 2048, 0, 416, ko, 1); } }
    add(a.in[23], nullptr, Wb + W_G2 / 2, DM, 160, 256, DM, 256, 0, 0, 0, 1);
    add(a.in[29], nullptr, Wb + W_RWO / 2, DM, DM, DM, DM, DM, 0, 0, 0, 0);
    for (int gi = 0; gi < 4; ++gi) add(a.in[30] + (size_t)gi * 256 * 256, nullptr, Wb + W_POOL / 2, 256, 256, 256, 256, 256, 256 * gi, 0, 0, 0);
    if (nj != NJOBS) { fprintf(stderr, "kernel_launch: job count %d != %d\n", nj, NJOBS); return; }
    a.istart[NJOBS] = items; a.istart[NJOBS + 1] = 0;
    if (hipMemsetAsync(d_ws, 0, WS_ZERO_BYTES, stream) != hipSuccess) { fprintf(stderr, "kernel_launch: memset of the barrier words failed\n"); return; }
    void* kargs[] = {&a};
    hipError_t e = hipLaunchCooperativeKernel((const void*)hybrid_fwd, dim3(grid), dim3(NWAVES * 64), kargs, LDS_BYTES, stream);
    if (e != hipSuccess) fprintf(stderr, "kernel_launch: cooperative launch failed: %s (grid %d)\n", hipGetErrorString(e), grid);
}
```

```cpp
#include <hip/hip_runtime.h>
#include <hip/hip_cooperative_groups.h>
#include <cstdio>
#include <cstdint>
namespace cg = cooperative_groups;
namespace pg8 {
#define PG8_LAS __attribute__((address_space(3)))
typedef unsigned short bf16_t;
typedef short bf16x8 __attribute__((ext_vector_type(8)));
typedef float f32x4 __attribute__((ext_vector_type(4)));
typedef unsigned u32x4 __attribute__((ext_vector_type(4)));
constexpr int BM = 256, BK = 64, HALF = 128, HTB = HALF * BK * 2  , STAGE_BYTES = 8 * HTB, NXCD = 8, WGM = 8;

__host__ __device__ __forceinline__ int lds_byte(int r, int c) { const int st = (r >> 4) * 2 + (c >> 5), rr = r & 15, cc = c & 31, ob = rr * 64 + cc * 2; return st * 1024 + (ob ^ (((ob >> 9) & 1) << 5)); }
__host__ __device__ __forceinline__ void stage_rc(int b, int& R, int& C) { const int st = b / 1024, sb = b % 1024, swz = sb ^ (((sb >> 9) & 1) << 5); R = (st >> 1) * 16 + swz / 64; C = (st & 1) * 32 + (swz % 64) / 2; }
__host__ __device__ __forceinline__ int perm32(int rho) { const int n = rho >> 4, i = rho & 15; return 8 * (i >> 2) + 4 * n + (i & 3); }

struct Unit { int pm, pn, kofs; };
struct Gemm { const bf16_t* A; const bf16_t* Bt; int M, N, K; int lda, ldb; long a_pn_off; };

struct StaticOrder {
    int nM, nN, nwg, G, c, skip;
    __host__ __device__ void init(int M, int N, int G_, int c_, int skip_ = 0) { skip = skip_; nM = M / BM; if (skip) nM = nM / 17 * 16; nN = N / BM; nwg = nM * nN; G = G_; c = c_; }
    __host__ __device__ bool next(int i, Unit& u) const {
        const long L = (long)i * G + c; if (L >= nwg) return false;
        int wgid = (int)L; { const int q = nwg / NXCD, r = nwg % NXCD, xcd = wgid % NXCD, off = wgid / NXCD; wgid = (xcd < r ? xcd * (q + 1) : r * (q + 1) + (xcd - r) * q) + off; }
        const int nig = WGM * nN, gid = wgid / nig, fm = gid * WGM, gsz = (nM - fm) < WGM ? (nM - fm) : WGM;
        u.pm = fm + ((wgid % nig) % gsz); u.pn = (wgid % nig) / gsz; u.kofs = 0; if (skip) u.pm += u.pm / 16; return true;
    }
    __device__ __forceinline__ void a_ready(const Unit&) const {}
    __device__ __forceinline__ void done(const Unit&) const {}
};

struct CtxSplitK {
    int G, c, kq;
    __host__ __device__ void init(int Kfull, int G_, int c_) { G = G_; c = c_; kq = Kfull / 4; }
    __host__ __device__ bool next(int i, Unit& u) const { const long L = (long)i * G + c; if (L >= 256) return false; const int l = (int)L; u.pm = (l >> 4) * 17 + 16; u.pn = (l >> 2) & 3; u.kofs = (l & 3) * kq; return true; }
    __device__ __forceinline__ void a_ready(const Unit&) const {}
    __device__ __forceinline__ void done(const Unit&) const {}
};
__device__ __forceinline__ unsigned cvt_pk_bf16(float lo, float hi) { unsigned r; asm volatile("v_cvt_pk_bf16_f32 %0, %1, %2" : "=v"(r) : "v"(lo), "v"(hi)); return r; }
typedef float f32x2 __attribute__((ext_vector_type(2)));
template <class Epi, class Sched, bool ALIGN_EPI = false, bool SP2 = false>
__device__ __forceinline__ void gemm_phase(PG8_LAS unsigned char* lds, const Gemm g, const Sched& S, const Epi& E) {
    int tid_ = threadIdx.x; asm volatile("" : "+v"(tid_)); const int tid = tid_, wid = __builtin_amdgcn_readfirstlane(tid >> 6), lane = tid & 63, wr = wid >> 2, wc = wid & 3, fr = lane & 15, fq = lane >> 4;
    const int K = g.K, nt = K / BK;
    unsigned voffA[2], voffB[2];
#pragma unroll
    for (int i = 0; i < 2; ++i) { int R, C; stage_rc(tid * 16 + i * 8192, R, C); const int Rb = Epi::PERM ? ((R & ~31) + perm32(R & 31)) : R;
        voffA[i] = (unsigned)(R * g.lda + C) * 2u; voffB[i] = (unsigned)(Rb * g.ldb + C) * 2u; }
    const size_t kstep = (size_t)(BK * 2);
    const size_t hA = (size_t)HALF * g.lda * 2, hB = (size_t)HALF * g.ldb * 2;
    const size_t tA = 2 * hA, tB = 2 * hB, pnA = (size_t)g.a_pn_off * 2;
    const unsigned ldsw = (unsigned)wid * 1024u;
    const int aoff = lds_byte(wr * 64 + fr, fq * 8), boff = lds_byte(wc * 32 + fr, fq * 8);
#define PG8_SA(b, h) (((b) * 2 + (h)) * HTB)
#define PG8_SB(b, h) ((4 + (b) * 2 + (h)) * HTB)
#define PG8_STAGE(bufoff, gbase, voff) do { _Pragma("unroll") for (int _i = 0; _i < 2; ++_i) \
        __builtin_amdgcn_global_load_lds((const unsigned*)((const char*)(gbase) + (voff)[_i]), (PG8_LAS unsigned*)(lds + (bufoff) + ldsw + _i * 8192), 16, 0, 0); } while (0)
#define PG8_LDA(dst, b, h) do { _Pragma("unroll") for (int m = 0; m < 4; ++m) _Pragma("unroll") for (int k = 0; k < 2; ++k) dst[m][k] = *(const PG8_LAS bf16x8*)(lds + PG8_SA(b, h) + aoff + m * 2048 + k * 1024); } while (0)
#define PG8_LDB(dst, b, h) do { _Pragma("unroll") for (int n = 0; n < 2; ++n) _Pragma("unroll") for (int k = 0; k < 2; ++k) dst[n][k] = *(const PG8_LAS bf16x8*)(lds + PG8_SB(b, h) + boff + n * 2048 + k * 1024); } while (0)
#define PG8_MMA(ai, bj, At, Bt) do { __builtin_amdgcn_s_setprio(1); _Pragma("unroll") for (int m = 0; m < 4; ++m) _Pragma("unroll") for (int n = 0; n < 2; ++n) _Pragma("unroll") for (int k = 0; k < 2; ++k) \
        acc[ai][bj][m][n] = __builtin_amdgcn_mfma_f32_16x16x32_bf16(Bt[n][k], At[m][k], acc[ai][bj][m][n], 0, 0, 0); __builtin_amdgcn_s_setprio(0); } while (0)
#define PG8_WAIT_V(n) asm volatile("s_waitcnt vmcnt(" #n ")" ::: "memory")
#define PG8_WAIT_L(n) asm volatile("s_waitcnt lgkmcnt(" #n ")" ::: "memory")
#define PG8_BAR __builtin_amdgcn_s_barrier()
#define PG8_SCHED __builtin_amdgcn_sched_barrier(0)
    Unit cur, nxt; int ui = 0;
    if (!S.next(0, cur)) return;
    f32x4 acc[2][2][4][2];
#pragma unroll
    for (int a = 0; a < 2; ++a)
#pragma unroll
        for (int b = 0; b < 2; ++b)
#pragma unroll
            for (int m = 0; m < 4; ++m)
#pragma unroll
                for (int n = 0; n < 2; ++n) acc[a][b][m][n] = (f32x4){0.f, 0.f, 0.f, 0.f};
    bf16x8 At[4][2], B0[2][2], B1[2][2];
    const char* cA = (const char*)g.A + (size_t)cur.pm * tA + (size_t)cur.pn * pnA + (size_t)cur.kofs * 2; const char* cB = (const char*)g.Bt + (size_t)cur.pn * tB + (size_t)cur.kofs * 2;
    S.a_ready(cur);
    if constexpr (SP2) {
        PG8_STAGE(PG8_SB(0, 0), cB, voffB); PG8_STAGE(PG8_SB(0, 1), cB + hB, voffB); PG8_STAGE(PG8_SA(0, 0), cA, voffA); PG8_STAGE(PG8_SA(0, 1), cA + hA, voffA);
        if (wr == 1) PG8_BAR;
        PG8_WAIT_V(2); PG8_BAR;
        PG8_STAGE(PG8_SB(1, 0), cB + kstep, voffB); PG8_STAGE(PG8_SA(1, 0), cA + kstep, voffA); PG8_STAGE(PG8_SB(1, 1), cB + hB + kstep, voffB);
        PG8_WAIT_V(6); PG8_BAR;
    } else {
        PG8_STAGE(PG8_SB(0, 0), cB, voffB); PG8_STAGE(PG8_SA(0, 0), cA, voffA); PG8_STAGE(PG8_SB(0, 1), cB + hB, voffB); PG8_STAGE(PG8_SA(0, 1), cA + hA, voffA);
        if (wr == 1) PG8_BAR;
        PG8_WAIT_V(4); PG8_BAR;
        PG8_STAGE(PG8_SB(1, 0), cB + kstep, voffB); PG8_STAGE(PG8_SA(1, 0), cA + kstep, voffA); PG8_STAGE(PG8_SB(1, 1), cB + hB + kstep, voffB);
        PG8_WAIT_V(6); PG8_BAR;
    }
    for (;;) {
        const bool has_next = S.next(ui + 1, nxt);
        const char* nA = has_next ? (const char*)g.A + (size_t)nxt.pm * tA + (size_t)nxt.pn * pnA + (size_t)nxt.kofs * 2 : cA; const char* nB = has_next ? (const char*)g.Bt + (size_t)nxt.pn * tB + (size_t)nxt.kofs * 2 : cB;
#pragma unroll 1
        for (int t = 0; t < nt; t += 2) {
            const bool last = (t == nt - 2);
            const char* a1 = cA + (size_t)(t + 1) * kstep;
            const char* a2 = last ? nA : cA + (size_t)(t + 2) * kstep; const char* b2 = last ? nB : cB + (size_t)(t + 2) * kstep;
            const char* a3 = a2 + kstep; const char* b3 = b2 + kstep;
            if (last && has_next) S.a_ready(nxt);
            if constexpr (SP2) {
            PG8_LDB(B0, 0, 0); PG8_LDB(B1, 0, 1); PG8_SCHED; PG8_LDA(At, 0, 0); PG8_STAGE(PG8_SA(1, 1), a1 + hA, voffA);
            PG8_WAIT_V(8); PG8_WAIT_L(0); PG8_BAR; PG8_MMA(0, 0, At, B0); PG8_MMA(0, 1, At, B1); PG8_BAR; PG8_SCHED;
            PG8_LDA(At, 0, 1); PG8_STAGE(PG8_SB(0, 0), b2, voffB); PG8_STAGE(PG8_SB(0, 1), b2 + hB, voffB); PG8_STAGE(PG8_SA(0, 0), a2, voffA);
            PG8_WAIT_V(8); PG8_WAIT_L(0); PG8_BAR; PG8_MMA(1, 0, At, B0); PG8_MMA(1, 1, At, B1); PG8_BAR; PG8_SCHED;
            PG8_LDB(B0, 1, 0); PG8_LDB(B1, 1, 1); PG8_SCHED; PG8_LDA(At, 1, 0); PG8_STAGE(PG8_SA(0, 1), a2 + hA, voffA);
            PG8_WAIT_V(8); PG8_WAIT_L(0); PG8_BAR; PG8_MMA(0, 0, At, B0); PG8_MMA(0, 1, At, B1); PG8_BAR; PG8_SCHED;
            PG8_LDA(At, 1, 1); PG8_STAGE(PG8_SB(1, 0), b3, voffB); PG8_STAGE(PG8_SB(1, 1), b3 + hB, voffB); PG8_STAGE(PG8_SA(1, 0), a3, voffA);
            PG8_WAIT_V(8); PG8_WAIT_L(0); PG8_BAR; PG8_MMA(1, 0, At, B0); PG8_MMA(1, 1, At, B1); PG8_BAR; PG8_SCHED;
            } else {
            PG8_LDB(B0, 0, 0); PG8_SCHED; PG8_LDA(At, 0, 0); PG8_STAGE(PG8_SA(1, 1), a1 + hA, voffA);
            PG8_WAIT_L(8); PG8_BAR; PG8_WAIT_L(0); PG8_MMA(0, 0, At, B0); PG8_BAR; PG8_SCHED;
            PG8_LDB(B1, 0, 1); PG8_STAGE(PG8_SB(0, 0), b2, voffB);
            PG8_BAR; PG8_WAIT_L(0); PG8_MMA(0, 1, At, B1); PG8_BAR;
            PG8_LDA(At, 0, 1); PG8_STAGE(PG8_SA(0, 0), a2, voffA);
            PG8_BAR; PG8_WAIT_L(0); PG8_MMA(1, 0, At, B0); PG8_BAR; PG8_SCHED;
            PG8_STAGE(PG8_SB(0, 1), b2 + hB, voffB);
            PG8_WAIT_V(6); PG8_BAR; PG8_MMA(1, 1, At, B1); PG8_BAR;
            PG8_LDB(B0, 1, 0); PG8_SCHED; PG8_LDA(At, 1, 0); PG8_STAGE(PG8_SA(0, 1), a2 + hA, voffA);
            PG8_WAIT_L(8); PG8_BAR; PG8_WAIT_L(0); PG8_MMA(0, 0, At, B0); PG8_BAR; PG8_SCHED;
            PG8_LDB(B1, 1, 1); PG8_STAGE(PG8_SB(1, 0), b3, voffB);
            PG8_BAR; PG8_WAIT_L(0); PG8_MMA(0, 1, At, B1); PG8_BAR;
            PG8_LDA(At, 1, 1); PG8_STAGE(PG8_SA(1, 0), a3, voffA);
            PG8_BAR; PG8_WAIT_L(0); PG8_MMA(1, 0, At, B0); PG8_BAR; PG8_SCHED;
            PG8_STAGE(PG8_SB(1, 1), b3 + hB, voffB);
            PG8_WAIT_V(6); PG8_BAR; PG8_MMA(1, 1, At, B1); PG8_BAR;
            }
        }
        if constexpr (ALIGN_EPI) { if (wr == 0) PG8_BAR; }
        if constexpr (!Epi::AFTER_DRAIN) { E(acc, cur, wr, wc, fr, fq); S.done(cur); }
        if (!has_next) break;
#pragma unroll
        for (int a = 0; a < 2; ++a)
#pragma unroll
            for (int b = 0; b < 2; ++b)
#pragma unroll
                for (int m = 0; m < 4; ++m)
#pragma unroll
                    for (int n = 0; n < 2; ++n) acc[a][b][m][n] = (f32x4){0.f, 0.f, 0.f, 0.f};
        cur = nxt; cA = nA; cB = nB; ++ui;
        if constexpr (ALIGN_EPI) { if (wr == 1) PG8_BAR; }
    }
    PG8_WAIT_V(0);
    if constexpr (!ALIGN_EPI) { if (wr == 0) PG8_BAR; }
    PG8_BAR;
    if constexpr (Epi::AFTER_DRAIN) { E.fused(acc, cur, wr, wc, fr, fq, lds, wid, lane); S.done(cur); }
#undef PG8_SA
#undef PG8_SB
#undef PG8_STAGE
#undef PG8_LDA
#undef PG8_LDB
#undef PG8_MMA
#undef PG8_WAIT_V
#undef PG8_WAIT_L
#undef PG8_BAR
#undef PG8_SCHED
}
}
#include <hip/hip_bf16.h>
#include <cmath>
namespace attn_body {
using bf16=__hip_bfloat16;
using bf16x8=__attribute__((ext_vector_type(8)))short;
using s16x4=__attribute__((ext_vector_type(4)))short;
using f32x16=__attribute__((ext_vector_type(16)))float;
using u32x4=__attribute__((ext_vector_type(4)))unsigned;
constexpr int D=64,DM=1024,KVP=256;
constexpr int NW=8,QBLK=32,QB=QBLK*NW,KVBLK=64;
constexpr int ATTN_PITCH=DM, ATTN_UNIT_ROWS=QB;
__device__ __forceinline__ int crow(int r,int hi){return (r&3)+8*(r>>2)+4*hi;}
#define SBAR() __builtin_amdgcn_sched_barrier(0)
__device__ __forceinline__ void cmask(f32x16&p0,f32x16&p1,int jb,int qrel,int hi){
  const float NEG=-INFINITY; int kb=64*jb+4*hi;
  #pragma unroll
  for(int r=0;r<16;++r){int kv=kb+(r&3)+8*(r>>2); if(kv>qrel)p0[r]=NEG; if(kv+32>qrel)p1[r]=NEG;}
}

constexpr int NSLOT=3, SLOTB=8192;
constexpr int LDS_K=0, LDS_V=NSLOT*SLOTB, LDS_WS=2*NSLOT*SLOTB, LDS_OST=LDS_WS+NW*64*4, LDS_BYTES=LDS_OST+NW*4096;
constexpr float C2=0.125f*1.4426950408889634f;
__device__ __forceinline__ void glds16(const void*gsrc,unsigned lds_dst){unsigned keep;
  asm volatile("s_mov_b32 %0, m0\n\ts_mov_b32 m0, %2\n\ts_nop 0\n\tglobal_load_lds_dwordx4 %1, off\n\ts_mov_b32 m0, %0":"=&s"(keep):"v"(gsrc),"s"(lds_dst):"memory");}
__device__ __forceinline__ float max3f(float a,float b,float c){float r;asm("v_max3_f32 %0, %1, %2, %3":"=v"(r):"v"(a),"v"(b),"v"(c));return r;}
__device__ __forceinline__ float max2f(float a,float b){float r;asm("v_max_f32_e32 %0, %1, %2":"=v"(r):"v"(a),"v"(b));return r;}
__device__ __forceinline__ float fadd_s(float a,float b){float r;asm("v_add_f32_e32 %0, %1, %2":"=v"(r):"v"(a),"v"(b));return r;}
__device__ __forceinline__ float fsub_s(float a,float b){float r;asm("v_sub_f32_e32 %0, %1, %2":"=v"(r):"v"(a),"v"(b));return r;}
typedef float f32x2_t __attribute__((ext_vector_type(2))); typedef __bf16 bf16x2_t __attribute__((ext_vector_type(2)));
__device__ __forceinline__ unsigned cvtpk_s(float lo,float hi){f32x2_t v={lo,hi};bf16x2_t b=__builtin_convertvector(v,bf16x2_t);return __builtin_bit_cast(unsigned,b);}
#define WAIT_BAR(N) asm volatile("s_waitcnt vmcnt(" #N ") lgkmcnt(0)\n\ts_barrier":::"memory")

__device__ __forceinline__ void qkt(f32x16&p0,f32x16&p1,const char*Kslot,const bf16x8*qr,const f32x16&negm,int r32,int hi){
  const char*kb=Kslot+hi*1024+r32*16;
  #pragma unroll
  for(int d0=0;d0<4;++d0){
    const bf16x8 b0=*reinterpret_cast<const bf16x8*>(kb+d0*2048);
    const bf16x8 b1=*reinterpret_cast<const bf16x8*>(kb+d0*2048+512);
    if(d0==0){p0=__builtin_amdgcn_mfma_f32_32x32x16_bf16(b0,qr[0],negm,0,0,0);p1=__builtin_amdgcn_mfma_f32_32x32x16_bf16(b1,qr[0],negm,0,0,0);}
    else{p0=__builtin_amdgcn_mfma_f32_32x32x16_bf16(b0,qr[d0],p0,0,0,0);p1=__builtin_amdgcn_mfma_f32_32x32x16_bf16(b1,qr[d0],p1,0,0,0);}}
}
typedef __attribute__((address_space(3))) const char* lds_cptr;
typedef short v4i16_t __attribute__((ext_vector_type(4)));
__device__ __forceinline__ void kload8(bf16x8*kf,lds_cptr kp){
  kf[0]=*(const __attribute__((address_space(3))) bf16x8*)(kp);      kf[1]=*(const __attribute__((address_space(3))) bf16x8*)(kp+512);
  kf[2]=*(const __attribute__((address_space(3))) bf16x8*)(kp+2048); kf[3]=*(const __attribute__((address_space(3))) bf16x8*)(kp+2560);
  kf[4]=*(const __attribute__((address_space(3))) bf16x8*)(kp+4096); kf[5]=*(const __attribute__((address_space(3))) bf16x8*)(kp+4608);
  kf[6]=*(const __attribute__((address_space(3))) bf16x8*)(kp+6144); kf[7]=*(const __attribute__((address_space(3))) bf16x8*)(kp+6656);
}
__device__ __forceinline__ void kload2(bf16x8*kf,lds_cptr kp,int j){ kf[2*j]=*(const __attribute__((address_space(3))) bf16x8*)(kp+j*2048); kf[2*j+1]=*(const __attribute__((address_space(3))) bf16x8*)(kp+j*2048+512); }
__device__ __forceinline__ s16x4 vtr(lds_cptr p){ return __builtin_bit_cast(s16x4,__builtin_amdgcn_ds_read_tr16_b64_v4i16((__attribute__((address_space(3))) v4i16_t*)p)); }
__device__ __forceinline__ float rowmax(const f32x16&p0,const f32x16&p1){
  float a=max3f(p0[0],p0[1],p1[0]),b=max3f(p0[2],p0[3],p1[1]);a=max3f(a,p1[2],p1[3]);
  #pragma unroll
  for(int r=4;r<16;r+=4){a=max3f(a,p0[r],p0[r+1]);b=max3f(b,p0[r+2],p0[r+3]);a=max3f(a,p1[r],p1[r+1]);b=max3f(b,p1[r+2],p1[r+3]);}
  const float m=max2f(a,b);
  auto rr=__builtin_amdgcn_permlane32_swap(__float_as_uint(m),__float_as_uint(m),false,false);
  return max2f(__uint_as_float(rr[0]),__uint_as_float(rr[1]));
}
__device__ __forceinline__ void pv(f32x16*o,int vb,bf16x8 pa0,bf16x8 pa1,bf16x8 pa2,bf16x8 pa3){
  #pragma unroll
  for(int d0=0;d0<2;++d0){s16x4 lo[4],hi[4];
    #pragma unroll
    for(int ks=0;ks<4;++ks){
      asm volatile("ds_read_b64_tr_b16 %0,%1 offset:%c2":"=&v"(lo[ks]):"v"(vb),"i"(d0*4096+ks*1024):"memory");
      asm volatile("ds_read_b64_tr_b16 %0,%1 offset:%c2":"=&v"(hi[ks]):"v"(vb),"i"(d0*4096+ks*1024+512):"memory");}
    asm volatile("s_waitcnt lgkmcnt(0)":::"memory");SBAR();
    #define PK(k) (bf16x8){lo[k][0],lo[k][1],lo[k][2],lo[k][3],hi[k][0],hi[k][1],hi[k][2],hi[k][3]}
    o[d0]=__builtin_amdgcn_mfma_f32_32x32x16_bf16(pa0,PK(0),o[d0],0,0,0);
    o[d0]=__builtin_amdgcn_mfma_f32_32x32x16_bf16(pa1,PK(1),o[d0],0,0,0);
    o[d0]=__builtin_amdgcn_mfma_f32_32x32x16_bf16(pa2,PK(2),o[d0],0,0,0);
    o[d0]=__builtin_amdgcn_mfma_f32_32x32x16_bf16(pa3,PK(3),o[d0],0,0,0);
    #undef PK
  }
}

#ifndef ATTN_STORE16
#define ATTN_STORE16(p,v) (*(u32x4*)(p)=(v))
#endif
template<int THRL> __device__ __forceinline__ void attn_unit(long qrow0,long kvrow0,const int NT,int h,const bf16*Q,const bf16*__restrict__ K,const bf16*__restrict__ V,bf16*O,char*shm){
  int tid_=threadIdx.x; asm volatile("":"+v"(tid_)); const int tid=tid_,lane=tid&63,r32=lane&31,hi=lane>>5; const int wid=__builtin_amdgcn_readfirstlane(tid>>6);
  const int g=h>>2;
  const bf16*Qw=Q+(qrow0+wid*QBLK)*DM+h*D;
  const bf16*Kh=K+kvrow0*KVP+g*D,*Vh=V+kvrow0*KVP+g*D;
  const unsigned lds0=(unsigned)(uintptr_t)shm;
  float*wsf=(float*)(shm+LDS_WS)+wid*64;
  const bf16*ksrc=Kh+(long)lane*KVP+wid*8;
  const bf16*vsrc=Vh+(long)(16*(wid&3)+(lane>>2))*KVP+(wid>>2)*32+(lane&3)*8;
  const unsigned kdst=lds0+LDS_K+wid*1024, vdst=lds0+LDS_V+wid*1024;
  #define DMA_K(t,slot) glds16(ksrc+(long)(t)*KVBLK*KVP,(unsigned)__builtin_amdgcn_readfirstlane(kdst+(slot)))
  #define DMA_V(t,slot) glds16(vsrc+(long)(t)*KVBLK*KVP,(unsigned)__builtin_amdgcn_readfirstlane(vdst+(slot)))
  const int vb0=(int)(lds0+LDS_V)+((lane>>4)&1)*32+(lane&3)*8+(4*hi+((lane&15)>>2))*64;
  const char*Kbase=shm+LDS_K; bf16x8 kf[8];
  const lds_cptr shm3=(lds_cptr)shm; const lds_cptr kp0=shm3+LDS_K+hi*1024+r32*16; const lds_cptr vp0=shm3+LDS_V+((lane>>4)&1)*32+(lane&3)*8+(4*hi+((lane&15)>>2))*64;
  DMA_K(0,0);DMA_V(0,0);DMA_K(1,SLOTB);
  bf16x8 qr[4];
  #pragma unroll
  for(int d0=0;d0<4;++d0)qr[d0]=*reinterpret_cast<const bf16x8*>(&Qw[(long)r32*DM+d0*16+hi*8]);
  float mhat=0.f,l_reg=0.f;f32x16 o[2];o[0]=f32x16{};o[1]=f32x16{};f32x16 negm=f32x16{};asm volatile("":"+v"(negm));
  const int qrel=wid*QBLK+r32;
  #define CMASK(P0,P1,t) do{}while(0)
  bool resc=false;
  #define START(P0,P1) do{ const float rm=rowmax(P0,P1); resc=false; \
    { const float dl=rm; mhat=fadd_s(mhat,dl); \
      _Pragma("unroll") for(int r=0;r<16;++r){P0[r]=fsub_s(P0[r],dl);P1[r]=fsub_s(P1[r],dl);} \
      _Pragma("unroll") for(int r=0;r<16;++r)negm[r]=-mhat; asm volatile("":"+v"(negm)); } \
    _Pragma("unroll") for(int r=0;r<16;++r)P0[r]=__builtin_amdgcn_exp2f(P0[r]); }while(0)
  #define RESC() do{ if(resc){ asm volatile("s_waitcnt lgkmcnt(0)":::"memory"); \
      _Pragma("unroll") for(int d_=0;d_<2;++d_) _Pragma("unroll") for(int r=0;r<16;++r)o[d_][r]*=wsf[crow(r,hi)]; } }while(0)
  f32x16 pA0,pA1,pB0,pB1;
  int sl_prev=0,sl_cur=0,sl_next=SLOTB;
  #define ROT() do{sl_prev=sl_cur;sl_cur=sl_next;sl_next=(sl_next==(NSLOT-1)*SLOTB)?0:sl_next+SLOTB;}while(0)
  DMA_K(2,2*SLOTB);
  WAIT_BAR(3);
  qkt(pA0,pA1,Kbase,qr,negm,r32,hi);asm volatile("s_nop 15\n\ts_nop 7":"+v"(pA0),"+v"(pA1));CMASK(pA0,pA1,0);
  START(pA0,pA1);
  _Pragma("unroll") for(int r=0;r<16;++r)pA1[r]=__builtin_amdgcn_exp2f(pA1[r]);
  WAIT_BAR(0);
  DMA_K(3,0);DMA_V(1,SLOTB);
  ROT();
  kload8(kf,kp0+sl_cur);
  WAIT_BAR(2);
  s16x4 vlo[8],vhi[8]; u32x4 pw0,pw1,pw2,pw3;
  #define PKW(P,B) cvtpk_s(P[B],P[B+1])
  #define PAF(k) __builtin_bit_cast(bf16x8,pw##k)
  #define VFR(i) (bf16x8){vlo[i][0],vlo[i][1],vlo[i][2],vlo[i][3],vhi[i][0],vhi[i][1],vhi[i][2],vhi[i][3]}
  #define PIN(x) asm volatile("":"+v"(x))
  #define MX3(a,b,c) __builtin_fmaxf(__builtin_fmaxf((a),(b)),(c))
  #define GAPA(MF,A0,A1,A2,A3,W0,W1,PW) do{ MF; sacc+=A0; sacc+=A1; sacc+=A2; sacc+=A3; PIN(sacc); W0; W1; PIN(PW); SBAR(); }while(0)
  #define EX(v) __builtin_amdgcn_exp2f(v)
  #define GAPB(MF,X,B) do{ MF; X[B]=EX(X[B]); X[B+1]=EX(X[B+1]); X[B+2]=EX(X[B+2]); X[B+3]=EX(X[B+3]); PIN(X); SBAR(); }while(0)
  #define VRD(i) do{ vlo[i]=vtr(vp_+(((i)>>2)*4096+((i)&3)*1024)); vhi[i]=vtr(vp_+(((i)>>2)*4096+((i)&3)*1024+512)); }while(0)
  #define KRD(G,j) do{ if(G){ kload2(kf,kp0+sl_next,j); SBAR(); } }while(0)
  #define STEP(C0,C1,P0,P1,t,GK,GV,GL) do{ SBAR(); \
    const lds_cptr vp_=vp0+sl_prev; \
    VRD(0); SBAR(); float sacc=(P0[0]+P0[1]); \
    GAPA(C0=__builtin_amdgcn_mfma_f32_32x32x16_bf16(kf[0],qr[0],negm,0,0,0), P0[2],P0[3],P0[4],P0[5],     pw0[0]=PKW(P0,0), pw0[1]=PKW(P0,2), pw0); \
    VRD(4); SBAR(); GAPA(C1=__builtin_amdgcn_mfma_f32_32x32x16_bf16(kf[1],qr[0],negm,0,0,0), P0[6],P0[7],P0[8],P0[9],     pw0[2]=PKW(P0,4), pw0[3]=PKW(P0,6), pw0); \
    VRD(1); SBAR(); GAPA(C0=__builtin_amdgcn_mfma_f32_32x32x16_bf16(kf[2],qr[1],C0,0,0,0),   P0[10],P0[11],P0[12],P0[13], pw1[0]=PKW(P0,8), pw1[1]=PKW(P0,10), pw1); \
    VRD(5); SBAR(); GAPA(C1=__builtin_amdgcn_mfma_f32_32x32x16_bf16(kf[3],qr[1],C1,0,0,0),   P0[14],P0[15],P1[0],P1[1],   pw1[2]=PKW(P0,12),pw1[3]=PKW(P0,14), pw1); \
    VRD(2); SBAR(); GAPA(C0=__builtin_amdgcn_mfma_f32_32x32x16_bf16(kf[4],qr[2],C0,0,0,0),   P1[2],P1[3],P1[4],P1[5],     pw2[0]=PKW(P1,0), pw2[1]=PKW(P1,2), pw2); \
    VRD(6); SBAR(); GAPA(C1=__builtin_amdgcn_mfma_f32_32x32x16_bf16(kf[5],qr[2],C1,0,0,0),   P1[6],P1[7],P1[8],P1[9],     pw2[2]=PKW(P1,4), pw2[3]=PKW(P1,6), pw2); \
    VRD(3); SBAR(); GAPA(C0=__builtin_amdgcn_mfma_f32_32x32x16_bf16(kf[6],qr[3],C0,0,0,0),   P1[10],P1[11],P1[12],P1[13], pw3[0]=PKW(P1,8), pw3[1]=PKW(P1,10), pw3); \
    VRD(7); SBAR(); GAPA(C1=__builtin_amdgcn_mfma_f32_32x32x16_bf16(kf[7],qr[3],C1,0,0,0),   P1[14],P1[15],0.f,0.f,       pw3[2]=PKW(P1,12),pw3[3]=PKW(P1,14), pw3); \
    l_reg+=sacc; \
    if(GK){DMA_K((t)+3,sl_cur);} if(GV){DMA_V((t)+1,sl_next);} \
    CMASK(C0,C1,t); \
    { float a=MX3(C0[0],C0[1],C1[0]),b=MX3(C0[2],C0[3],C1[1]); a=MX3(a,C1[2],C1[3]); \
      _Pragma("unroll") for(int r=4;r<16;r+=4){a=MX3(a,C0[r],C0[r+1]);b=MX3(b,C0[r+2],C0[r+3]);a=MX3(a,C1[r],C1[r+1]);b=MX3(b,C1[r+2],C1[r+3]);} \
      float rm=__builtin_fmaxf(a,b); { auto rr=__builtin_amdgcn_permlane32_swap(__float_as_uint(rm),__float_as_uint(rm),false,false); rm=__builtin_fmaxf(__uint_as_float(rr[0]),__uint_as_float(rr[1])); } \
      resc=false; \
      if(__builtin_expect(__any(rm>(float)THRL),0)){ const float dl=__builtin_fmaxf(rm,0.f); mhat+=dl; \
        _Pragma("unroll") for(int r=0;r<16;++r){C0[r]-=dl;C1[r]-=dl;} \
        _Pragma("unroll") for(int r=0;r<16;++r)negm[r]=-mhat; asm volatile("":"+v"(negm)); \
        const float f=__builtin_amdgcn_exp2f(-dl); l_reg*=f; if(hi==0)wsf[r32]=f; resc=true; } } \
    SBAR(); \
    GAPB(o[0]=__builtin_amdgcn_mfma_f32_32x32x16_bf16(PAF(0),VFR(0),o[0],0,0,0), C0,0); \
    GAPB(o[1]=__builtin_amdgcn_mfma_f32_32x32x16_bf16(PAF(0),VFR(4),o[1],0,0,0), C0,4); \
    KRD(GL,0); GAPB(o[0]=__builtin_amdgcn_mfma_f32_32x32x16_bf16(PAF(1),VFR(1),o[0],0,0,0), C0,8); \
    KRD(GL,1); GAPB(o[1]=__builtin_amdgcn_mfma_f32_32x32x16_bf16(PAF(1),VFR(5),o[1],0,0,0), C0,12); \
    KRD(GL,2); GAPB(o[0]=__builtin_amdgcn_mfma_f32_32x32x16_bf16(PAF(2),VFR(2),o[0],0,0,0), C1,0); \
    KRD(GL,3); GAPB(o[1]=__builtin_amdgcn_mfma_f32_32x32x16_bf16(PAF(2),VFR(6),o[1],0,0,0), C1,4); \
    GAPB(o[0]=__builtin_amdgcn_mfma_f32_32x32x16_bf16(PAF(3),VFR(3),o[0],0,0,0), C1,8); \
    GAPB(o[1]=__builtin_amdgcn_mfma_f32_32x32x16_bf16(PAF(3),VFR(7),o[1],0,0,0), C1,12); \
    }while(0)
  int t=1;
  #undef CMASK
  #define CMASK(P0,P1,t) do{}while(0)
  for(;t+5<NT;t+=2){
    STEP(pB0,pB1,pA0,pA1,t,true,true,true);     WAIT_BAR(2); RESC(); ROT();
    STEP(pA0,pA1,pB0,pB1,t+1,true,true,true);   WAIT_BAR(2); RESC(); ROT();
  }
  #undef CMASK
  #define CMASK(P0,P1,t) do{}while(0)
  #define ENDW(tt) do{ if((tt)+3<NT){WAIT_BAR(2);} else if((tt)+2<NT){WAIT_BAR(1);} else {WAIT_BAR(0);} }while(0)
  for(;t+1<NT;t+=2){
    STEP(pB0,pB1,pA0,pA1,t,(t+3<NT),(t+1<NT),(t+1<NT));       ENDW(t);   RESC(); ROT();
    STEP(pA0,pA1,pB0,pB1,t+1,(t+4<NT),(t+2<NT),(t+2<NT));     ENDW(t+1); RESC(); ROT();
  }
  STEP(pB0,pB1,pA0,pA1,NT-1,false,false,false); RESC();
  { float sacc=pB0[0]+pB0[1]; _Pragma("unroll") for(int r=2;r<16;++r)sacc+=pB0[r]; _Pragma("unroll") for(int r=0;r<16;++r)sacc+=pB1[r]; l_reg+=sacc;
    pw0=(u32x4){PKW(pB0,0),PKW(pB0,2),PKW(pB0,4),PKW(pB0,6)};pw1=(u32x4){PKW(pB0,8),PKW(pB0,10),PKW(pB0,12),PKW(pB0,14)};pw2=(u32x4){PKW(pB1,0),PKW(pB1,2),PKW(pB1,4),PKW(pB1,6)};pw3=(u32x4){PKW(pB1,8),PKW(pB1,10),PKW(pB1,12),PKW(pB1,14)};
    SBAR(); pv(o,vb0+sl_cur,PAF(0),PAF(1),PAF(2),PAF(3)); }
  #undef PKW
  #undef PAF
  #undef VFR
  #undef PIN
  #undef MX3
  #undef GAPA
  #undef GAPB
  #undef EX
  #undef VRD
  #undef KRD
  #undef STEP
  #undef ENDW
  {auto rr=__builtin_amdgcn_permlane32_swap(__float_as_uint(l_reg),__float_as_uint(l_reg),false,false);l_reg=__uint_as_float(rr[0])+__uint_as_float(rr[1]);}
  if(hi==0)wsf[32+r32]=l_reg;asm volatile("s_waitcnt lgkmcnt(0)":::"memory");
  float rli[16];
  #pragma unroll
  for(int r=0;r<16;++r)rli[r]=__builtin_amdgcn_rcpf(wsf[32+crow(r,hi)]);
  bf16*Ow=O+(qrow0+wid*QBLK)*DM+h*D;
  { bf16*stg=(bf16*)(shm+LDS_OST)+wid*2048;
    #pragma unroll
    for(int r=0;r<16;++r){const int orow=crow(r,hi);
      #pragma unroll
      for(int d0=0;d0<2;++d0)stg[orow*64+d0*32+r32]=__float2bfloat16(o[d0][r]*rli[r]);}
    asm volatile("s_waitcnt lgkmcnt(0)":::"memory");
    #pragma unroll
    for(int i=0;i<4;++i){const int row=i*8+(lane>>3),ch=lane&7; const u32x4 v=*(const u32x4*)(stg+row*64+ch*8); ATTN_STORE16(Ow+(long)row*DM+ch*8,v);} }
  asm volatile("s_waitcnt lgkmcnt(0)\n\ts_barrier":::"memory");
  #undef DMA_K
  #undef DMA_V
  #undef CMASK
  #undef START
  #undef RESC
  #undef ROT
}
constexpr int ATTN_LDS_BYTES=LDS_BYTES;
#undef SBAR
#undef WAIT_BAR
}
constexpr int NB = 16, SEQ = 4096, CTXL = 256, TPB = SEQ + CTXL, DM = 1024, FF = 4096, MROWS = NB * TPB;
constexpr int NMOD = 6 * DM;
constexpr int NWAVES = 8;
constexpr int LDS_BYTES = 147456;
constexpr float RMS_EPS = 1e-6f, GN_EPS_F = 64.0f * 1e-5f;
constexpr float QSCALE = 0.125f * 1.4426950408889634f;

#define LAS __attribute__((address_space(3)))
typedef unsigned short bf16;
typedef float f32x4 __attribute__((ext_vector_type(4)));
typedef float f32x2 __attribute__((ext_vector_type(2)));
typedef unsigned u32x4 __attribute__((ext_vector_type(4)));
typedef unsigned u32x2 __attribute__((ext_vector_type(2)));
typedef short bf16x8 __attribute__((ext_vector_type(8)));
using pg8::Unit; using pg8::cvt_pk_bf16;
constexpr int HALF = 128, BM = 256;

constexpr size_t MiB = 1u << 20;
constexpr size_t WS_ROWSQ = 64 * 1024  , WS_SW = 2 * MiB  , WS_ZERO_BYTES = 2 * MiB;
constexpr size_t WS_MODP = 4 * MiB, WS_MOD = 11 * MiB, WS_ROPE = 13 * MiB, WS_BONUS = 15 * MiB, WS_CTX = 24 * MiB, WS_W = 40 * MiB, WS_ACT = 132 * MiB, WS_NEED = 1024 * MiB;
constexpr size_t W_QKV = 0, W_WO = 6 * MiB, W_IN = 10 * MiB, W_OUT = 42 * MiB, W_R1 = 74 * MiB, W_G2 = 88 * MiB, W_RWO = 89 * MiB, W_POOL = 91 * MiB;
constexpr size_t ACT1 = 136 * MiB;

__device__ __forceinline__ float bflo(unsigned u) { return __uint_as_float(u << 16); }
__device__ __forceinline__ float bfhi(unsigned u) { return __uint_as_float(u & 0xffff0000u); }
__device__ __forceinline__ float bf2f(unsigned short u) { return __uint_as_float(((unsigned)u) << 16); }
__device__ __forceinline__ float fsigmoid(float x) { return __builtin_amdgcn_rcpf(1.0f + __builtin_amdgcn_exp2f(-1.4426950408889634f * x)); }
__device__ __forceinline__ u32x4 pack8(f32x4 a, f32x4 b) { u32x4 w; w.x = cvt_pk_bf16(a[0], a[1]); w.y = cvt_pk_bf16(a[2], a[3]); w.z = cvt_pk_bf16(b[0], b[1]); w.w = cvt_pk_bf16(b[2], b[3]); return w; }
__device__ __forceinline__ void unpack8(u32x4 w, f32x4& a, f32x4& b) { a = (f32x4){bflo(w.x), bfhi(w.x), bflo(w.y), bfhi(w.y)}; b = (f32x4){bflo(w.z), bfhi(w.z), bflo(w.w), bfhi(w.w)}; }
__device__ __forceinline__ float wave_sum(float v) {
#pragma unroll
    for (int o = 1; o < 64; o <<= 1) v += __shfl_xor(v, o);
    return v;
}


struct EpiRelu2 {
    static constexpr bool PERM = true, AFTER_DRAIN = false;
    bf16* O; int ldc; const float* rowsq; const float* sw;
    __device__ __forceinline__ void operator()(const f32x4 (&acc)[2][2][4][2], const Unit& u, int wr_, int wc_, int fr_, int fq_) const {
        int wr = wr_, wc = wc_, fr = fr_, fq = fq_; asm volatile("" : "+s"(wr), "+s"(wc), "+v"(fr), "+v"(fq));
        const int row0 = u.pm * BM + wr * 64 + fr, col0 = u.pn * BM + wc * 32 + 8 * fq;
        const f32x4 z = (f32x4){0.f, 0.f, 0.f, 0.f};
        const int bb = u.pm / 17; const float* swr = sw + (size_t)((u.pm - bb * 17 == 16) ? 16 : bb) * FF + col0;
        f32x4 bv[2][2];
#pragma unroll
        for (int bj = 0; bj < 2; ++bj)
#pragma unroll
            for (int n = 0; n < 2; ++n) bv[bj][n] = *(const f32x4*)(swr + bj * HALF + 4 * n);
#pragma unroll
        for (int ai = 0; ai < 2; ++ai)
#pragma unroll
            for (int m = 0; m < 4; ++m) { bf16* rowp = O + (size_t)(row0 + ai * HALF + m * 16) * ldc + col0;
                const float rinv = __builtin_amdgcn_rsqf(rowsq[row0 + ai * HALF + m * 16] * (1.0f / DM) + RMS_EPS);
#pragma unroll
                for (int bj = 0; bj < 2; ++bj) { f32x4 v0 = __builtin_elementwise_max(acc[ai][bj][m][0] * rinv + bv[bj][0], z), v1 = __builtin_elementwise_max(acc[ai][bj][m][1] * rinv + bv[bj][1], z);
                    *(u32x4*)(rowp + bj * HALF) = pack8(v0 * v0, v1 * v1); } }
    }
};

template <bool ATOMIC> struct EpiResidT {
    static constexpr bool PERM = true, AFTER_DRAIN = false;
    const float* srcL; const float* srcC; float* dstL; float* dstC; const float* mod; int slot; const float* colscale;
    bf16* Hout; float* rowsq; const float* gamma; const float* hscale;
    const float* pend; const float* pgate;
    __device__ __forceinline__ void operator()(const f32x4 (&acc)[2][2][4][2], const Unit& u, int wr_, int wc_, int fr_, int fq_) const {
        int wr = wr_, wc = wc_, fr = fr_, fq = fq_; asm volatile("" : "+s"(wr), "+s"(wc), "+v"(fr), "+v"(fq));
        const int b = u.pm / 17, tt = u.pm - b * 17; const bool ctx = (tt == 16);
        const size_t tb = ctx ? (size_t)b * CTXL * DM : ((size_t)b * SEQ + (size_t)tt * 256) * DM;
        const float* s = (ctx ? srcC : srcL) + tb; float* d = (ctx ? dstC : dstL) + tb;
        const int col0 = u.pn * BM + wc * 32 + 8 * fq;
        const float* gate = mod + (size_t)(ctx ? 16 : b) * NMOD + slot * DM + col0;
        f32x4 gv[2][2];
#pragma unroll
        for (int bj = 0; bj < 2; ++bj)
#pragma unroll
            for (int n = 0; n < 2; ++n) { gv[bj][n] = *(const f32x4*)(gate + bj * HALF + n * 4); if (colscale) gv[bj][n] = gv[bj][n] * *(const f32x4*)(colscale + col0 + bj * HALF + n * 4); }
        f32x4 gs[2][2];
        if (Hout != nullptr) { const float* sc4 = hscale + (size_t)(ctx ? 16 : b) * NMOD + col0;
#pragma unroll
            for (int bj = 0; bj < 2; ++bj)
#pragma unroll
                for (int n = 0; n < 2; ++n) gs[bj][n] = *(const f32x4*)(gamma + col0 + bj * HALF + n * 4) * (*(const f32x4*)(sc4 + bj * HALF + n * 4) + 1.0f); }
#pragma unroll
        for (int ai = 0; ai < 2; ++ai)
#pragma unroll
            for (int m = 0; m < 4; ++m) { const size_t off = (size_t)(ai * HALF + wr * 64 + m * 16 + fr) * DM + col0; float ssq = 0.f; const size_t grow = (size_t)u.pm * BM + (ai * HALF + wr * 64 + m * 16 + fr);
#pragma unroll
                for (int bj = 0; bj < 2; ++bj) { f32x4 hq2[2];
#pragma unroll
                    for (int n = 0; n < 2; ++n) {
                        if constexpr (ATOMIC) { const f32x4 v = gv[bj][n] * acc[ai][bj][m][n]; float* p = d + off + bj * HALF + n * 4;
#pragma unroll
                            for (int e = 0; e < 4; ++e) (void)__hip_atomic_fetch_add(p + e, v[e], __ATOMIC_RELAXED, __HIP_MEMORY_SCOPE_AGENT); }
                        else { f32x4 bs = *(const f32x4*)(s + off + bj * HALF + n * 4);
                            if (pend != nullptr && ctx) { const float* pp = pend + tb + off + bj * HALF + n * 4; const f32x4 pg = *(const f32x4*)(pgate + col0 + bj * HALF + n * 4);
                                bs += pg * ((*(const f32x4*)(pp) + *(const f32x4*)(pp + (size_t)NB * CTXL * DM)) + (*(const f32x4*)(pp + (size_t)2 * NB * CTXL * DM) + *(const f32x4*)(pp + (size_t)3 * NB * CTXL * DM))); }
                            const f32x4 xn = bs + gv[bj][n] * acc[ai][bj][m][n]; *(f32x4*)(d + off + bj * HALF + n * 4) = xn;
                            if (Hout != nullptr) { ssq += (xn[0] * xn[0] + xn[1] * xn[1]) + (xn[2] * xn[2] + xn[3] * xn[3]); hq2[n] = xn * gs[bj][n];
                                if (n == 1) *(u32x4*)(Hout + grow * DM + col0 + bj * HALF) = pack8(hq2[0], hq2[1]); } } } }
                if (Hout != nullptr) { ssq += __shfl_xor(ssq, 16); ssq += __shfl_xor(ssq, 32); if (fq == 0) (void)__hip_atomic_fetch_add(rowsq + grow, ssq, __ATOMIC_RELAXED, __HIP_MEMORY_SCOPE_AGENT); }
                if (m == 3) asm volatile("" ::: "memory"); }
    }
};

typedef EpiResidT<false> EpiResid;
struct EpiPartial {
    static constexpr bool PERM = false, AFTER_DRAIN = false;
    float* part; int kq_len;
    __device__ __forceinline__ void operator()(const f32x4 (&acc)[2][2][4][2], const Unit& u, int wr_, int wc_, int fr_, int fq_) const {
        int wr = wr_, wc = wc_, fr = fr_, fq = fq_; asm volatile("" : "+s"(wr), "+s"(wc), "+v"(fr), "+v"(fq));
        const int b = u.pm / 17; const int kq = u.kofs / kq_len; const int col0 = u.pn * BM + wc * 32 + 4 * fq;
        float* d = part + ((size_t)kq * NB * CTXL + (size_t)b * CTXL) * DM + col0;
#pragma unroll
        for (int ai = 0; ai < 2; ++ai)
#pragma unroll
            for (int m = 0; m < 4; ++m) { const size_t off = (size_t)(ai * HALF + wr * 64 + m * 16 + fr) * DM;
#pragma unroll
                for (int bj = 0; bj < 2; ++bj)
#pragma unroll
                    for (int n = 0; n < 2; ++n) *(f32x4*)(d + off + bj * HALF + n * 16) = acc[ai][bj][m][n]; }
    }
};

struct EpiQKV {
    static constexpr bool PERM = true, AFTER_DRAIN = false;
    bf16* Q; bf16* Kb; bf16* Vb; const float* qg; const float* kg; const float* rope;
    __device__ __forceinline__ void operator()(const f32x4 (&acc)[2][2][4][2], const Unit& u, int wr_, int wc_, int fr_, int fq_) const {
        int wr = wr_, wc = wc_, fr = fr_, fq = fq_; asm volatile("" : "+s"(wr), "+s"(wc), "+v"(fr), "+v"(fq));
        const int tt = u.pm % 17; const int row0 = u.pm * BM + wr * 64 + fr;
        if (u.pn == 5) {
#pragma unroll
            for (int ai = 0; ai < 2; ++ai)
#pragma unroll
                for (int m = 0; m < 4; ++m) { bf16* rp = Vb + (size_t)(row0 + ai * HALF + m * 16) * 256 + wc * 64 + 8 * fq;
#pragma unroll
                    for (int bj = 0; bj < 2; ++bj) *(u32x4*)(rp + 32 * bj) = pack8(acc[ai][bj][m][0], acc[ai][bj][m][1]); }
            return;
        }
        const bool isq = u.pn < 4; const float* gain = isq ? qg : kg; const float osc = isq ? QSCALE : 1.0f;
        f32x4 g[2][2];
#pragma unroll
        for (int bj = 0; bj < 2; ++bj)
#pragma unroll
            for (int n = 0; n < 2; ++n) g[bj][n] = *(const f32x4*)(gain + 32 * bj + 8 * fq + 4 * n) * osc;
#pragma unroll
        for (int ai = 0; ai < 2; ++ai)
#pragma unroll
            for (int m = 0; m < 4; ++m) {
                float ss = 0.f;
#pragma unroll
                for (int bj = 0; bj < 2; ++bj)
#pragma unroll
                    for (int n = 0; n < 2; ++n) { const f32x4 x = acc[ai][bj][m][n]; ss += (x[0] * x[0] + x[1] * x[1]) + (x[2] * x[2] + x[3] * x[3]); }
                ss += __shfl_xor(ss, 16); ss += __shfl_xor(ss, 32);
                const float rinv = __builtin_amdgcn_rsqf(ss * (1.0f / 64.0f) + RMS_EPS);
                const int rl = ai * HALF + wr * 64 + m * 16 + fr;
                const int t = tt * 256 + rl;
                const float* rp = rope + (size_t)t * 64 + 8 * fq;
                f32x4 o1[2], o2[2];
#pragma unroll
                for (int n = 0; n < 2; ++n) { const f32x4 c = *(const f32x4*)(rp + 4 * n), s = *(const f32x4*)(rp + 32 + 4 * n);
                    const f32x4 x1 = acc[ai][0][m][n] * rinv * g[0][n], x2 = acc[ai][1][m][n] * rinv * g[1][n];
                    o1[n] = x1 * c - x2 * s; o2[n] = x1 * s + x2 * c; }
                const size_t grow = (size_t)(u.pm * BM + rl);
                bf16* dst = isq ? Q + grow * DM + (u.pn * 4 + wc) * 64 + 8 * fq : Kb + grow * 256 + wc * 64 + 8 * fq;
                *(u32x4*)(dst) = pack8(o1[0], o1[1]); *(u32x4*)(dst + 32) = pack8(o2[0], o2[1]);
            }
    }
};

struct EpiRwkv1 {
    static constexpr bool PERM = true, AFTER_DRAIN = false;
    bf16* Oo; bf16* KK; bf16* P; const float* k_k; int pn_base;
    __device__ __forceinline__ void operator()(const f32x4 (&acc)[2][2][4][2], const Unit& u, int wr_, int wc_, int fr_, int fq_) const {
        int wr = wr_, wc = wc_, fr = fr_, fq = fq_; asm volatile("" : "+s"(wr), "+s"(wc), "+v"(fr), "+v"(fq));
        const int row0 = u.pm * BM + wr * 64 + fr; const int pn = u.pn + pn_base;
        if (pn >= 12) {
            const int ob = 256 * (pn - 12) + 64 * wc + 8 * fq;
#pragma unroll
            for (int ai = 0; ai < 2; ++ai)
#pragma unroll
                for (int m = 0; m < 4; ++m) { bf16* rp = P + (size_t)(row0 + ai * HALF + m * 16) * 512 + ob;
#pragma unroll
                    for (int bj = 0; bj < 2; ++bj) { const int o = ob + 32 * bj; f32x4 v0 = acc[ai][bj][m][0], v1 = acc[ai][bj][m][1];
                        if (o < 128) {
#pragma unroll
                            for (int e = 0; e < 4; ++e) { v0[e] = 2.0f * fsigmoid(2.0f * v0[e]) - 1.0f; v1[e] = 2.0f * fsigmoid(2.0f * v1[e]) - 1.0f; }
                        } else if (o < 256) {
                        } else if (o < 416) {
#pragma unroll
                            for (int e = 0; e < 4; ++e) { v0[e] = fsigmoid(v0[e]); v1[e] = fsigmoid(v1[e]); }
                        } else { v0 = (f32x4){0.f, 0.f, 0.f, 0.f}; v1 = v0; }
                        *(u32x4*)(rp + 32 * bj) = pack8(v0, v1); } }
            return;
        }
        const int sel = pn >> 2; const int cb = (pn & 3) * 256 + wc * 64 + 8 * fq;
        bf16* O = Oo;
        f32x4 kkg[2][2];
        if (sel == 1) {
#pragma unroll
            for (int bj = 0; bj < 2; ++bj)
#pragma unroll
                for (int n = 0; n < 2; ++n) kkg[bj][n] = *(const f32x4*)(k_k + cb + 32 * bj + 4 * n);
        }
#pragma unroll
        for (int ai = 0; ai < 2; ++ai)
#pragma unroll
            for (int m = 0; m < 4; ++m) { const size_t ro = (size_t)(row0 + ai * HALF + m * 16) * DM + cb;
#pragma unroll
                for (int bj = 0; bj < 2; ++bj) *(u32x4*)(O + ro + 32 * bj) = pack8(acc[ai][bj][m][0], acc[ai][bj][m][1]);
                if (sel == 1) {
                    f32x4 q[2][2]; float ss = 0.f;
#pragma unroll
                    for (int bj = 0; bj < 2; ++bj)
#pragma unroll
                        for (int n = 0; n < 2; ++n) { q[bj][n] = acc[ai][bj][m][n] * kkg[bj][n]; const f32x4 x = q[bj][n]; ss += (x[0] * x[0] + x[1] * x[1]) + (x[2] * x[2] + x[3] * x[3]); }
                    ss += __shfl_xor(ss, 16); ss += __shfl_xor(ss, 32);
                    const float rn = 1.0f / fmaxf(sqrtf(ss), 1e-12f);
#pragma unroll
                    for (int bj = 0; bj < 2; ++bj) *(u32x4*)(KK + ro + 32 * bj) = pack8(q[bj][0] * rn, q[bj][1] * rn);
                }
                if (m & 1) asm volatile("" ::: "memory"); }
    }
};

struct EpiFinish {
    static constexpr bool PERM = true, AFTER_DRAIN = false;
    const bf16* Y0; const bf16* Y1; const bf16* Vb; const float* bonus; const float* ln_g; const float* ln_b; bf16* Z;
    __device__ __forceinline__ void operator()(const f32x4 (&acc)[2][2][4][2], const Unit& u, int wr_, int wc_, int fr_, int fq_) const {
        int wr = wr_, wc = wc_, fr = fr_, fq = fq_; asm volatile("" : "+s"(wr), "+s"(wc), "+v"(fr), "+v"(fq));
        const int row0 = u.pm * BM + wr * 64 + fr; const int head = u.pn * 4 + wc; const int cb = head * 64 + 8 * fq;
#pragma unroll
        for (int ai = 0; ai < 2; ++ai)
#pragma unroll
            for (int m = 0; m < 4; ++m) { const size_t grow = (size_t)(row0 + ai * HALF + m * 16); const size_t ro = grow * DM + cb;
                float sum = 0.f, sq = 0.f;
#pragma unroll
                for (int bj = 0; bj < 2; ++bj) { f32x4 a0, a1, b0, b1; unpack8(*(const u32x4*)(Y0 + ro + 32 * bj), a0, a1); unpack8(*(const u32x4*)(Y1 + ro + 32 * bj), b0, b1);
                    a0 += b0; a1 += b1; sum += (a0[0] + a0[1]) + (a0[2] + a0[3]) + (a1[0] + a1[1]) + (a1[2] + a1[3]);
                    sq += (a0[0] * a0[0] + a0[1] * a0[1]) + (a0[2] * a0[2] + a0[3] * a0[3]) + (a1[0] * a1[0] + a1[1] * a1[1]) + (a1[2] * a1[2] + a1[3] * a1[3]); }
                sum += __shfl_xor(sum, 16); sq += __shfl_xor(sq, 16); sum += __shfl_xor(sum, 32); sq += __shfl_xor(sq, 32);
                const float mean = sum * (1.0f / 64.0f); const float var = fmaxf(sq * (1.0f / 64.0f) - mean * mean, 0.f);
                const float rstd = __builtin_amdgcn_rsqf(var + GN_EPS_F);
                const f32x2 bo = *(const f32x2*)(bonus + (grow * 16 + head) * 2); const float bsum = bo.x + bo.y;

#pragma unroll
                for (int bj = 0; bj < 2; ++bj) { f32x4 a0, a1, b0, b1, v0, v1; unpack8(*(const u32x4*)(Y0 + ro + 32 * bj), a0, a1); unpack8(*(const u32x4*)(Y1 + ro + 32 * bj), b0, b1); unpack8(*(const u32x4*)(Vb + ro + 32 * bj), v0, v1);
                    const f32x4 lg0 = *(const f32x4*)(ln_g + cb + 32 * bj), lg1 = *(const f32x4*)(ln_g + cb + 32 * bj + 4), lb0 = *(const f32x4*)(ln_b + cb + 32 * bj), lb1 = *(const f32x4*)(ln_b + cb + 32 * bj + 4);
                    const f32x4 z0 = ((a0 + b0 - mean) * rstd * lg0 + lb0 + v0 * bsum) * acc[ai][bj][m][0];
                    const f32x4 z1 = ((a1 + b1 - mean) * rstd * lg1 + lb1 + v1 * bsum) * acc[ai][bj][m][1];
                    *(u32x4*)(Z + ro + 32 * bj) = pack8(z0, z1);
                    if (bj == 1) asm volatile("" ::: "memory"); }
            }
    }
};

struct WJob { const float* src; const float* kscale; bf16* dst; int ld_src, k_src, ldt, row_off, col_base, k_off, nblk, mode; };
constexpr int NJOBS = 33;
struct Args { const float* in[32]; float* out; unsigned char* ws; WJob job[NJOBS]; int istart[NJOBS + 2]; };

struct Frame { LAS unsigned char* lds; int tid, lane, wave, vcu, G; };

__device__ __forceinline__ int perm256(int o) { return (o & ~255) | (((o >> 5) & 1) << 7) | (((o >> 6) & 3) << 5) | (o & 31); }

__device__ __forceinline__ void wconv_item(const __attribute__((address_space(4))) WJob* Jp, int item, LAS float* scr, int lane) {
    WJob J; J.src = Jp->src; J.kscale = Jp->kscale; J.dst = Jp->dst; J.ld_src = Jp->ld_src; J.k_src = Jp->k_src; J.ldt = Jp->ldt; J.row_off = Jp->row_off; J.col_base = Jp->col_base; J.k_off = Jp->k_off; J.nblk = Jp->nblk; J.mode = Jp->mode;
    const int kb = item / J.nblk, nb = item - kb * J.nblk, k0 = 64 * kb, n0 = 32 * nb;
#pragma unroll 8
    for (int i = 0; i < 32; ++i) { const int kk = 2 * i + (lane >> 5), k = k0 + kk; float v = 0.f;
        if (J.src != nullptr && k < J.k_src) { v = J.src[(size_t)k * J.ld_src + n0 + (lane & 31)]; if (J.kscale) v *= J.kscale[k]; }
        scr[kk * 33 + (lane & 31)] = v; }
    asm volatile("s_waitcnt lgkmcnt(0)" ::: "memory");
    const int c = lane & 7;
#pragma unroll
    for (int j = 0; j < 4; ++j) { const int n = (lane >> 3) + 8 * j; const LAS float* s = scr + (8 * c) * 33 + n;
        u32x4 o; o.x = cvt_pk_bf16(s[0 * 33], s[1 * 33]); o.y = cvt_pk_bf16(s[2 * 33], s[3 * 33]); o.z = cvt_pk_bf16(s[4 * 33], s[5 * 33]); o.w = cvt_pk_bf16(s[6 * 33], s[7 * 33]);
        const int oc = J.col_base + n0 + n; const int drow = J.row_off + (J.mode ? perm256(oc) : oc);
        *(u32x4*)(J.dst + (size_t)drow * J.ldt + J.k_off + k0 + 8 * c) = o; }
    asm volatile("s_waitcnt lgkmcnt(0)" ::: "memory");
}

__device__ __forceinline__ void p0a(Frame& F, const __attribute__((address_space(4))) Args* A) {
    LAS float* sl = (LAS float*)F.lds;
    const float* c = A->in[1]; const float* cc = A->in[3];
    for (int idx = F.tid; idx < 17 * DM; idx += NWAVES * 64) { const int r = idx >> 10, k = idx & 1023; const float x = r < 16 ? c[r * DM + k] : cc[k]; sl[idx] = x * fsigmoid(x); }
    __syncthreads();
    const int gw = F.vcu * NWAVES + F.wave, NGW = F.G * NWAVES;
    float* modp = (float*)(A->ws + WS_MODP);
    for (int it = gw; it < 4 * 96 * 4; it += NGW) {
        const int l = it / 384, rem = it - l * 384, cgp = rem >> 2, kq = rem & 3, col = cgp * 64 + F.lane;
        const float* w = A->in[4] + ((size_t)l * DM + kq * 256) * NMOD + col;
        float acc[17];
#pragma unroll
        for (int r = 0; r < 17; ++r) acc[r] = 0.f;
#pragma unroll 4
        for (int k4 = 0; k4 < 256; k4 += 4) {
            const float w0 = w[(size_t)(k4 + 0) * NMOD], w1 = w[(size_t)(k4 + 1) * NMOD], w2 = w[(size_t)(k4 + 2) * NMOD], w3 = w[(size_t)(k4 + 3) * NMOD];
#pragma unroll
            for (int r = 0; r < 17; ++r) { const f32x4 sv = *(const LAS f32x4*)(sl + r * DM + kq * 256 + k4); acc[r] += (sv[0] * w0 + sv[1] * w1) + (sv[2] * w2 + sv[3] * w3); }
        }
#pragma unroll
        for (int r = 0; r < 17; ++r) modp[((size_t)(kq * 4 + l) * 17 + r) * NMOD + col] = acc[r];
    }
    __syncthreads();
    LAS float* scr = (LAS float*)(F.lds + F.wave * 16384);
    const int total = A->istart[NJOBS];
    for (int it = gw; it < total; it += NGW) {
        int j = 0;
        while (it >= A->istart[j + 1]) ++j;
        wconv_item(&A->job[j], it - A->istart[j], scr, F.lane);
    }
    { const f32x4* cs = (const f32x4*)A->in[2]; f32x4* cd = (f32x4*)(A->ws + WS_CTX);
      for (int idx = (F.vcu * NWAVES * 64) + F.tid; idx < NB * CTXL * DM / 4; idx += F.G * NWAVES * 64) cd[idx] = cs[idx]; }
    float* rope = (float*)(A->ws + WS_ROPE);
    for (int idx = (F.vcu * NWAVES * 64) + F.tid; idx < TPB * 32; idx += F.G * NWAVES * 64) {
        const int t = idx >> 5, p = idx & 31; float cs = 1.f, sn = 0.f;
        if (t < SEQ) { const int f = p & 15; const int pos = p < 16 ? (t >> 6) : (t & 63);
            const float inv = __builtin_amdgcn_exp2f(-(float)f * (13.287712379549449f / 16.0f)); const float ang = (float)pos * inv;
            float x = ang * 0.15915494309189535f; x = x - floorf(x); cs = __builtin_amdgcn_cosf(x); sn = __builtin_amdgcn_sinf(x); }
        rope[(size_t)t * 64 + p] = cs; rope[(size_t)t * 64 + 32 + p] = sn;
    }
}
__device__ __forceinline__ void p0b(Frame& F, const __attribute__((address_space(4))) Args* A) {
    const float* modp = (const float*)(A->ws + WS_MODP); float* mod = (float*)(A->ws + WS_MOD); const float* bm = A->in[5];
    const int n = 4 * 17 * NMOD;
    for (int idx = (F.vcu * NWAVES * 64) + F.tid; idx < n; idx += F.G * NWAVES * 64) {
        const int l = idx / (17 * NMOD), rem = idx - l * 17 * NMOD, col = rem % NMOD;
        float s = bm[l * NMOD + col];
#pragma unroll
        for (int kq = 0; kq < 4; ++kq) s += modp[(size_t)(kq * 4 + l) * 17 * NMOD + rem];
        mod[idx] = s;
    }
}

__device__ __forceinline__ void p0c(Frame& F, const __attribute__((address_space(4))) Args* A) {
    LAS float* sl = (LAS float*)F.lds; LAS float* red = (LAS float*)(F.lds + 17 * DM * 4);
    const float* mod = (const float*)(A->ws + WS_MOD); float* swt = (float*)(A->ws + WS_SW);
    for (int it = F.vcu; it < 4 * 64; it += F.G) {
        const int l = it >> 6, cgp = it & 63;
        for (int idx = F.tid; idx < 17 * DM; idx += NWAVES * 64) sl[idx] = mod[((size_t)l * 17 + (idx >> 10)) * NMOD + 3 * DM + (idx & 1023)];
        __syncthreads();
        const float* w = A->in[8] + ((size_t)l * DM + F.wave * 128) * FF + cgp * 64 + F.lane;
        float acc[17];
#pragma unroll
        for (int r = 0; r < 17; ++r) acc[r] = 0.f;
#pragma unroll 4
        for (int k4 = 0; k4 < 128; k4 += 4) {
            const float w0 = w[(size_t)(k4 + 0) * FF], w1 = w[(size_t)(k4 + 1) * FF], w2 = w[(size_t)(k4 + 2) * FF], w3 = w[(size_t)(k4 + 3) * FF];
#pragma unroll
            for (int r = 0; r < 17; ++r) { const f32x4 sv = *(const LAS f32x4*)(sl + r * DM + F.wave * 128 + k4); acc[r] += (sv[0] * w0 + sv[1] * w1) + (sv[2] * w2 + sv[3] * w3); }
        }
#pragma unroll
        for (int r = 0; r < 17; ++r) red[(F.wave * 17 + r) * 64 + F.lane] = acc[r];
        __syncthreads();
        for (int idx = F.tid; idx < 17 * 64; idx += NWAVES * 64) { float t = 0.f;
#pragma unroll
            for (int wv = 0; wv < 8; ++wv) t += red[wv * 17 * 64 + idx];
            swt[((size_t)l * 17 + (idx >> 6)) * FF + cgp * 64 + (idx & 63)] = t; }
        __syncthreads();
    }
}

struct LnPar { f32x4 g[4], sc[4], sh[4]; };
__device__ __forceinline__ void ln_load_par(LnPar& P, const float* gamma, const float* modrow, int slot, int lane) {
#pragma unroll
    for (int j = 0; j < 4; ++j) { const int c = 4 * lane + 256 * j; P.g[j] = *(const f32x4*)(gamma + c); P.sh[j] = *(const f32x4*)(modrow + slot * DM + c); P.sc[j] = *(const f32x4*)(modrow + (slot + 1) * DM + c) + 1.0f; P.g[j] = P.g[j] * P.sc[j]; }
}
__device__ __forceinline__ void ln_row(f32x4 (&h)[4], const float* xrow, const LnPar& P, int lane, const float* prow = nullptr, const float* pgate = nullptr) {
    float ss = 0.f;
#pragma unroll
    for (int j = 0; j < 4; ++j) { h[j] = *(const f32x4*)(xrow + 4 * lane + 256 * j);
        if (prow != nullptr) { const float* pp = prow + 4 * lane + 256 * j; h[j] += *(const f32x4*)(pgate + 4 * lane + 256 * j) * ((*(const f32x4*)(pp) + *(const f32x4*)(pp + (size_t)NB * CTXL * DM)) + (*(const f32x4*)(pp + (size_t)2 * NB * CTXL * DM) + *(const f32x4*)(pp + (size_t)3 * NB * CTXL * DM))); } ss += (h[j][0] * h[j][0] + h[j][1] * h[j][1]) + (h[j][2] * h[j][2] + h[j][3] * h[j][3]); }
    const float rinv = __builtin_amdgcn_rsqf(wave_sum(ss) * (1.0f / DM) + RMS_EPS);
#pragma unroll
    for (int j = 0; j < 4; ++j) h[j] = h[j] * rinv * P.g[j] + P.sh[j];
}
__device__ __forceinline__ const float* prow_ptr(const float* pend, int b, int t) { return (pend != nullptr && t >= SEQ) ? pend + ((size_t)b * CTXL + (t - SEQ)) * DM : nullptr; }
__device__ __forceinline__ const float* xrow_ptr(const float* L, const float* C, int b, int t) { return t < SEQ ? L + ((size_t)b * SEQ + t) * DM : C + ((size_t)b * CTXL + (t - SEQ)) * DM; }
__device__ __forceinline__ void st_row_bf16(bf16* orow, const f32x4 (&h)[4], int lane) {
#pragma unroll
    for (int j = 0; j < 4; ++j) { u32x2 w; w.x = cvt_pk_bf16(h[j][0], h[j][1]); w.y = cvt_pk_bf16(h[j][2], h[j][3]); *(u32x2*)(orow + 4 * lane + 256 * j) = w; }
}
__device__ __forceinline__ void ln_phase(Frame& F, const float* xl, const float* xc, const float* gamma, const float* modL, int slot, bf16* H, const float* pend = nullptr, const float* pgate = nullptr) {
    const int gw = F.vcu * NWAVES + F.wave, NGW = F.G * NWAVES;
    for (int run = gw; run < MROWS / 8; run += NGW) {
        const int row0 = run * 8, b = row0 / TPB, t0 = row0 - b * TPB;
        LnPar P; ln_load_par(P, gamma, modL + (size_t)(t0 < SEQ ? b : 16) * NMOD, slot, F.lane);
#pragma unroll 2
        for (int i = 0; i < 8; ++i) {
            f32x4 h[4]; ln_row(h, xrow_ptr(xl, xc, b, t0 + i), P, F.lane, prow_ptr(pend, b, t0 + i), pgate);
            st_row_bf16(H + (size_t)(row0 + i) * DM, h, F.lane);
        }
    }
}
__device__ __forceinline__ void hn_row(f32x4 (&h)[4], const bf16* hrow, float rsq, const LnPar& P, int lane) {
    const float rinv = __builtin_amdgcn_rsqf(rsq * (1.0f / DM) + RMS_EPS);
#pragma unroll
    for (int j = 0; j < 4; ++j) { const u32x2 w = *(const u32x2*)(hrow + 4 * lane + 256 * j); h[j] = (f32x4){bflo(w.x), bfhi(w.x), bflo(w.y), bfhi(w.y)} * rinv + P.sh[j]; }
}
__device__ __forceinline__ void ln_rwkv_phase(Frame& F, const bf16* Hn, const float* rq, const float* gamma, const float* modL, bf16* XR, bf16* XK, bf16* XV, bf16* A1, const float* mu) {
    const int gw = F.vcu * NWAVES + F.wave, NGW = F.G * NWAVES;
    for (int run = gw; run < MROWS / 8; run += NGW) {
        const int row0 = run * 8, b = row0 / TPB, t0 = row0 - b * TPB;
        const int slo = t0 < SEQ ? 0 : SEQ, shi = t0 < SEQ ? SEQ : TPB;
        LnPar P; ln_load_par(P, gamma, modL + (size_t)(t0 < SEQ ? b : 16) * NMOD, 0, F.lane);
        f32x4 mur[4], muk[4], muv[4];
#pragma unroll
        for (int j = 0; j < 4; ++j) { const int c = 4 * F.lane + 256 * j; mur[j] = *(const f32x4*)(mu + c); muk[j] = *(const f32x4*)(mu + 2 * DM + c); muv[j] = *(const f32x4*)(mu + 3 * DM + c); }
        f32x4 prev[4], cur[4], nxt[4];
        if (t0 > slo) hn_row(prev, Hn + (size_t)(row0 - 1) * DM, rq[row0 - 1], P, F.lane);
        else {
#pragma unroll
            for (int j = 0; j < 4; ++j) prev[j] = (f32x4){0.f, 0.f, 0.f, 0.f}; }
        hn_row(cur, Hn + (size_t)row0 * DM, rq[row0], P, F.lane);
        for (int i = 0; i < 8; ++i) {
            const int t = t0 + i;
            if (t + 1 < shi) hn_row(nxt, Hn + (size_t)(row0 + i + 1) * DM, rq[row0 + i + 1], P, F.lane);
            else {
#pragma unroll
                for (int j = 0; j < 4; ++j) nxt[j] = (f32x4){0.f, 0.f, 0.f, 0.f}; }
            f32x4 xx[4];
#pragma unroll
            for (int j = 0; j < 4; ++j) xx[j] = (prev[j] + nxt[j]) * 0.5f - cur[j];
            bf16* o = A1 + (size_t)(row0 + i) * 2048;
            st_row_bf16(o, cur, F.lane); st_row_bf16(o + DM, xx, F.lane);
            { f32x4 t4[4];
#pragma unroll
              for (int j = 0; j < 4; ++j) t4[j] = cur[j] + xx[j] * mur[j];
              st_row_bf16(XR + (size_t)(row0 + i) * DM, t4, F.lane);
#pragma unroll
              for (int j = 0; j < 4; ++j) t4[j] = cur[j] + xx[j] * muk[j];
              st_row_bf16(XK + (size_t)(row0 + i) * DM, t4, F.lane);
#pragma unroll
              for (int j = 0; j < 4; ++j) t4[j] = cur[j] + xx[j] * muv[j];
              st_row_bf16(XV + (size_t)(row0 + i) * DM, t4, F.lane); }
#pragma unroll
            for (int j = 0; j < 4; ++j) { prev[j] = cur[j]; cur[j] = nxt[j]; }
        }
    }
}
__device__ __forceinline__ void pool_phase(Frame& F, const bf16* H, const float* rq, bf16* PL) {
    const int gt = F.vcu * NWAVES * 64 + F.tid, NT_ = F.G * NWAVES * 64;
    for (int it = gt; it < (MROWS / 16) * 128; it += NT_) {
        const int run = it >> 7, ch = it & 127, half = 1 << (ch >> 5);
        const int row0 = run * 16, b = row0 / TPB, t0 = row0 - b * TPB;
        const int slo = t0 < SEQ ? 0 : SEQ, shi = t0 < SEQ ? SEQ : TPB;
        const bf16* hb = H + (size_t)b * TPB * DM + ch * 8;
        const float* rqb = rq + (size_t)b * TPB;
#define LDROW(r_, a_, c_) do { unpack8(*(const u32x4*)(hb + (size_t)(r_) * DM), a_, c_); const float ri_ = __builtin_amdgcn_rsqf(rqb[r_] * (1.0f / DM) + RMS_EPS); a_ = a_ * ri_; c_ = c_ * ri_; } while (0)
        f32x4 s0 = (f32x4){0.f, 0.f, 0.f, 0.f}, s1 = s0;
        { const int lo = max(t0 - half, slo), hi = min(t0 + half, shi);
          for (int r = lo; r < hi; ++r) { f32x4 a, c2; LDROW(r, a, c2); s0 += a; s1 += c2; } }
        for (int i = 0; i < 16; ++i) {
            const int t = t0 + i; const int lo = max(t - half, slo), hi = min(t + half, shi);
            f32x4 a, c2; LDROW(t, a, c2);
            const float ic = 1.0f / (float)(hi - lo);
            *(u32x4*)(PL + (size_t)(row0 + i) * DM + ch * 8) = pack8(s0 * ic - a, s1 * ic - c2);
            if (t + half < shi) { f32x4 p, q; LDROW(t + half, p, q); s0 += p; s1 += q; }
            if (t - half >= slo) { f32x4 p, q; LDROW(t - half, p, q); s0 -= p; s1 -= q; }
        }
    }
#undef LDROW
}

__device__ __forceinline__ float dpp_x1(float x) { return __int_as_float(__builtin_amdgcn_update_dpp(0, __float_as_int(x), 0xB1, 0xF, 0xF, true)); }
__device__ __forceinline__ float dpp_x2(float x) { return __int_as_float(__builtin_amdgcn_update_dpp(0, __float_as_int(x), 0x4E, 0xF, 0xF, true)); }
__device__ __forceinline__ float dpp_hm(float x) { return __int_as_float(__builtin_amdgcn_update_dpp(0, __float_as_int(x), 0x141, 0xF, 0xF, true)); }
__device__ __forceinline__ float fma_s(float a, float b, float c) { float d; asm("v_fma_f32 %0, %1, %2, %3" : "=v"(d) : "v"(a), "v"(b), "v"(c)); return d; }
__device__ __forceinline__ float mul_s(float a, float b) { float d; asm("v_mul_f32_e32 %0, %1, %2" : "=v"(d) : "v"(a), "v"(b)); return d; }
__device__ __forceinline__ float red8(float x) { x += dpp_x1(x); x += dpp_x2(x); x += dpp_hm(x); return x; }
__device__ __forceinline__ int scan_tok(int dir, int s) { return dir ? (TPB - 1 - s) : (s < CTXL ? SEQ + s : s - CTXL); }
constexpr int NCHUNK = TPB / 16;
#ifndef PSUB
#define PSUB 0
#endif
#define PSUB_T0(x) unsigned long long ps0_##x = (PSUB & (x)) ? __builtin_amdgcn_s_memrealtime() : 0ull
#define PSUB_T1(x) do { if (PSUB & (x)) psum_ += __builtin_amdgcn_s_memrealtime() - ps0_##x; } while (0)
#define PSUB_SPIN() do { if (PSUB) { const unsigned long long t1_ = __builtin_amdgcn_s_memrealtime(); while (__builtin_amdgcn_s_memrealtime() - t1_ < psum_) __builtin_amdgcn_s_sleep(8); } } while (0)

__device__ __forceinline__ void scan_phase(Frame& F, const bf16* Rg, const bf16* Kg, const bf16* KKg, const bf16* Vg, const bf16* P, bf16* Y0, bf16* Y1, float* bonus,
                                           const float* w0, const float* w2, const float* a0, const float* a2, const float* k_a, const float* r_k) {
    LAS float* L = (LAS float*)F.lds;
    const int lane = F.lane, dir = F.wave >> 2, wq = F.wave & 3, vg = lane >> 3, kg = lane & 7, fr = lane & 15, fq = lane >> 4;
    const int mm = wq >> 1, cth = wq & 1;
    for (int bh = F.vcu; bh < NB * 16; bh += F.G) {
        const int b = bh >> 4, h = bh & 15; const size_t rb = (size_t)b * TPB;
        const float* W2 = (mm == 0 ? w2 : a2) + (size_t)dir * 64 * DM + h * 64;
        bf16x8 Bf[2][2]; float bias[2], ka[2];
#pragma unroll
        for (int ct2 = 0; ct2 < 2; ++ct2) { const int j = 16 * (2 * cth + ct2) + fr;
            bias[ct2] = (mm == 0 ? w0 : a0)[dir * DM + h * 64 + j]; ka[ct2] = k_a[h * 64 + j];
#pragma unroll
            for (int ks = 0; ks < 2; ++ks) { const float* wp = W2 + (size_t)(32 * ks + 8 * fq) * DM + j;
                u32x4 pk; pk.x = cvt_pk_bf16(wp[0], wp[DM]); pk.y = cvt_pk_bf16(wp[2 * DM], wp[3 * DM]); pk.z = cvt_pk_bf16(wp[4 * DM], wp[5 * DM]); pk.w = cvt_pk_bf16(wp[6 * DM], wp[7 * DM]);
                Bf[ct2][ks] = __builtin_bit_cast(bf16x8, pk); } }
        f32x4 rkb[4];
#pragma unroll
        for (int q4 = 0; q4 < 4; ++q4) rkb[q4] = *(const f32x4*)(r_k + h * 64 + 16 * (lane & 3) + 4 * q4);
        f32x2 S[2][4];
#pragma unroll
        for (int rr = 0; rr < 2; ++rr)
#pragma unroll
            for (int jp = 0; jp < 4; ++jp) S[rr][jp] = (f32x2){0.f, 0.f};
        unsigned long long psum_ = 0ull; (void)psum_;
        bf16* Yd = dir ? Y1 : Y0;
        const bf16* srcA = mm == 0 ? Rg : Kg; const bf16* srcB = mm == 0 ? Vg : KKg;
        bf16x8 Pa[2]; unsigned short ga[8], gb[8];
#define SC_LOAD(c) do { const int s0_ = 16 * (c); const size_t ra_ = rb + scan_tok(dir, s0_ + fr); \
        _Pragma("unroll") for (int ks = 0; ks < 2; ++ks) Pa[ks] = *(const bf16x8*)(P + ra_ * 512 + 128 * mm + 64 * dir + 32 * ks + 8 * fq); \
        _Pragma("unroll") for (int e = 0; e < 4; ++e) { const size_t ri_ = (rb + scan_tok(dir, s0_ + 4 * fq + e)) * DM + h * 64 + 32 * cth + fr; \
            _Pragma("unroll") for (int ct2 = 0; ct2 < 2; ++ct2) { ga[e * 2 + ct2] = srcA[ri_ + 16 * ct2]; gb[e * 2 + ct2] = srcB[ri_ + 16 * ct2]; } } } while (0)
#define SC_COMPUTE(buf) do { LAS float* Lb_ = L + ((buf) * 2 + dir) * 6 * 1024; \
        _Pragma("unroll") for (int ct2 = 0; ct2 < 2; ++ct2) { f32x4 D_ = (f32x4){0.f, 0.f, 0.f, 0.f}; \
            D_ = __builtin_amdgcn_mfma_f32_16x16x32_bf16(Pa[0], Bf[ct2][0], D_, 0, 0, 0); D_ = __builtin_amdgcn_mfma_f32_16x16x32_bf16(Pa[1], Bf[ct2][1], D_, 0, 0, 0); \
            _Pragma("unroll") for (int e = 0; e < 4; ++e) { const int idx_ = (4 * fq + e) * 64 + 16 * (2 * cth + ct2) + fr; const float xa_ = bf2f(ga[e * 2 + ct2]), xb_ = bf2f(gb[e * 2 + ct2]); \
                if (mm == 0) { const float sg_ = fsigmoid(bias[ct2] + D_[e]); Lb_[1 * 1024 + idx_] = __builtin_amdgcn_exp2f(-0.8750387749f * sg_); Lb_[4 * 1024 + idx_] = xa_; Lb_[5 * 1024 + idx_] = xb_; } \
                else { const float a_ = fsigmoid(bias[ct2] + D_[e]); Lb_[3 * 1024 + idx_] = xa_ * (1.0f + (a_ - 1.0f) * ka[ct2]); Lb_[2 * 1024 + idx_] = xb_ * a_; Lb_[0 * 1024 + idx_] = xb_; } } } } while (0)
        SC_LOAD(0); SC_COMPUTE(0); __syncthreads();
#define ST_LOAD(X, i) do { const LAS float* q_ = Lb + (i) * 64; \
            X##kk0 = *(const LAS f32x4*)(q_); X##kk1 = *(const LAS f32x4*)(q_ + 4); X##w0 = *(const LAS f32x4*)(q_ + 1024); X##w1 = *(const LAS f32x4*)(q_ + 1024 + 4); \
            X##ka0 = *(const LAS f32x4*)(q_ + 2048); X##ka1 = *(const LAS f32x4*)(q_ + 2048 + 4); X##kt0 = *(const LAS f32x4*)(q_ + 3072); X##kt1 = *(const LAS f32x4*)(q_ + 3072 + 4); \
            X##r0 = *(const LAS f32x4*)(q_ + 4096); X##r1 = *(const LAS f32x4*)(q_ + 4096 + 4); X##v = *(const LAS f32x2*)(Lv + (i) * 64); } while (0)
#define LOHI(v4, jp) ((jp) & 1 ? (f32x2){v4[2], v4[3]} : (f32x2){v4[0], v4[1]})
#define ST_COMPUTE(X, i) do { \
            const f32x2 kk2_[4] = {LOHI(X##kk0, 0), LOHI(X##kk0, 1), LOHI(X##kk1, 0), LOHI(X##kk1, 1)}; const f32x2 w2_[4] = {LOHI(X##w0, 0), LOHI(X##w0, 1), LOHI(X##w1, 0), LOHI(X##w1, 1)}; \
            const f32x2 ka2_[4] = {LOHI(X##ka0, 0), LOHI(X##ka0, 1), LOHI(X##ka1, 0), LOHI(X##ka1, 1)}; const f32x2 kt2_[4] = {LOHI(X##kt0, 0), LOHI(X##kt0, 1), LOHI(X##kt1, 0), LOHI(X##kt1, 1)}; \
            const f32x2 r2_[4] = {LOHI(X##r0, 0), LOHI(X##r0, 1), LOHI(X##r1, 0), LOHI(X##r1, 1)}; \
            float sa_[2], yv_[2]; \
            _Pragma("unroll") for (int rr = 0; rr < 2; ++rr) { f32x2 t2 = S[rr][0] * kk2_[0]; t2 += S[rr][1] * kk2_[1]; t2 += S[rr][2] * kk2_[2]; t2 += S[rr][3] * kk2_[3]; sa_[rr] = red8(t2.x + t2.y); } \
            _Pragma("unroll") for (int rr = 0; rr < 2; ++rr) { const float nsa = -sa_[rr]; const float vr = rr == 0 ? X##v.x : X##v.y; f32x2 t2 = (f32x2){0.f, 0.f}; \
                _Pragma("unroll") for (int jp = 0; jp < 4; ++jp) { S[rr][jp] = S[rr][jp] * w2_[jp] + ka2_[jp] * nsa + kt2_[jp] * vr; t2 += S[rr][jp] * r2_[jp]; } \
                yv_[rr] = red8(t2.x + t2.y); } \
            if (kg == 0) *(unsigned*)(Yd + (rb + scan_tok(dir, 16 * c + (i))) * DM + h * 64 + 16 * wq + 2 * vg) = cvt_pk_bf16(yv_[0], yv_[1]); } while (0)
        for (int c = 0; c < NCHUNK; ++c) {
            if (c + 1 < NCHUNK) SC_LOAD(c + 1);
            const LAS float* Lb = L + ((c & 1) * 2 + dir) * 6 * 1024 + 8 * kg;
            const LAS float* Lv = L + ((c & 1) * 2 + dir) * 6 * 1024 + 5 * 1024 + 16 * wq + 2 * vg;
            f32x4 Akk0, Akk1, Aw0, Aw1, Aka0, Aka1, Akt0, Akt1, Ar0, Ar1, Bkk0, Bkk1, Bw0, Bw1, Bka0, Bka1, Bkt0, Bkt1, Br0, Br1; f32x2 Av, Bv;
            ST_LOAD(A, 0);
            if (wq == 0) {
                const LAS float* Lq = L + ((c & 1) * 2 + dir) * 6 * 1024 + (lane >> 2) * 64 + 16 * (lane & 3); float bs = 0.f;
#pragma unroll
                for (int q4 = 0; q4 < 4; ++q4) { const f32x4 rr4 = *(const LAS f32x4*)(Lq + 4096 + 4 * q4), kt4 = *(const LAS f32x4*)(Lq + 3072 + 4 * q4); const f32x4 p4 = rr4 * kt4 * rkb[q4]; bs += (p4[0] + p4[1]) + (p4[2] + p4[3]); }
                bs += dpp_x1(bs); bs += dpp_x2(bs);
                if ((lane & 3) == 0) bonus[((rb + scan_tok(dir, 16 * c + (lane >> 2))) * 16 + h) * 2 + dir] = bs;
            }
            PSUB_T0(1);
#pragma unroll 1
            for (int i = 0; i < 16; i += 2) {
                ST_LOAD(B, i + 1);
                ST_COMPUTE(A, i);
                if (i + 2 < 16) ST_LOAD(A, i + 2);
                ST_COMPUTE(B, i + 1);
            }
            PSUB_T1(1); PSUB_T0(2);
            if (c + 1 < NCHUNK) SC_COMPUTE((c + 1) & 1);
            PSUB_T1(2); PSUB_T0(4);
            __syncthreads();
            PSUB_T1(4);
        }
        PSUB_SPIN();
#undef ST_LOAD
#undef ST_COMPUTE
#undef LOHI
#undef SC_LOAD
#undef SC_COMPUTE
    }
}

#define XB_TMO      128
#define XB_XCNT(j)  (256  + 64 * (j))
#define XB_XSUB(j)  (1280 + 64 * (j))
#define XB_XGEN(j)  (2304 + 64 * (j))
#define XB_TOP      3328
#define XB_TOPGEN   3392
#define XCD_BAR_WORDS 3456
#define XB_SPIN_CAP (1u << 18)

__device__ __forceinline__ unsigned xb_ld(unsigned* p)              { return __hip_atomic_load(p, __ATOMIC_RELAXED, __HIP_MEMORY_SCOPE_AGENT); }
__device__ __forceinline__ unsigned xb_add(unsigned* p, unsigned v) { return __hip_atomic_fetch_add(p, v, __ATOMIC_RELAXED, __HIP_MEMORY_SCOPE_AGENT); }
__device__ __forceinline__ unsigned xb_xcc_id() { return (unsigned)__builtin_amdgcn_s_getreg((3 << 11) | 20) & 0xFu; }
#define XB_SPIN(cond, bar) do { unsigned _sp = 0; while (cond) {   \
    if ((++_sp & 255u) == 0u) { if (xb_ld(&(bar)[XB_TMO])) break; if (_sp > XB_SPIN_CAP) { atomicAdd(&(bar)[XB_TMO], 1u); break; } } } } while (0)

struct XcdBarrier {
    unsigned* bar; unsigned x;
    volatile LAS unsigned* st;
};

__device__ __forceinline__ XcdBarrier xcd_barrier_post(unsigned* bar, volatile LAS unsigned* st) {
    XcdBarrier b; b.bar = bar; b.x = xb_xcc_id(); b.st = st;
    if (threadIdx.x == 0) (void)xb_add(&bar[XB_XCNT(b.x)], 1u);
    return b;
}
__device__ __forceinline__ void xcd_barrier_complete(unsigned* bar, unsigned x, unsigned& nloc, unsigned& nx) {
    const unsigned G = gridDim.x * gridDim.y * gridDim.z;
    unsigned sum, cnt, mine, sp = 0u;
    for (;;) {
        sum = 0u; cnt = 0u; mine = 0u;
#pragma unroll
        for (unsigned j = 0; j < 16; ++j) { const unsigned c = xb_ld(&bar[XB_XCNT(j)]); sum += c; cnt += (c > 0u) ? 1u : 0u; mine = (j == x) ? c : mine; }
        if (sum == G) break;
        __builtin_amdgcn_s_sleep(1);
        if ((++sp & 255u) == 0u) { if (xb_ld(&bar[XB_TMO])) break; if (sp > XB_SPIN_CAP) { atomicAdd(&bar[XB_TMO], 1u); break; } }
    }
    nloc = mine > 0u ? mine : 1u; nx = cnt > 0u ? cnt : 1u;
}

__device__ __forceinline__ void xcd_barrier(const XcdBarrier& b) {
    asm volatile("s_waitcnt vmcnt(0)" ::: "memory");
    __syncthreads();
    if (threadIdx.x == 0) {
        unsigned* bar = b.bar;
        __builtin_amdgcn_s_waitcnt(0);
        unsigned nloc = b.st[0], nx = b.st[1];
        if (nloc == 0u) { xcd_barrier_complete(bar, b.x, nloc, nx); b.st[0] = nloc; b.st[1] = nx; }
        const unsigned old = xb_add(&bar[XB_XSUB(b.x)], 1u);
        const unsigned gen = old / nloc;
        if (old + 1u == (gen + 1u) * nloc) {
            __builtin_amdgcn_fence(__ATOMIC_RELEASE, "agent");
            asm volatile("s_waitcnt vmcnt(0)" ::: "memory");
            const unsigned og = xb_add(&bar[XB_TOP], 1u);
            const unsigned tg = og / nx;
            if (og + 1u == (tg + 1u) * nx) xb_add(&bar[XB_TOPGEN], 1u);
            else XB_SPIN(xb_ld(&bar[XB_TOPGEN]) == tg, bar);
            __builtin_amdgcn_fence(__ATOMIC_ACQUIRE, "agent");
            xb_add(&bar[XB_XGEN(b.x)], 1u);
            asm volatile("s_waitcnt vmcnt(0)" ::: "memory");
        } else {
            XB_SPIN(xb_ld(&bar[XB_XGEN(b.x)]) == gen, bar);
            __builtin_amdgcn_fence(__ATOMIC_ACQUIRE, "agent");
            asm volatile("s_waitcnt vmcnt(0)" ::: "memory");
        }
    }
    __syncthreads();
}

constexpr int MISC_OFF = 131072 + 320;

typedef const __attribute__((address_space(4))) Args* ArgsP;
__device__ __forceinline__ ArgsP get_args() { ArgsP p = (ArgsP)__builtin_amdgcn_kernarg_segment_ptr(); asm volatile("" : "+s"(p)); return p; }
#define PHASE_BEGIN() Frame F; { int t_ = threadIdx.x; asm volatile("" : "+v"(t_)); F.tid = t_; F.lane = t_ & 63; F.wave = __builtin_amdgcn_readfirstlane(t_ >> 6); \
        F.lds = (LAS unsigned char*)lds; F.G = gridDim.x; const int bx_ = blockIdx.x; F.vcu = (F.G % 8 == 0) ? (bx_ % 8) * (F.G / 8) + bx_ / 8 : bx_; } \
    ArgsP A = get_args(); unsigned char* const ws = A->ws; float* const xout = A->out; float* const ctxb = (float*)(ws + WS_CTX); bf16* const Wb = (bf16*)(ws + WS_W); unsigned char* const act = ws + WS_ACT; \
    const float* const modL = (const float*)(ws + WS_MOD) + (size_t)layer * 17 * NMOD; \
    const float* const srcL = layer == 0 ? A->in[0] : xout; const float* const srcC = ctxb; \
      \
    const float* const pendP = nullptr; const float* const pendG = modL - (size_t)17 * NMOD + (size_t)16 * NMOD + 5 * DM; \
    (void)xout; (void)ctxb; (void)Wb; (void)act; (void)modL; (void)srcL; (void)srcC; (void)pendP; (void)pendG
#ifndef PHM
#define PHM 0xFFFF
#endif
#define PH(x) if (PHM & (x))
#ifndef PROBE_MASK
#define PROBE_MASK 0
#endif
#define TIC() const unsigned long long t0_ = PROBE_MASK ? __builtin_amdgcn_s_memrealtime() : 0ull
#define TOC(x) do { if (PROBE_MASK & (x)) { const unsigned long long t1_ = __builtin_amdgcn_s_memrealtime(); while (__builtin_amdgcn_s_memrealtime() - t1_ < t1_ - t0_) __builtin_amdgcn_s_sleep(8); } } while (0)
#define GSYNC_CG() cg::this_grid().sync()
#ifndef XSYNC
#define XSYNC 0
#endif
#define GSYNC() do { GSYNC1(); if (XSYNC) GSYNC1(); } while (0)
#define GSYNC1() do { XcdBarrier b_; b_.bar = (unsigned*)get_args()->ws; b_.x = xb_xcc_id(); b_.st = (volatile LAS unsigned*)((LAS unsigned char*)lds + MISC_OFF) + 8; xcd_barrier(b_); } while (0)
#define GEMM(EpiT, gg, EE) do { pg8::StaticOrder S_; S_.init((gg).M, (gg).N, F.G, (int)blockIdx.x); pg8::gemm_phase<EpiT, pg8::StaticOrder, true, true>(F.lds, gg, S_, EE); } while (0)
#define GEMM_SK(EpiT, gg, EE, sk) do { pg8::StaticOrder S_; S_.init((gg).M, (gg).N, F.G, (int)blockIdx.x, (sk) ? 1 : 0); pg8::gemm_phase<EpiT, pg8::StaticOrder, true, true>(F.lds, gg, S_, EE); } while (0)

__global__ void __launch_bounds__(NWAVES * 64, 2) hybrid_fwd(Args args_unused) {
    extern __shared__ __attribute__((aligned(16))) unsigned char lds[];
    { volatile LAS unsigned* misc = (volatile LAS unsigned*)((LAS unsigned char*)lds + MISC_OFF); if (threadIdx.x < 32) misc[threadIdx.x] = 0u; __syncthreads();
      (void)xcd_barrier_post((unsigned*)get_args()->ws, misc + 8); }
    { const int layer = 0; TIC(); PHASE_BEGIN(); PH(1) p0a(F, A); TOC(1); } GSYNC_CG();
    { const int layer = 0; TIC(); PHASE_BEGIN(); PH(1) p0b(F, A); TOC(1); } GSYNC();
    { const int layer = 0; TIC(); PHASE_BEGIN(); PH(1) p0c(F, A); TOC(1); } GSYNC();

#pragma unroll 1
    for (int layer = 0; layer < 4; ++layer) {
        const int kind = layer % 3;
        if (layer > 0) {
            { TIC(); PHASE_BEGIN(); const float* pp = (const float*)(act + 680 * MiB); const float* pg = modL - (size_t)17 * NMOD + (size_t)16 * NMOD + 5 * DM;
              constexpr size_t NQ = (size_t)NB * CTXL * DM;
              const bool fuse = layer < 3;
              bf16* Hn = (bf16*)(act + (layer == 1 ? 748 * MiB : 0)); float* rq = (float*)(ws + WS_ROWSQ) + (size_t)(3 + layer) * MROWS;
              const float* g1 = A->in[6] + layer * DM; const float* sc1 = modL + (size_t)16 * NMOD + 1 * DM;
              for (int r = F.vcu * NWAVES + F.wave; r < NB * CTXL; r += F.G * NWAVES) { float ss = 0.f; const size_t grow = (size_t)(r >> 8) * TPB + SEQ + (r & 255);
#pragma unroll
                  for (int j = 0; j < 4; ++j) { const int c = 4 * F.lane + 256 * j; const float* p = pp + (size_t)r * DM + c;
                      const f32x4 xn = *(const f32x4*)(ctxb + (size_t)r * DM + c) + *(const f32x4*)(pg + c) * ((*(const f32x4*)(p) + *(const f32x4*)(p + NQ)) + (*(const f32x4*)(p + 2 * NQ) + *(const f32x4*)(p + 3 * NQ)));
                      *(f32x4*)(ctxb + (size_t)r * DM + c) = xn;
                      if (fuse) { ss += (xn[0] * xn[0] + xn[1] * xn[1]) + (xn[2] * xn[2] + xn[3] * xn[3]); const f32x4 hq = xn * (*(const f32x4*)(g1 + c) * (*(const f32x4*)(sc1 + c) + 1.0f));
                          u32x2 w; w.x = cvt_pk_bf16(hq[0], hq[1]); w.y = cvt_pk_bf16(hq[2], hq[3]); *(u32x2*)(Hn + grow * DM + c) = w; } }
                  if (fuse) { ss = wave_sum(ss); if (F.lane == 0) rq[grow] = ss; } }
              TOC(2); } GSYNC();
        }
        if (kind == 0) {
            PH(2) { TIC(); PHASE_BEGIN(); ln_phase(F, srcL, srcC, A->in[6] + layer * DM, modL, 0, (bf16*)act, pendP, pendG); TOC(2); } GSYNC();
            PH(4) { TIC(); PHASE_BEGIN(); const int j = layer / 3; bf16* Q = (bf16*)(act + ACT1); bf16* Kb = (bf16*)(act + 2 * ACT1); bf16* Vb = (bf16*)(act + 2 * ACT1 + 34 * MiB);
              pg8::Gemm g{(bf16*)act, Wb + (W_QKV + (size_t)j * 3 * MiB) / 2, MROWS, 1536, DM, DM, DM, 0};
              EpiQKV E{Q, Kb, Vb, A->in[11] + j * 64, A->in[12] + j * 64, (const float*)(ws + WS_ROPE)};
              GEMM(EpiQKV, g, E); TOC(4); } GSYNC();
            PH(8) { TIC(); PHASE_BEGIN(); const bool with_ctx = layer != 3; bf16* Q = (bf16*)(act + ACT1); bf16* Kb = (bf16*)(act + 2 * ACT1); bf16* Vb = (bf16*)(act + 2 * ACT1 + 34 * MiB);
              for (int bh = F.vcu; bh < NB * 16; bh += F.G) { const int b = bh >> 4, h = bh & 15; const long rb = (long)b * TPB;
                  for (int qb = 0; qb < 16; ++qb) attn_body::attn_unit<8>(rb + qb * 256, rb, TPB / 64, h, (const attn_body::bf16*)Q, (const attn_body::bf16*)Kb, (const attn_body::bf16*)Vb, (attn_body::bf16*)Q, (char*)lds);
                  if (with_ctx) attn_body::attn_unit<8>(rb + SEQ, rb + SEQ, CTXL / 64, h, (const attn_body::bf16*)Q, (const attn_body::bf16*)Kb, (const attn_body::bf16*)Vb, (attn_body::bf16*)Q, (char*)lds); } TOC(8); } GSYNC();
            PH(16) { TIC(); PHASE_BEGIN(); const int j = layer / 3; bf16* Q = (bf16*)(act + ACT1);
              pg8::Gemm g{Q, Wb + (W_WO + (size_t)j * 2 * MiB) / 2, MROWS, DM, DM, DM, DM, 0};
              EpiResid E{srcL, srcC, xout, ctxb, modL, 2, nullptr, (bf16*)act, (float*)(ws + WS_ROWSQ) + (size_t)layer * MROWS, A->in[7] + layer * DM, modL + 4 * DM, pendP, pendG};
              GEMM_SK(EpiResid, g, E, layer == 3); TOC(16); } GSYNC();
        } else if (kind == 1) {
            PH(32) { TIC(); PHASE_BEGIN(); ln_rwkv_phase(F, (const bf16*)(act + 748 * MiB), (const float*)(ws + WS_ROWSQ) + (size_t)4 * MROWS, A->in[6] + layer * DM, modL, (bf16*)act, (bf16*)(act + 136 * MiB), (bf16*)(act + 272 * MiB), (bf16*)(act + 408 * MiB), A->in[14]); TOC(32); } GSYNC();
#pragma unroll 1
            for (int q = 0; q < 4; ++q) {
                PH(64) { TIC(); PHASE_BEGIN();
                  const size_t aoff = q == 0 ? 408 * MiB : (size_t)(q - 1) * 136 * MiB; const size_t ooff = q == 1 ? 748 * MiB : (q == 2 ? 408 * MiB : 0);
                  const size_t woff = q == 0 ? 6 * MiB : (size_t)(q - 1) * 2 * MiB; const int kk_ = q == 0 ? 2048 : DM;
                  pg8::Gemm g{(bf16*)(act + aoff), Wb + (W_R1 + woff) / 2, MROWS, q == 0 ? 512 : DM, kk_, kk_, kk_, 0};
                  EpiRwkv1 E{(bf16*)(act + ooff), (bf16*)(act + 544 * MiB), (bf16*)(act + 680 * MiB), A->in[24], q == 0 ? 12 : 4 * (q - 1)};
                  GEMM(EpiRwkv1, g, E); TOC(64); } GSYNC();
            }
            PH(128) { TIC(); PHASE_BEGIN(); bf16* R = (bf16*)(act + 748 * MiB); bf16* Kb = (bf16*)(act + 408 * MiB); bf16* Vb = (bf16*)(act); bf16* KK = (bf16*)(act + 544 * MiB); bf16* P = (bf16*)(act + 680 * MiB);
              scan_phase(F, R, Kb, KK, Vb, P, (bf16*)(act + 136 * MiB), (bf16*)(act + 272 * MiB), (float*)(ws + WS_BONUS), A->in[16], A->in[18], A->in[19], A->in[21], A->in[25], A->in[26]); TOC(128); } GSYNC();
            PH(256) { TIC(); PHASE_BEGIN(); bf16* Vb = (bf16*)(act); bf16* P = (bf16*)(act + 680 * MiB); bf16* Z = (bf16*)(act + 408 * MiB);
              pg8::Gemm g{P + 256, Wb + W_G2 / 2, MROWS, DM, 256, 512, 256, 0};
              EpiFinish E{(bf16*)(act + 136 * MiB), (bf16*)(act + 272 * MiB), Vb, (const float*)(ws + WS_BONUS), A->in[27], A->in[28], Z};
              GEMM(EpiFinish, g, E); TOC(256); } GSYNC();
            PH(512) { TIC(); PHASE_BEGIN(); bf16* Z = (bf16*)(act + 408 * MiB);
              pg8::Gemm g{Z, Wb + W_RWO / 2, MROWS, DM, DM, DM, DM, 0};
              EpiResid E{srcL, srcC, xout, ctxb, modL, 2, nullptr, (bf16*)act, (float*)(ws + WS_ROWSQ) + (size_t)layer * MROWS, A->in[7] + layer * DM, modL + 4 * DM, pendP, pendG};
              GEMM(EpiResid, g, E); TOC(512); } GSYNC();
        } else {
            PH(1024) { TIC(); PHASE_BEGIN(); pool_phase(F, (bf16*)act, (const float*)(ws + WS_ROWSQ) + (size_t)5 * MROWS, (bf16*)(act + ACT1)); TOC(1024); } GSYNC();
            PH(2048) { TIC(); PHASE_BEGIN(); bf16* PL = (bf16*)(act + ACT1);
              pg8::Gemm g{PL, Wb + W_POOL / 2, MROWS, DM, 256, DM, 256, 256};
              EpiResid E{srcL, srcC, xout, ctxb, modL, 2, A->in[31], (bf16*)act, (float*)(ws + WS_ROWSQ) + (size_t)layer * MROWS, A->in[7] + layer * DM, modL + 4 * DM, pendP, pendG};
              GEMM(EpiResid, g, E); TOC(2048); } GSYNC();
        }
        PH(4096) { TIC(); PHASE_BEGIN(); bf16* U = (bf16*)(act + ACT1);
          pg8::Gemm g{(bf16*)act, Wb + (W_IN + (size_t)layer * 8 * MiB) / 2, MROWS, FF, DM, DM, DM, 0};
          EpiRelu2 E{U, FF, (const float*)(ws + WS_ROWSQ) + (size_t)layer * MROWS, (const float*)(ws + WS_SW) + (size_t)layer * 17 * FF};
          { pg8::StaticOrder S_; S_.init(g.M, g.N, F.G, (int)blockIdx.x, layer == 3 ? 1 : 0); pg8::gemm_phase<EpiRelu2, pg8::StaticOrder, true, true>(F.lds, g, S_, E); } TOC(4096); } GSYNC();
        PH(8192) { TIC(); PHASE_BEGIN(); bf16* U = (bf16*)(act + ACT1);
          pg8::Gemm g{U, Wb + (W_OUT + (size_t)layer * 8 * MiB) / 2, MROWS, DM, FF, FF, FF, 0};
          const bool f1 = layer < 2;
          EpiResid E{xout, ctxb, xout, ctxb, modL, 5, nullptr, f1 ? (bf16*)(act + (layer == 0 ? 748 * MiB : 0)) : nullptr, (float*)(ws + WS_ROWSQ) + (size_t)(4 + layer) * MROWS, A->in[6] + (layer + 1) * DM, modL + (size_t)17 * NMOD + 1 * DM, nullptr, nullptr};
          GEMM_SK(EpiResid, g, E, 1);
          if (layer != 3) { pg8::Gemm g4 = g; g4.K = FF / 4; EpiPartial Ep{(float*)(act + 680 * MiB), FF / 4}; pg8::CtxSplitK S_; S_.init(FF, F.G, (int)blockIdx.x);
              pg8::gemm_phase<EpiPartial, pg8::CtxSplitK, true, true>(F.lds, g4, S_, Ep); } TOC(8192); }
        if (layer != 3) GSYNC();
    }
}

extern "C" void kernel_launch(void* const* d_in, const int* in_sizes, int n_in, void* d_out, int out_size, void* d_ws, size_t ws_size, hipStream_t stream) {
    static int grid = 0;
    if (grid == 0) {
        if (n_in != 32 || in_sizes[0] != NB * SEQ * DM || out_size != NB * SEQ * DM || ws_size < WS_NEED) { fprintf(stderr, "kernel_launch: unexpected shapes (n_in %d, in0 %d, out %d, ws %zu); nothing launched\n", n_in, n_in > 0 ? in_sizes[0] : -1, out_size, ws_size); grid = -1; return; }
        int dev = 0, cus = 0, per_cu = 0;
        if (hipGetDevice(&dev) != hipSuccess || hipDeviceGetAttribute(&cus, hipDeviceAttributeMultiprocessorCount, dev) != hipSuccess) { grid = -1; return; }
        if (hipFuncSetAttribute((const void*)hybrid_fwd, hipFuncAttributeMaxDynamicSharedMemorySize, LDS_BYTES) != hipSuccess) { fprintf(stderr, "kernel_launch: hipFuncSetAttribute failed\n"); grid = -1; return; }
        if (hipOccupancyMaxActiveBlocksPerMultiprocessor(&per_cu, (const void*)hybrid_fwd, NWAVES * 64, LDS_BYTES) != hipSuccess || per_cu < 1) { fprintf(stderr, "kernel_launch: occupancy query says %d\n", per_cu); per_cu = 1; }
        (void)hipGetLastError();
        grid = cus * per_cu;
    }
    if (grid < 0) return;
    Args a{};
    for (int i = 0; i < 32; ++i) a.in[i] = (const float*)d_in[i];
    a.out = (float*)d_out; a.ws = (unsigned char*)d_ws;
    bf16* Wb = (bf16*)((unsigned char*)d_ws + WS_W);
    int nj = 0, items = 0;
    auto add = [&](const float* src, const float* kscale, bf16* dst, int ld_src, int k_src, int k_pad, int ncols, int ldt, int row_off, int col_base, int k_off, int mode) {
        WJob& J = a.job[nj]; J.src = src; J.kscale = kscale; J.dst = dst; J.ld_src = ld_src; J.k_src = k_src; J.ldt = ldt; J.row_off = row_off; J.col_base = col_base; J.k_off = k_off; J.nblk = ncols / 32; J.mode = mode;
        a.istart[nj] = items; items += (k_pad / 64) * (ncols / 32); ++nj; };
    const float* in10 = a.in[10]; const float* in13 = a.in[13];
    for (int j = 0; j < 2; ++j) add(in10 + (size_t)j * DM * 1536, nullptr, Wb + (W_QKV + (size_t)j * 3 * MiB) / 2, 1536, DM, DM, 1536, DM, 0, 0, 0, 1);
    for (int j = 0; j < 2; ++j) add(in13 + (size_t)j * DM * DM, nullptr, Wb + (W_WO + (size_t)j * 2 * MiB) / 2, DM, DM, DM, DM, DM, 0, 0, 0, 0);
    for (int i = 0; i < 4; ++i) add(a.in[8] + (size_t)i * DM * FF, nullptr, Wb + (W_IN + (size_t)i * 8 * MiB) / 2, FF, DM, DM, FF, DM, 0, 0, 0, 0);
    for (int i = 0; i < 4; ++i) add(a.in[9] + (size_t)i * FF * DM, nullptr, Wb + (W_OUT + (size_t)i * 8 * MiB) / 2, DM, FF, FF, DM, FF, 0, 0, 0, 0);
    { bf16* W1 = Wb + W_R1 / 2; const float* mu = a.in[14]; const float* rkv = a.in[15];
      for (int i = 0; i < 3; ++i) add(rkv + (size_t)i * DM * DM, nullptr, W1 + (size_t)i * DM * DM, DM, DM, DM, DM, DM, 0, 0, 0, 1);
      bf16* WL = W1 + (size_t)3 * DM * DM;
      for (int hf = 0; hf < 2; ++hf) { const int ko = hf * DM;
          for (int d = 0; d < 2; ++d) add(a.in[17] + (size_t)d * DM * 64, hf ? mu + 1 * DM : nullptr, WL, 64, DM, DM, 64, 2048, 0, 64 * d, ko, 1);
          for (int d = 0; d < 2; ++d) add(a.in[20] + (size_t)d * DM * 64, hf ? mu + 4 * DM : nullptr, WL, 64, DM, DM, 64, 2048, 0, 128 + 64 * d, ko, 1);
          add(a.in[22], hf ? mu + 5 * DM : nullptr, WL, 160, DM, DM, 160, 2048, 0, 256, ko, 1);
          add(nullptr, nullptr, WL, 96, DM, DM, 96, 2048, 0, 416, ko, 1); } }
    add(a.in[23], nullptr, Wb + W_G2 / 2, DM, 160, 256, DM, 256, 0, 0, 0, 1);
    add(a.in[29], nullptr, Wb + W_RWO / 2, DM, DM, DM, DM, DM, 0, 0, 0, 0);
    for (int gi = 0; gi < 4; ++gi) add(a.in[30] + (size_t)gi * 256 * 256, nullptr, Wb + W_POOL / 2, 256, 256, 256, 256, 256, 256 * gi, 0, 0, 0);
    if (nj != NJOBS) { fprintf(stderr, "kernel_launch: job count %d != %d\n", nj, NJOBS); return; }
    a.istart[NJOBS] = items; a.istart[NJOBS + 1] = 0;
    if (hipMemsetAsync(d_ws, 0, WS_ZERO_BYTES, stream) != hipSuccess) { fprintf(stderr, "kernel_launch: memset of the barrier words failed\n"); return; }
    void* kargs[] = {&a};
    hipError_t e = hipLaunchCooperativeKernel((const void*)hybrid_fwd, dim3(grid), dim3(NWAVES * 64), kargs, LDS_BYTES, stream);
    if (e != hipSuccess) fprintf(stderr, "kernel_launch: cooperative launch failed: %s (grid %d)\n", hipGetErrorString(e), grid);
}
```
